# Optimizing an MI355X kernel written in HIP

```python
import jax, jax.numpy as jnp
from jax import lax
import numpy as np

D_MODEL = 1024
BATCH = 16
SEQ = 256
DEPTH = 2
DEC_BATCH = 4
DEC_SEQ = 1024
PAST_LEN = 256

GRID_W = 64
N_EVEN = (DEPTH + 1) // 2
N_ODD = DEPTH // 2
H_A = 4
DK_A = 128
DV_A = 128
H_B = 4
DK_B = 128
DV_B = 128
SHORT_CONV = 5
C_CONV = H_B * (2 * DK_B + DV_B)
CHUNK = 32
H_C = 16
HD_C = 64
KH_MAX = 8
KW = 16
QBW = 16
KBW = QBW + KW
Q_BLOCK = 128
D_FF = 4 * D_MODEL
EPS = 1e-6
NEG_INF = -1e30

_AB_SIZES = (H_A * DK_A, H_A * DK_A, H_A * DK_A, H_A * DV_A, H_A * DV_A,
             C_CONV, H_B * DV_B, H_B, H_B, H_B, H_B)
D_IN_AB = 3 * H_A * DK_A + 2 * H_A * DV_A + C_CONV + H_B * DV_B + 4 * H_B
D_MIX_AB = H_A * DV_A + H_B * DV_B

kernel_name = 'hybrid_hgrn2_gdn_natten_prefix_dit'


def _split(x, sizes):
    offs, acc = [], 0
    for s in sizes[:-1]:
        acc += s
        offs.append(acc)
    return jnp.split(x, offs, axis=-1)


def _rmsnorm(x, g):
    x32 = x.astype(jnp.float32)
    y = x32 * lax.rsqrt(jnp.mean(x32 * x32, axis=-1, keepdims=True) + EPS)
    return (y * g.astype(jnp.float32)).astype(x.dtype)


def _l2norm(x):
    return x * lax.rsqrt(jnp.sum(x * x, axis=-1, keepdims=True) + EPS)


def _heads(x, h):
    b, t, _ = x.shape
    return x.reshape(b, t, h, -1).transpose(0, 2, 1, 3)


def _merge(x):
    b, h, t, d = x.shape
    return x.transpose(0, 2, 1, 3).reshape(b, t, h * d)


def _modulation(cond, w, b):
    m = jax.nn.silu(cond) @ w + b
    return jnp.split(m[:, None, :], 6, axis=-1)


def _short_conv(x, w):
    return lax.conv_general_dilated(
        x, w.astype(x.dtype), window_strides=(1,),
        padding=[(SHORT_CONV // 2, SHORT_CONV // 2)],
        dimension_numbers=('NWC', 'WIO', 'NWC'), feature_group_count=x.shape[-1])


def _gla_chunked(q, k, v, log_f, s0):
    b, h, t, _ = q.shape
    n = t // CHUNK
    rs = lambda a: a.reshape(b, h, n, CHUNK, a.shape[-1])
    q, k, v, log_f = rs(q), rs(k), rs(v), rs(log_f)
    g = jnp.cumsum(log_f, axis=3)
    tri = jnp.tril(jnp.ones((CHUNK, CHUNK), bool))[:, :, None]
    diff = g[:, :, :, :, None, :] - g[:, :, :, None, :, :]
    decay = jnp.where(tri, jnp.exp(jnp.where(tri, diff, 0.0)), 0.0)
    attn = jnp.einsum('bhntd,bhnsd,bhntsd->bhnts', q, k, decay)
    o_intra = jnp.einsum('bhnts,bhnsv->bhntv', attn, v)
    g_last = g[:, :, :, -1:, :]
    u = jnp.einsum('bhnsd,bhnsv->bhndv', k * jnp.exp(g_last - g), v)
    a_chunk = jnp.exp(g_last[:, :, :, 0])

    def step(s, inp):
        a_n, u_n = inp
        return a_n[..., None] * s + u_n, s

    s_final, s_before = lax.scan(step, s0, (jnp.moveaxis(a_chunk, 2, 0), jnp.moveaxis(u, 2, 0)))
    s_before = jnp.moveaxis(s_before, 0, 2)
    o_inter = jnp.einsum('bhntd,bhndv->bhntv', q * jnp.exp(g), s_before)
    return (o_intra + o_inter).reshape(b, h, t, -1), s_final


def _gated_delta_chunked(q, k, v, glog, beta, s0):
    b, h, t, _ = q.shape
    n = t // CHUNK
    rs = lambda a: a.reshape(b, h, n, CHUNK, a.shape[-1])
    q, k, v = rs(q), rs(k), rs(v)
    g = jnp.cumsum(glog.reshape(b, h, n, CHUNK), axis=-1)
    beta = beta.reshape(b, h, n, CHUNK)
    tri = jnp.tril(jnp.ones((CHUNK, CHUNK), bool))
    strict = jnp.tril(jnp.ones((CHUNK, CHUNK), bool), -1)
    diff = g[..., :, None] - g[..., None, :]
    L = jnp.where(tri, jnp.exp(jnp.where(tri, diff, 0.0)), 0.0)
    kb = k * beta[..., None]
    A = jnp.where(strict, jnp.einsum('bhntd,bhnsd->bhnts', kb, k) * L, 0.0)
    T = jnp.eye(CHUNK, dtype=A.dtype) + A
    u = lax.linalg.triangular_solve(T, v * beta[..., None], left_side=True, lower=True, unit_diagonal=True)
    w = lax.linalg.triangular_solve(T, kb * jnp.exp(g)[..., None], left_side=True, lower=True, unit_diagonal=True)
    attn = jnp.where(tri, jnp.einsum('bhntd,bhnsd->bhnts', q, k) * L, 0.0)
    qg = q * jnp.exp(g)[..., None]
    g_last = g[..., -1]
    kdec = k * jnp.exp(g_last[..., None] - g)[..., None]

    def step(s, inp):
        u_n, w_n, attn_n, qg_n, kdec_n, gl_n = inp
        v_new = u_n - jnp.einsum('bhtd,bhdv->bhtv', w_n, s)
        o_n = jnp.einsum('bhtd,bhdv->bhtv', qg_n, s) + jnp.einsum('bhts,bhsv->bhtv', attn_n, v_new)
        s = jnp.exp(gl_n)[..., None, None] * s + jnp.einsum('bhsd,bhsv->bhdv', kdec_n, v_new)
        return s, o_n

    xs = tuple(jnp.moveaxis(a, 2, 0) for a in (u, w, attn, qg, kdec, g_last))
    s_final, o = lax.scan(step, s0, xs)
    return jnp.moveaxis(o, 0, 2).reshape(b, h, t, -1), s_final


def _mixer_ab(h, w_in, w_out, lb, conv_w, a_log, dt_bias, gn_a, gn_b, s_hgrn, s_gdn):
    f32 = jnp.float32
    q_a, f_fw, f_bw, i_a, g_a, qkv_b, g_b, a_fw, a_bw, b_fw, b_bw = _split(h @ w_in, _AB_SIZES)
    lbh = lb.reshape(H_A, 1, DK_A)
    qa = _heads(jax.nn.silu(q_a), H_A).astype(f32) * DK_A ** -0.5
    va = _heads(i_a, H_A).astype(f32)
    s_h = s_hgrn.astype(f32)

    def hgrn_dir(f_raw, s0, flip):
        f = lbh + (1.0 - lbh) * jax.nn.sigmoid(_heads(f_raw, H_A).astype(f32))
        args = [qa, 1.0 - f, va, jnp.log(f)]
        if flip:
            args = [jnp.flip(a, axis=2) for a in args]
        o, s = _gla_chunked(*args, s0)
        return (jnp.flip(o, axis=2) if flip else o), s

    oa_f, sa_f = hgrn_dir(f_fw, s_h[:, 0], False)
    oa_b, sa_b = hgrn_dir(f_bw, s_h[:, 1], True)
    o_a = _rmsnorm(oa_f + oa_b, gn_a) * jax.nn.silu(_heads(g_a, H_A).astype(f32))
    qkv = jax.nn.silu(_short_conv(qkv_b, conv_w))
    q_b, k_b, v_b = _split(qkv, (H_B * DK_B, H_B * DK_B, H_B * DV_B))
    qb = _l2norm(_heads(q_b, H_B).astype(f32)) * DK_B ** -0.5
    kb = _l2norm(_heads(k_b, H_B).astype(f32))
    vb = _heads(v_b, H_B).astype(f32)
    s_g = s_gdn.astype(f32)

    def gdn_dir(a_raw, b_raw, d, s0, flip):
        beta = jax.nn.sigmoid(b_raw.astype(f32)).transpose(0, 2, 1)
        glog = (-jnp.exp(a_log[d].astype(f32))
                * jax.nn.softplus(a_raw.astype(f32) + dt_bias[d].astype(f32))).transpose(0, 2, 1)
        args = [qb, kb, vb, glog, beta]
        if flip:
            args = [jnp.flip(a, axis=2) for a in args]
        o, s = _gated_delta_chunked(*args, s0)
        return (jnp.flip(o, axis=2) if flip else o), s

    ob_f, sb_f = gdn_dir(a_fw, b_fw, 0, s_g[:, 0], False)
    ob_b, sb_b = gdn_dir(a_bw, b_bw, 1, s_g[:, 1], True)
    o_b = _rmsnorm(ob_f + ob_b, gn_b) * jax.nn.silu(_heads(g_b, H_B).astype(f32))
    o = jnp.concatenate([_merge(o_a), _merge(o_b)], axis=-1).astype(h.dtype)
    return (o @ w_out,
            jnp.stack([sa_f, sa_b], axis=1).astype(h.dtype),
            jnp.stack([sb_f, sb_b], axis=1).astype(h.dtype))


def _na_qkv(h, w_qkv, qn, kn):
    q, k, v = jnp.split(h @ w_qkv, 3, axis=-1)
    return _rmsnorm(_heads(q, H_C), qn), _rmsnorm(_heads(k, H_C), kn), _heads(v, H_C)


def _ctx_attention(q, k, v):
    b, h, t, d = q.shape
    qb = jnp.moveaxis(q.reshape(b, h, t // Q_BLOCK, Q_BLOCK, d), 2, 0)

    def blk(qi):
        s = jnp.einsum('bhqd,bhkd->bhqk', qi, k).astype(jnp.float32) * HD_C ** -0.5
        p = jax.nn.softmax(s, axis=-1)
        return jnp.einsum('bhqk,bhkd->bhqd', p.astype(v.dtype), v)

    o = lax.map(blk, qb)
    return jnp.moveaxis(o, 0, 2).reshape(b, h, t, d)


def _na_latent(q, k, v, k_ctx, v_ctx, rpb):
    b, h, t, d = q.shape
    rows = t // GRID_W
    kh = min(KH_MAX, rows)
    ncb = GRID_W // QBW
    qg = q.reshape(b, h, rows, GRID_W, d)
    kg = k.reshape(b, h, rows, GRID_W, d)
    vg = v.reshape(b, h, rows, GRID_W, d)
    qc = np.arange(GRID_W).reshape(ncb, QBW)
    kc0 = np.clip(np.arange(ncb) * QBW - KW // 2, 0, GRID_W - KBW)
    kcols = kc0[:, None] + np.arange(KBW)
    cstart = np.clip(qc - KW // 2, 0, GRID_W - KW)
    col_valid = (kcols[:, None, :] >= cstart[..., None]) & (kcols[:, None, :] < cstart[..., None] + KW)
    col_idx = np.clip(kcols[:, None, :] - qc[:, :, None] + KW - 1, 0, 2 * KW - 2)
    rpb_c = rpb.astype(jnp.float32)[:, :, col_idx]
    scale = HD_C ** -0.5

    def row_block(r):
        rs = jnp.clip(r - kh // 2, 0, rows - kh)
        q_r = lax.dynamic_index_in_dim(qg, r, axis=2, keepdims=False).reshape(b, h, ncb, QBW, d)
        k_r = lax.dynamic_slice_in_dim(kg, rs, kh, axis=2)[:, :, :, kcols]
        v_r = lax.dynamic_slice_in_dim(vg, rs, kh, axis=2)[:, :, :, kcols]
        s_win = jnp.einsum('bhjqd,bhajkd->bhjqak', q_r, k_r).astype(jnp.float32) * scale
        dr_idx = rs + jnp.arange(kh) - r + (KH_MAX - 1)
        bias = jnp.transpose(rpb_c[:, dr_idx], (0, 2, 3, 1, 4))
        s_win = jnp.where(col_valid[:, :, None, :], s_win + bias, NEG_INF).reshape(b, h, ncb, QBW, kh * KBW)
        s_ctx = jnp.einsum('bhjqd,bhld->bhjql', q_r, k_ctx).astype(jnp.float32) * scale
        p = jax.nn.softmax(jnp.concatenate([s_win, s_ctx], axis=-1), axis=-1)
        p_win = p[..., :kh * KBW].reshape(b, h, ncb, QBW, kh, KBW).astype(v.dtype)
        p_ctx = p[..., kh * KBW:].astype(v.dtype)
        o = (jnp.einsum('bhjqak,bhajkd->bhjqd', p_win, v_r)
             + jnp.einsum('bhjql,bhld->bhjqd', p_ctx, v_ctx.astype(v.dtype)))
        return o.reshape(b, h, GRID_W, d)

    o = lax.map(row_block, jnp.arange(rows))
    return jnp.moveaxis(o, 0, 2).reshape(b, h, t, d)


def _mlp(h, w1, w2):
    return jnp.square(jax.nn.relu(h @ w1)) @ w2


def setup_inputs(seed: int = 0) -> dict:
    key = jax.random.key(seed)
    ks = jax.random.split(key, 32)
    nrm = lambda k, shape, s: jax.random.normal(k, shape, jnp.float32) * s
    d = D_MODEL
    return {
        'x_prompt': nrm(ks[0], (BATCH, SEQ, d), 1.0),
        'x_sample': nrm(ks[1], (DEC_BATCH, DEC_SEQ, d), 1.0),
        'state_hgrn': nrm(ks[2], (DEC_BATCH, N_EVEN, 2, H_A, DK_A, DV_A), 0.5),
        'state_gdn': nrm(ks[3], (DEC_BATCH, N_EVEN, 2, H_B, DK_B, DV_B), 0.1),
        'cache_na_k': nrm(ks[4], (DEC_BATCH, N_ODD, H_C, PAST_LEN, HD_C), 1.0),
        'cache_na_v': nrm(ks[5], (DEC_BATCH, N_ODD, H_C, PAST_LEN, HD_C), 1.0),
        'c': nrm(ks[6], (DEC_BATCH, d), 1.0),
        'c_ctx': nrm(ks[7], (d,), 1.0),
        'ada_w': nrm(ks[8], (DEPTH, d, 6 * d), 0.5 * d ** -0.5),
        'ada_b': nrm(ks[9], (DEPTH, 6 * d), 0.02),
        'norm_g': 1.0 + nrm(ks[10], (DEPTH, 2, d), 0.01),
        'w_in_ab': nrm(ks[11], (N_EVEN, d, D_IN_AB), d ** -0.5),
        'w_out_ab': nrm(ks[12], (N_EVEN, D_MIX_AB, d), D_MIX_AB ** -0.5),
        'hgrn_lb': nrm(ks[13], (DEPTH + 1, H_A * DK_A), 0.1),
        'gdn_conv': nrm(ks[14], (N_EVEN, SHORT_CONV, 1, C_CONV), SHORT_CONV ** -0.5),
        'gdn_a_log': jnp.log(jax.random.uniform(ks[15], (N_EVEN, 2, H_B), jnp.float32, 1.0, 8.0)),
        'gdn_dt_bias': nrm(ks[16], (N_EVEN, 2, H_B), 0.1),
        'gn_hgrn': 1.0 + nrm(ks[17], (N_EVEN, DV_A), 0.01),
        'gn_gdn': 1.0 + nrm(ks[18], (N_EVEN, DV_B), 0.01),
        'w_qkv_na': nrm(ks[19], (N_ODD, d, 3 * H_C * HD_C), d ** -0.5),
        'qn_na': 1.0 + nrm(ks[20], (N_ODD, HD_C), 0.01),
        'kn_na': 1.0 + nrm(ks[21], (N_ODD, HD_C), 0.01),
        'rpb_na': nrm(ks[22], (N_ODD, H_C, 2 * KH_MAX - 1, 2 * KW - 1), 0.02),
        'w_out_na': nrm(ks[23], (N_ODD, H_C * HD_C, d), (H_C * HD_C) ** -0.5),
        'w_mlp1': nrm(ks[24], (DEPTH, d, D_FF), d ** -0.5),
        'w_mlp2': nrm(ks[25], (DEPTH, D_FF, d), D_FF ** -0.5),
    }


def reference(x_prompt, x_sample, state_hgrn, state_gdn, cache_na_k, cache_na_v, c,
              c_ctx, ada_w, ada_b, norm_g, w_in_ab, w_out_ab, hgrn_lb, gdn_conv,
              gdn_a_log, gdn_dt_bias, gn_hgrn, gn_gdn, w_qkv_na, qn_na, kn_na, rpb_na,
              w_out_na, w_mlp1, w_mlp2):
    xp, xs = x_prompt, x_sample
    bp = xp.shape[0]
    lbs = jnp.cumsum(jax.nn.softmax(hgrn_lb.astype(jnp.float32), axis=0), axis=0)
    new_hgrn, new_gdn, new_k, new_v = [], [], [], []
    for l in range(DEPTH):
        p_sh1, p_sc1, p_g1, p_sh2, p_sc2, p_g2 = _modulation(c_ctx[None, :], ada_w[l], ada_b[l])
        s_sh1, s_sc1, s_g1, s_sh2, s_sc2, s_g2 = _modulation(c, ada_w[l], ada_b[l])
        hp = _rmsnorm(xp, norm_g[l, 0]) * (1.0 + p_sc1) + p_sh1
        hs = _rmsnorm(xs, norm_g[l, 0]) * (1.0 + s_sc1) + s_sh1
        if l % 2 == 0:
            e = l // 2
            w = (w_in_ab[e], w_out_ab[e], lbs[l], gdn_conv[e], gdn_a_log[e], gdn_dt_bias[e], gn_hgrn[e], gn_gdn[e])
            zh = jnp.zeros((bp, 2, H_A, DK_A, DV_A), jnp.float32)
            zg = jnp.zeros((bp, 2, H_B, DK_B, DV_B), jnp.float32)
            mp, sh_new, sg_new = _mixer_ab(hp, *w, zh, zg)
            ms, _, _ = _mixer_ab(hs, *w, state_hgrn[:, e], state_gdn[:, e])
            new_hgrn.append(sh_new)
            new_gdn.append(sg_new)
        else:
            o = l // 2
            qp, kp, vp = _na_qkv(hp, w_qkv_na[o], qn_na[o], kn_na[o])
            mp = _merge(_ctx_attention(qp, kp, vp)) @ w_out_na[o]
            qs, ks_, vs = _na_qkv(hs, w_qkv_na[o], qn_na[o], kn_na[o])
            ms = _merge(_na_latent(qs, ks_, vs, cache_na_k[:, o], cache_na_v[:, o], rpb_na[o])) @ w_out_na[o]
            new_k.append(kp)
            new_v.append(vp)
        xp = xp + p_g1 * mp
        xs = xs + s_g1 * ms
        hp = _rmsnorm(xp, norm_g[l, 1]) * (1.0 + p_sc2) + p_sh2
        hs = _rmsnorm(xs, norm_g[l, 1]) * (1.0 + s_sc2) + s_sh2
        xp = xp + p_g2 * _mlp(hp, w_mlp1[l], w_mlp2[l])
        xs = xs + s_g2 * _mlp(hs, w_mlp1[l], w_mlp2[l])
    return (xp, xs, jnp.stack(new_hgrn, axis=1), jnp.stack(new_gdn, axis=1),
            jnp.stack(new_k, axis=1), jnp.stack(new_v, axis=1))
```

```cpp
#include <hip/hip_runtime.h>
#include <hip/hip_cooperative_groups.h>
#include <cstdint>
#include <cstdio>
namespace cg = cooperative_groups;
namespace pg8 {
#define PG8_LAS __attribute__((address_space(3)))
typedef unsigned short bf16_t;
typedef short bf16x8 __attribute__((ext_vector_type(8)));
typedef float f32x4 __attribute__((ext_vector_type(4)));
typedef unsigned u32x4 __attribute__((ext_vector_type(4)));
constexpr int BM = 256, BK = 64, HALF = 128, HTB = HALF * BK * 2  , STAGE_BYTES = 8 * HTB, NXCD = 8, WGM = 8;

__host__ __device__ __forceinline__ int lds_byte(int r, int c) { const int st = (r >> 4) * 2 + (c >> 5), rr = r & 15, cc = c & 31, ob = rr * 64 + cc * 2; return st * 1024 + (ob ^ (((ob >> 9) & 1) << 5)); }
__host__ __device__ __forceinline__ void stage_rc(int b, int& R, int& C) { const int st = b / 1024, sb = b % 1024, swz = sb ^ (((sb >> 9) & 1) << 5); R = (st >> 1) * 16 + swz / 64; C = (st & 1) * 32 + (swz % 64) / 2; }
__host__ __device__ __forceinline__ int perm32(int rho) { const int n = rho >> 4, i = rho & 15; return 8 * (i >> 2) + 4 * n + (i & 3); }

struct Unit { int pm, pn; };
struct Gemm { const bf16_t* A; const bf16_t* Bt; int M, N, K; };

struct StaticOrder {
    int nM, nN, nwg, G, c;
    __host__ __device__ void init(int M, int N, int G_, int c_) { nM = M / BM; nN = N / BM; nwg = nM * nN; G = G_; c = c_; }
    __host__ __device__ bool next(int i, Unit& u) const {
        const long L = (long)i * G + c; if (L >= nwg) return false;
        int wgid = (int)L; { const int q = nwg / NXCD, r = nwg % NXCD, xcd = wgid % NXCD, off = wgid / NXCD; wgid = (xcd < r ? xcd * (q + 1) : r * (q + 1) + (xcd - r) * q) + off; }
        const int nig = WGM * nN, gid = wgid / nig, fm = gid * WGM, gsz = (nM - fm) < WGM ? (nM - fm) : WGM;
        u.pm = fm + ((wgid % nig) % gsz); u.pn = (wgid % nig) / gsz; return true;
    }
    __device__ __forceinline__ void a_ready(const Unit&) const {}
    __device__ __forceinline__ void done(const Unit&) const {}
};
__device__ __forceinline__ unsigned cvt_pk_bf16(float lo, float hi) { unsigned r; asm volatile("v_cvt_pk_bf16_f32 %0, %1, %2" : "=v"(r) : "v"(lo), "v"(hi)); return r; }
template <int ACT  > struct EpiBf {
    static constexpr bool PERM = true, AFTER_DRAIN = false;
    bf16_t* O; int ldc;
    __device__ __forceinline__ void operator()(const f32x4 (&acc)[2][2][4][2], const Unit& u, int wr, int wc, int fr, int fq) const {
        const int row0 = u.pm * BM + wr * 64 + fr, col0 = u.pn * BM + wc * 32 + 8 * fq;
#pragma unroll
        for (int ai = 0; ai < 2; ++ai)
#pragma unroll
            for (int m = 0; m < 4; ++m) { bf16_t* rowp = O + (size_t)(row0 + ai * HALF + m * 16) * ldc + col0;
#pragma unroll
                for (int bj = 0; bj < 2; ++bj) { f32x4 v0 = acc[ai][bj][m][0], v1 = acc[ai][bj][m][1];
                    if (ACT == 1) {
#pragma unroll
                        for (int e = 0; e < 4; ++e) { const float a = v0[e] > 0.f ? v0[e] : 0.f, b = v1[e] > 0.f ? v1[e] : 0.f; v0[e] = a * a; v1[e] = b * b; } }
                    u32x4 w; w.x = cvt_pk_bf16(v0[0], v0[1]); w.y = cvt_pk_bf16(v0[2], v0[3]); w.z = cvt_pk_bf16(v1[0], v1[1]); w.w = cvt_pk_bf16(v1[2], v1[3]);
                    *(u32x4*)(rowp + bj * HALF) = w; } }
    }
};
struct EpiRes {
    static constexpr bool PERM = false, AFTER_DRAIN = false;
    float* out; const float* base_p; const float* base_s; const float* gate;
    __device__ __forceinline__ void operator()(const f32x4 (&acc)[2][2][4][2], const Unit& u, int wr, int wc, int fr, int fq) const {
        const int row0 = u.pm * BM + wr * 64 + fr, col0 = u.pn * BM + wc * 32 + 4 * fq;
        const int t0 = u.pm * BM; const int mr = t0 < 4096 ? 0 : 1 + ((t0 - 4096) >> 10);
        const float* gp = gate + (size_t)mr * 6144 + col0;
        f32x4 gv[2][2];
#pragma unroll
        for (int bj = 0; bj < 2; ++bj)
#pragma unroll
            for (int n = 0; n < 2; ++n) gv[bj][n] = *(const f32x4*)(gp + bj * HALF + n * 16);
#pragma unroll
        for (int ai = 0; ai < 2; ++ai)
#pragma unroll
            for (int m = 0; m < 4; ++m) { const int row = row0 + ai * HALF + m * 16;
                const float* bp = (row < 4096 ? base_p + (size_t)row * 1024 : base_s + (size_t)(row - 4096) * 1024) + col0; float* op = out + (size_t)row * 1024 + col0;
#pragma unroll
                for (int bj = 0; bj < 2; ++bj)
#pragma unroll
                    for (int n = 0; n < 2; ++n) { const f32x4 b = *(const f32x4*)(bp + bj * HALF + n * 16); *(f32x4*)(op + bj * HALF + n * 16) = b + gv[bj][n] * acc[ai][bj][m][n]; } }
    }
};

template <class Epi, class Sched, bool STAMP = false>
__device__ __forceinline__ void gemm_phase(PG8_LAS unsigned char* lds, const Gemm g, const Sched& S, const Epi& E, unsigned long long* stamps) {
    const int tid = threadIdx.x, wid = __builtin_amdgcn_readfirstlane(tid >> 6), lane = tid & 63, wr = wid >> 2, wc = wid & 3, fr = lane & 15, fq = lane >> 4;
    const int K = g.K, nt = K / BK;
    int ts_lo = 0, ts_hi = 0, nts = 0; const unsigned long long rt_entry = STAMP ? (unsigned long long)wall_clock64() : 0ull;
#define PG8_STAMP() do { if (STAMP && wid == 0 && nts < 64) { const unsigned long long _c = (unsigned long long)clock64(); \
        ts_lo = (lane == nts) ? (int)(unsigned)_c : ts_lo; ts_hi = (lane == nts) ? (int)(unsigned)(_c >> 32) : ts_hi; ++nts; } } while (0)
    PG8_STAMP();
    unsigned voffA[2], voffB[2];
#pragma unroll
    for (int i = 0; i < 2; ++i) { int R, C; stage_rc(tid * 16 + i * 8192, R, C); const int Rb = Epi::PERM ? ((R & ~31) + perm32(R & 31)) : R;
        voffA[i] = (unsigned)(R * K + C) * 2u; voffB[i] = (unsigned)(Rb * K + C) * 2u; }
    const size_t kstep = (size_t)(BK * 2);
    const size_t hstep = (size_t)HALF * K * 2;
    const size_t tstep = 2 * hstep;
    const unsigned ldsw = (unsigned)wid * 1024u;
    const int aoff = lds_byte(wr * 64 + fr, fq * 8), boff = lds_byte(wc * 32 + fr, fq * 8);
#define PG8_SA(b, h) (((b) * 2 + (h)) * HTB)
#define PG8_SB(b, h) ((4 + (b) * 2 + (h)) * HTB)
#define PG8_STAGE(bufoff, gbase, voff) do { _Pragma("unroll") for (int _i = 0; _i < 2; ++_i) \
        __builtin_amdgcn_global_load_lds((const unsigned*)((const char*)(gbase) + (voff)[_i]), (PG8_LAS unsigned*)(lds + (bufoff) + ldsw + _i * 8192), 16, 0, 0); } while (0)
#define PG8_LDA(dst, b, h) do { _Pragma("unroll") for (int m = 0; m < 4; ++m) _Pragma("unroll") for (int k = 0; k < 2; ++k) dst[m][k] = *(const PG8_LAS bf16x8*)(lds + PG8_SA(b, h) + aoff + m * 2048 + k * 1024); } while (0)
#define PG8_LDB(dst, b, h) do { _Pragma("unroll") for (int n = 0; n < 2; ++n) _Pragma("unroll") for (int k = 0; k < 2; ++k) dst[n][k] = *(const PG8_LAS bf16x8*)(lds + PG8_SB(b, h) + boff + n * 2048 + k * 1024); } while (0)
#define PG8_MMA(ai, bj, At, Bt) do { __builtin_amdgcn_s_setprio(1); _Pragma("unroll") for (int m = 0; m < 4; ++m) _Pragma("unroll") for (int n = 0; n < 2; ++n) _Pragma("unroll") for (int k = 0; k < 2; ++k) \
        acc[ai][bj][m][n] = __builtin_amdgcn_mfma_f32_16x16x32_bf16(Bt[n][k], At[m][k], acc[ai][bj][m][n], 0, 0, 0); __builtin_amdgcn_s_setprio(0); } while (0)
#define PG8_WAIT_V(n) asm volatile("s_waitcnt vmcnt(" #n ")" ::: "memory")
#define PG8_WAIT_L(n) asm volatile("s_waitcnt lgkmcnt(" #n ")" ::: "memory")
#define PG8_BAR __builtin_amdgcn_s_barrier()
#define PG8_SCHED __builtin_amdgcn_sched_barrier(0)
    Unit cur, nxt; int ui = 0;
    if (!S.next(0, cur)) return;
    f32x4 acc[2][2][4][2];
#pragma unroll
    for (int a = 0; a < 2; ++a)
#pragma unroll
        for (int b = 0; b < 2; ++b)
#pragma unroll
            for (int m = 0; m < 4; ++m)
#pragma unroll
                for (int n = 0; n < 2; ++n) acc[a][b][m][n] = (f32x4){0.f, 0.f, 0.f, 0.f};
    bf16x8 At[4][2], B0[2][2], B1[2][2];
    const char* cA = (const char*)g.A + (size_t)cur.pm * tstep; const char* cB = (const char*)g.Bt + (size_t)cur.pn * tstep;
    S.a_ready(cur);
    PG8_STAGE(PG8_SB(0, 0), cB, voffB); PG8_STAGE(PG8_SA(0, 0), cA, voffA); PG8_STAGE(PG8_SB(0, 1), cB + hstep, voffB); PG8_STAGE(PG8_SA(0, 1), cA + hstep, voffA);
    if (wr == 1) PG8_BAR;
    PG8_WAIT_V(4); PG8_BAR;
    PG8_STAGE(PG8_SB(1, 0), cB + kstep, voffB); PG8_STAGE(PG8_SA(1, 0), cA + kstep, voffA); PG8_STAGE(PG8_SB(1, 1), cB + hstep + kstep, voffB);
    PG8_WAIT_V(6); PG8_BAR;
    PG8_STAMP();
    for (;;) {
        const bool has_next = S.next(ui + 1, nxt);
        const char* nA = has_next ? (const char*)g.A + (size_t)nxt.pm * tstep : cA; const char* nB = has_next ? (const char*)g.Bt + (size_t)nxt.pn * tstep : cB;
        for (int t = 0; t < nt; t += 2) {
            const bool last = (t == nt - 2);
            const char* a1 = cA + (size_t)(t + 1) * kstep;
            const char* a2 = last ? nA : cA + (size_t)(t + 2) * kstep; const char* b2 = last ? nB : cB + (size_t)(t + 2) * kstep;
            const char* a3 = a2 + kstep; const char* b3 = b2 + kstep;
            if (last && has_next) S.a_ready(nxt);
            PG8_LDB(B0, 0, 0); PG8_SCHED; PG8_LDA(At, 0, 0); PG8_STAGE(PG8_SA(1, 1), a1 + hstep, voffA);
            PG8_WAIT_L(8); PG8_BAR; PG8_WAIT_L(0); PG8_MMA(0, 0, At, B0); PG8_BAR; PG8_SCHED;
            PG8_LDB(B1, 0, 1); PG8_STAGE(PG8_SB(0, 0), b2, voffB);
            PG8_BAR; PG8_WAIT_L(0); PG8_MMA(0, 1, At, B1); PG8_BAR;
            PG8_LDA(At, 0, 1); PG8_STAGE(PG8_SA(0, 0), a2, voffA);
            PG8_BAR; PG8_WAIT_L(0); PG8_MMA(1, 0, At, B0); PG8_BAR; PG8_SCHED;
            PG8_STAGE(PG8_SB(0, 1), b2 + hstep, voffB);
            PG8_WAIT_V(6); PG8_BAR; PG8_MMA(1, 1, At, B1); PG8_BAR;
            PG8_LDB(B0, 1, 0); PG8_SCHED; PG8_LDA(At, 1, 0); PG8_STAGE(PG8_SA(0, 1), a2 + hstep, voffA);
            PG8_WAIT_L(8); PG8_BAR; PG8_WAIT_L(0); PG8_MMA(0, 0, At, B0); PG8_BAR; PG8_SCHED;
            PG8_LDB(B1, 1, 1); PG8_STAGE(PG8_SB(1, 0), b3, voffB);
            PG8_BAR; PG8_WAIT_L(0); PG8_MMA(0, 1, At, B1); PG8_BAR;
            PG8_LDA(At, 1, 1); PG8_STAGE(PG8_SA(1, 0), a3, voffA);
            PG8_BAR; PG8_WAIT_L(0); PG8_MMA(1, 0, At, B0); PG8_BAR; PG8_SCHED;
            PG8_STAGE(PG8_SB(1, 1), b3 + hstep, voffB);
            PG8_WAIT_V(6); PG8_BAR; PG8_MMA(1, 1, At, B1); PG8_BAR;
        }
        PG8_STAMP();
        if constexpr (!Epi::AFTER_DRAIN) { E(acc, cur, wr, wc, fr, fq); S.done(cur); }
        PG8_STAMP();
        if (!has_next) break;
#pragma unroll
        for (int a = 0; a < 2; ++a)
#pragma unroll
            for (int b = 0; b < 2; ++b)
#pragma unroll
                for (int m = 0; m < 4; ++m)
#pragma unroll
                    for (int n = 0; n < 2; ++n) acc[a][b][m][n] = (f32x4){0.f, 0.f, 0.f, 0.f};
        cur = nxt; cA = nA; cB = nB; ++ui;
    }
    PG8_WAIT_V(0);
    if (wr == 0) PG8_BAR;
    PG8_BAR;
    if constexpr (Epi::AFTER_DRAIN) { E.fused(acc, cur, wr, wc, fr, fq, lds, wid, lane); S.done(cur); }
    PG8_STAMP();
    if (STAMP && wid == 0) { stamps[lane] = lane < nts ? (((unsigned long long)(unsigned)ts_hi << 32) | (unsigned)ts_lo) : 0ull;
        if (lane == 62) stamps[62] = rt_entry; if (lane == 63) stamps[63] = (unsigned long long)wall_clock64(); }
#undef PG8_STAMP
#undef PG8_SA
#undef PG8_SB
#undef PG8_STAGE
#undef PG8_LDA
#undef PG8_LDB
#undef PG8_MMA
#undef PG8_WAIT_V
#undef PG8_WAIT_L
#undef PG8_BAR
#undef PG8_SCHED
}
}

using pg8::bf16_t; using pg8::bf16x8; using pg8::f32x4; using pg8::u32x4;
#define LAS __attribute__((address_space(3)))
#define DI __device__ __forceinline__
typedef float f32x2 __attribute__((ext_vector_type(2)));
typedef unsigned short u16x8 __attribute__((ext_vector_type(8)));
typedef unsigned short u16x4 __attribute__((ext_vector_type(4)));

constexpr int NTOK = 8192, DM = 1024, DFF = 4096, NPROJ = 4608, NPROJ_ALL = 4624, NMOD = 6144;
constexpr int LDS_BYTES = 147456;
constexpr int GDN_PACK_B = 34880, HG_PACK_B = 18944;
constexpr size_t OFF_MOD = 0;
constexpr size_t OFF_LBS = 262144;
constexpr size_t OFF_AB = OFF_LBS + 4096;
constexpr size_t OFF_W0 = OFF_AB + (size_t)NTOK * 16 * 4;
constexpr size_t SZ_WIN = (size_t)NPROJ * DM * 2, SZ_WSQ = (size_t)DM * DM * 2, SZ_WFF = (size_t)DFF * DM * 2;
constexpr size_t OFF_H = OFF_W0 + SZ_WIN + SZ_WSQ + 2 * SZ_WFF;
constexpr size_t OFF_PROJ = OFF_H + (size_t)NTOK * DM * 2;
constexpr size_t OFF_PACK = OFF_PROJ + (size_t)NTOK * NPROJ * 2;
constexpr size_t SZ_GPACK = (size_t)2048 * GDN_PACK_B, SZ_HPACK = (size_t)2048 * HG_PACK_B;
constexpr size_t OFF_O = OFF_PACK + SZ_GPACK + SZ_HPACK;
constexpr size_t WS_NEED = OFF_O + (size_t)2 * NTOK * DM * 2;
constexpr size_t OFF_W1 = OFF_PACK;
constexpr size_t SZ_WQKV = (size_t)3072 * DM * 2;
constexpr size_t OFF_X2 = OFF_W1 + SZ_WQKV + SZ_WSQ + 2 * SZ_WFF;
static_assert(OFF_X2 + (size_t)NTOK * DM * 4 <= OFF_O, "overlay");
static_assert(WS_NEED <= 268435456ull, "workspace");

struct Params {
    const float *xp, *xs, *st_hgrn, *st_gdn, *cache_k, *cache_v, *c, *c_ctx, *ada_w, *ada_b, *norm_g, *w_in, *w_out_ab, *hgrn_lb, *gdn_conv, *a_log, *dt_bias,
        *gn_hgrn, *gn_gdn, *w_qkv, *qn, *kn, *rpb, *w_out_na, *w_mlp1, *w_mlp2;
    float* out; unsigned char* ws;
};

DI bf16_t f2bf(float f) { unsigned u = __float_as_uint(f); u += 0x7FFFu + ((u >> 16) & 1u); return (bf16_t)(u >> 16); }
DI float bf2f(bf16_t h) { return __uint_as_float((unsigned)h << 16); }
DI float sigmoidf_(float x) { return 1.0f / (1.0f + __expf(-x)); }
DI float siluf_(float x) { return x / (1.0f + __expf(-x)); }
DI float softplusf_(float x) { return x > 20.f ? x : log1pf(__expf(x)); }
DI float wave_sum(float v) { for (int o = 32; o > 0; o >>= 1) v += __shfl_xor(v, o); return v; }
DI int modrow(int tok) { return tok < 4096 ? 0 : 1 + ((tok - 4096) >> 10); }
DI const float* xrow(const Params& p, int tok) { return tok < 4096 ? p.xp + (size_t)tok * DM : p.xs + (size_t)(tok - 4096) * DM; }

DI f32x4 mma16(const LAS bf16_t* A, int lda, const LAS bf16_t* Bt, int ldb, int K, f32x4 acc) {
    const int lane = threadIdx.x & 63, r = lane & 15, q = lane >> 4;
    const LAS bf16_t* pa = A + r * lda + 8 * q; const LAS bf16_t* pb = Bt + r * ldb + 8 * q;
    for (int k0 = 0; k0 < K; k0 += 32) {
        const bf16x8 a = *(const LAS bf16x8*)(pa + k0), b = *(const LAS bf16x8*)(pb + k0);
        acc = __builtin_amdgcn_mfma_f32_16x16x32_bf16(a, b, acc, 0, 0, 0);
    }
    return acc;
}
DI void phase_mod(const Params& p, LAS unsigned char* lds) {
    LAS float* sc = (LAS float*)lds;
    LAS float* red = (LAS float*)(lds + 20480);
    const int tid = threadIdx.x;
    float* mod = (float*)(p.ws + OFF_MOD);
    for (int e = tid; e < 5 * 1024; e += 512) { const int m = e >> 10, k = e & 1023; const float v = m == 0 ? p.c_ctx[k] : p.c[(m - 1) * 1024 + k]; sc[e] = siluf_(v); }
    __syncthreads();
    for (int cb = blockIdx.x; cb < 256; cb += gridDim.x) {
        const int l = cb >> 7, n0 = (cb & 127) * 48;
        const float* W = p.ada_w + (size_t)l * 1024 * NMOD + n0;
        const int cq = tid % 12, ks = tid / 12;
        float acc[5][4];
#pragma unroll
        for (int m = 0; m < 5; ++m)
#pragma unroll
            for (int j = 0; j < 4; ++j) acc[m][j] = 0.f;
        if (ks < 42) {
            const int k0 = ks * 25, k1 = (k0 + 25 < 1024) ? k0 + 25 : 1024;
            for (int k = k0; k < k1; ++k) {
                const f32x4 w = *(const f32x4*)(W + (size_t)k * NMOD + 4 * cq);
#pragma unroll
                for (int m = 0; m < 5; ++m) { const float s = sc[m * 1024 + k];
#pragma unroll
                    for (int j = 0; j < 4; ++j) acc[m][j] += s * w[j]; }
            }
#pragma unroll
            for (int m = 0; m < 5; ++m)
#pragma unroll
                for (int j = 0; j < 4; ++j) red[(ks * 5 + m) * 48 + 4 * cq + j] = acc[m][j];
        }
        __syncthreads();
        if (tid < 240) { const int m = tid / 48, j = tid % 48; float s = 0.f; for (int k = 0; k < 42; ++k) s += red[(k * 5 + m) * 48 + j];
            mod[((size_t)l * 5 + m) * NMOD + n0 + j] = s + p.ada_b[l * NMOD + n0 + j]; }
        __syncthreads();
    }
    if (blockIdx.x == gridDim.x - 1) {
        float* lbs = (float*)(p.ws + OFF_LBS);
        const float a = p.hgrn_lb[tid], b = p.hgrn_lb[512 + tid], c = p.hgrn_lb[1024 + tid];
        const float mx = fmaxf(a, fmaxf(b, c)); const float ea = __expf(a - mx), eb = __expf(b - mx), ec = __expf(c - mx);
        lbs[tid] = ea / (ea + eb + ec);
    }
}
DI void transpose_tiles(const float* W, int K, int N, int ldw, bf16_t* Wt, int tbase, int ttotal, LAS unsigned char* lds) {
    LAS float* tile = (LAS float*)lds;
    const int tid = threadIdx.x, nk = K / 64, nn = N / 64, nt = nk * nn;
    int g = blockIdx.x; if (g < tbase) g += ((tbase - g + gridDim.x - 1) / gridDim.x) * gridDim.x;
    for (; g < tbase + nt; g += gridDim.x) {
        const int t = g - tbase, tk = t % nk, tn = t / nk, k0 = tk * 64, n0 = tn * 64;
#pragma unroll
        for (int ps = 0; ps < 2; ++ps) { const int row = (tid >> 4) + ps * 32, c4 = tid & 15;
            const f32x4 v = *(const f32x4*)(W + (size_t)(k0 + row) * ldw + n0 + 4 * c4);
            tile[row * 65 + 4 * c4 + 0] = v[0]; tile[row * 65 + 4 * c4 + 1] = v[1]; tile[row * 65 + 4 * c4 + 2] = v[2]; tile[row * 65 + 4 * c4 + 3] = v[3]; }
        __syncthreads();
        { const int n = tid >> 3, k8 = tid & 7; u32x4 w;
          w.x = pg8::cvt_pk_bf16(tile[(k8 * 8 + 0) * 65 + n], tile[(k8 * 8 + 1) * 65 + n]); w.y = pg8::cvt_pk_bf16(tile[(k8 * 8 + 2) * 65 + n], tile[(k8 * 8 + 3) * 65 + n]);
          w.z = pg8::cvt_pk_bf16(tile[(k8 * 8 + 4) * 65 + n], tile[(k8 * 8 + 5) * 65 + n]); w.w = pg8::cvt_pk_bf16(tile[(k8 * 8 + 6) * 65 + n], tile[(k8 * 8 + 7) * 65 + n]);
          *(u32x4*)(Wt + (size_t)(n0 + n) * K + k0 + k8 * 8) = w; }
        __syncthreads();
    }
    (void)ttotal;
}
DI void phase_w0(const Params& p, LAS unsigned char* lds) {
    bf16_t* w = (bf16_t*)(p.ws + OFF_W0);
    int tb = 0;
    transpose_tiles(p.w_in, 1024, NPROJ, NPROJ_ALL, w, tb, 0, lds); tb += 16 * 72;
    transpose_tiles(p.w_out_ab, 1024, 1024, 1024, w + (size_t)NPROJ * DM, tb, 0, lds); tb += 256;
    transpose_tiles(p.w_mlp1, 1024, 4096, 4096, w + (size_t)NPROJ * DM + (size_t)DM * DM, tb, 0, lds); tb += 1024;
    transpose_tiles(p.w_mlp2, 4096, 1024, 1024, w + (size_t)NPROJ * DM + (size_t)DM * DM + (size_t)DFF * DM, tb, 0, lds);
}
DI void phase_w1(const Params& p, LAS unsigned char* lds) {
    bf16_t* w = (bf16_t*)(p.ws + OFF_W1);
    int tb = 0;
    transpose_tiles(p.w_qkv, 1024, 3072, 3072, w, tb, 0, lds); tb += 16 * 48;
    transpose_tiles(p.w_out_na, 1024, 1024, 1024, w + (size_t)3072 * DM, tb, 0, lds); tb += 256;
    transpose_tiles(p.w_mlp1 + (size_t)DM * DFF, 1024, 4096, 4096, w + (size_t)3072 * DM + (size_t)DM * DM, tb, 0, lds); tb += 1024;
    transpose_tiles(p.w_mlp2 + (size_t)DFF * DM, 4096, 1024, 1024, w + (size_t)3072 * DM + (size_t)DM * DM + (size_t)DFF * DM, tb, 0, lds);
}
template <bool AB> DI void phase_norm(const Params& p, const float* srcp, const float* srcs, int l, int sub, LAS unsigned char* lds) {
    const int tid = threadIdx.x, wid = tid >> 6, lane = tid & 63;
    const float* mod = (const float*)(p.ws + OFF_MOD) + (size_t)l * 5 * NMOD;
    const float* gw = p.norm_g + (l * 2 + sub) * 1024;
    bf16_t* H = (bf16_t*)(p.ws + OFF_H);
    LAS float* wab = (LAS float*)lds;
    if (AB) { for (int e = tid; e < 1024 * 16; e += 512) { const int k = e >> 4, j = e & 15; wab[e] = p.w_in[(size_t)k * NPROJ_ALL + NPROJ + j]; } __syncthreads(); }
    float* ab = (float*)(p.ws + OFF_AB);
    for (int tok = blockIdx.x * 8 + wid; tok < NTOK; tok += gridDim.x * 8) {
        const float* xr = tok < 4096 ? srcp + (size_t)tok * 1024 : srcs + (size_t)(tok - 4096) * 1024;
        const int mr = modrow(tok);
        const float* sh = mod + (size_t)mr * NMOD + sub * 3072; const float* scp = sh + 1024;
        f32x4 x[4]; float ss = 0.f;
#pragma unroll
        for (int i = 0; i < 4; ++i) { x[i] = *(const f32x4*)(xr + i * 256 + lane * 4); ss += x[i][0] * x[i][0] + x[i][1] * x[i][1] + x[i][2] * x[i][2] + x[i][3] * x[i][3]; }
        ss = wave_sum(ss);
        const float rs = rsqrtf(ss * (1.0f / 1024.0f) + 1e-6f);
        float pa[16];
        if (AB) {
#pragma unroll
            for (int j = 0; j < 16; ++j) pa[j] = 0.f; }
#pragma unroll
        for (int i = 0; i < 4; ++i) { const int k = i * 256 + lane * 4;
            const f32x4 g4 = *(const f32x4*)(gw + k), s4 = *(const f32x4*)(scp + k), h4 = *(const f32x4*)(sh + k);
            f32x4 hv;
#pragma unroll
            for (int e = 0; e < 4; ++e) hv[e] = x[i][e] * rs * g4[e] * (1.0f + s4[e]) + h4[e];
            uint2 w; w.x = pg8::cvt_pk_bf16(hv[0], hv[1]); w.y = pg8::cvt_pk_bf16(hv[2], hv[3]);
            *(uint2*)(H + (size_t)tok * 1024 + k) = w;
            if (AB) {
#pragma unroll
                for (int e = 0; e < 4; ++e) {
#pragma unroll
                    for (int j4 = 0; j4 < 4; ++j4) { const f32x4 wv = *(const LAS f32x4*)(wab + (k + e) * 16 + 4 * j4);
                        pa[4 * j4 + 0] += hv[e] * wv[0]; pa[4 * j4 + 1] += hv[e] * wv[1]; pa[4 * j4 + 2] += hv[e] * wv[2]; pa[4 * j4 + 3] += hv[e] * wv[3]; } } }
        }
        if (AB) {
            float mine = 0.f;
#pragma unroll
            for (int j = 0; j < 16; ++j) { const float s = wave_sum(pa[j]); if (lane == j) mine = s; }
            if (lane < 16) ab[(size_t)tok * 16 + lane] = mine;
        }
    }
}
DI int chunk_seq_start(int gc) { return gc < 128 ? (gc >> 3) * 256 : 4096 + ((gc - 128) >> 5) * 1024; }
DI int chunk_seq_len(int gc) { return gc < 128 ? 256 : 1024; }
DI void gdn_prep_item(const Params& p, int gc, int h, LAS unsigned char* lds) {
    const int tid = threadIdx.x, wid = tid >> 6, lane = tid & 63;
    LAS float* qf = (LAS float*)lds; LAS float* kf = (LAS float*)(lds + 16384); LAS float* vf = (LAS float*)(lds + 32768);
    LAS bf16_t* qb = (LAS bf16_t*)(lds + 49152); LAS bf16_t* kb = (LAS bf16_t*)(lds + 57856);
    LAS float* KK = (LAS float*)(lds + 66560); LAS float* QK = (LAS float*)(lds + 70784); LAS float* Am = (LAS float*)(lds + 75008);
    LAS bf16_t* Tm = (LAS bf16_t*)(lds + 79232); LAS bf16_t* RT = (LAS bf16_t*)(lds + 81792);
    LAS float* gs = (LAS float*)(lds + 102272);
    const bf16_t* proj = (const bf16_t*)(p.ws + OFF_PROJ);
    const float* ab = (const float*)(p.ws + OFF_AB);
    const int t0 = gc * 32, sb = chunk_seq_start(gc), se = sb + chunk_seq_len(gc);
    for (int e = tid; e < 32 * 384; e += 512) {
        const int i = e / 384, c = e % 384, part = c >> 7, d = c & 127, ch = part * 512 + h * 128 + d;
        float a = 0.f;
#pragma unroll
        for (int j = 0; j < 5; ++j) { const int tk = t0 + i + j - 2; if (tk >= sb && tk < se) a += bf2f(proj[(size_t)tk * NPROJ + 2560 + ch]) * p.gdn_conv[j * 1536 + ch]; }
        const float v = siluf_(a);
        (part == 0 ? qf : part == 1 ? kf : vf)[i * 128 + d] = v;
    }
    __syncthreads();
    for (int i = wid * 4; i < wid * 4 + 4; ++i) {
        const float q0 = qf[i * 128 + lane], q1 = qf[i * 128 + 64 + lane], k0 = kf[i * 128 + lane], k1 = kf[i * 128 + 64 + lane];
        const float sq = wave_sum(q0 * q0 + q1 * q1), sk = wave_sum(k0 * k0 + k1 * k1);
        const float rq = rsqrtf(sq + 1e-6f) * 0.08838834764831845f, rk = rsqrtf(sk + 1e-6f);
        qf[i * 128 + lane] = q0 * rq; qf[i * 128 + 64 + lane] = q1 * rq; kf[i * 128 + lane] = k0 * rk; kf[i * 128 + 64 + lane] = k1 * rk;
        qb[i * 136 + lane] = f2bf(q0 * rq); qb[i * 136 + 64 + lane] = f2bf(q1 * rq); kb[i * 136 + lane] = f2bf(k0 * rk); kb[i * 136 + 64 + lane] = f2bf(k1 * rk);
    }
    __syncthreads();
    { const int w4 = wid & 3, mt = w4 >> 1, nt = w4 & 1, r = lane & 15, q = lane >> 4;
      f32x4 acc = {0.f, 0.f, 0.f, 0.f};
      acc = mma16((wid < 4 ? kb : qb) + 16 * mt * 136, 136, kb + 16 * nt * 136, 136, 128, acc);
      LAS float* D = wid < 4 ? KK : QK;
#pragma unroll
      for (int i = 0; i < 4; ++i) D[(16 * mt + 4 * q + i) * 33 + 16 * nt + r] = acc[i]; }
    __syncthreads();
    for (int dir = 0; dir < 2; ++dir) {
        bf16_t* pack = (bf16_t*)(p.ws + OFF_PACK + ((size_t)(gc * 4 + h) * 2 + dir) * GDN_PACK_B);
        if (wid == 0) {
            const int pp = lane & 31, i = dir ? 31 - pp : pp, tk = t0 + i;
            const float araw = ab[(size_t)tk * 16 + dir * 4 + h], braw = ab[(size_t)tk * 16 + 8 + dir * 4 + h];
            const float beta = sigmoidf_(braw);
            float g = -__expf(p.a_log[dir * 4 + h]) * softplusf_(araw + p.dt_bias[dir * 4 + h]);
#pragma unroll
            for (int o = 1; o < 32; o <<= 1) { const float t = __shfl_up(g, o, 32); if (pp >= o) g += t; }
            if (lane < 32) { gs[pp] = g; gs[32 + pp] = beta; }
        }
        __syncthreads();
        for (int e = tid; e < 1024; e += 512) { const int pp = e >> 5, s = e & 31, ip = dir ? 31 - pp : pp, is = dir ? 31 - s : s;
            const float dec = s <= pp ? __expf(gs[pp] - gs[s]) : 0.f;
            Am[pp * 33 + s] = s < pp ? gs[32 + pp] * KK[ip * 33 + is] * dec : 0.f;
            pack[12288 + e] = f2bf(s <= pp ? QK[ip * 33 + is] * dec : 0.f); }
        { const float gl = gs[31];
          for (int e = tid; e < 4096; e += 512) { const int pp = e >> 7, d = e & 127, ip = dir ? 31 - pp : pp;
            const float g = gs[pp], beta = gs[32 + pp], eg = __expf(g);
            const float kv = kf[ip * 128 + d], qv = qf[ip * 128 + d], vv = vf[ip * 128 + d];
            RT[d * 40 + pp] = f2bf(kv * beta * eg); RT[(128 + d) * 40 + pp] = f2bf(vv * beta);
            pack[4096 + e] = f2bf(qv * eg); pack[8192 + d * 32 + pp] = f2bf(kv * __expf(gl - g)); }
          if (tid == 0) *(float*)((unsigned char*)pack + 34816) = __expf(gl); }
        __syncthreads();
        if (wid == 0 && lane < 32) {
            float x[32];
#pragma unroll
            for (int pp = 0; pp < 32; ++pp) {
                float a = (pp == lane) ? 1.f : 0.f;
#pragma unroll
                for (int j = 0; j < pp; ++j) a -= Am[pp * 33 + j] * x[j];
                x[pp] = a; Tm[pp * 40 + lane] = f2bf(a);
            }
        }
        __syncthreads();
#pragma unroll
        for (int t = 0; t < 4; ++t) { const int id = wid * 4 + t, which = id >> 4, mt = (id >> 3) & 1, nt = id & 7, r = lane & 15, q = lane >> 4;
            f32x4 acc = {0.f, 0.f, 0.f, 0.f};
            acc = mma16(Tm + 16 * mt * 40, 40, RT + (which * 128 + 16 * nt) * 40, 40, 32, acc);
            bf16_t* dst = pack + (which ? 13312 : 0);
#pragma unroll
            for (int i = 0; i < 4; ++i) dst[(16 * mt + 4 * q + i) * 128 + 16 * nt + r] = f2bf(acc[i]); }
        __syncthreads();
    }
}
DI void hgrn_prep_item(const Params& p, int gc, int h, LAS unsigned char* lds) {
    const int tid = threadIdx.x, wid = tid >> 6, lane = tid & 63;
    LAS float* qf = (LAS float*)lds; LAS float* lg = (LAS float*)(lds + 16384); LAS float* lf = (LAS float*)(lds + 32768);
    LAS bf16_t* qt = (LAS bf16_t*)(lds + 49152); LAS bf16_t* kt = (LAS bf16_t*)(lds + 57856);
    const bf16_t* proj = (const bf16_t*)(p.ws + OFF_PROJ);
    const float* lbs = (const float*)(p.ws + OFF_LBS);
    const int t0 = gc * 32;
    for (int dir = 0; dir < 2; ++dir) {
        bf16_t* pack = (bf16_t*)(p.ws + OFF_PACK + SZ_GPACK + ((size_t)(gc * 4 + h) * 2 + dir) * HG_PACK_B);
        for (int e = tid; e < 4096; e += 512) { const int pp = e >> 7, d = e & 127, ip = dir ? 31 - pp : pp; const size_t ro = (size_t)(t0 + ip) * NPROJ;
            const float qraw = bf2f(proj[ro + h * 128 + d]), fraw = bf2f(proj[ro + 512 + dir * 512 + h * 128 + d]), lb = lbs[h * 128 + d];
            const float f = lb + (1.0f - lb) * sigmoidf_(fraw);
            lf[e] = __logf(f); qf[e] = siluf_(qraw) * 0.08838834764831845f; }
        __syncthreads();
        if (tid < 128) { float a = 0.f; for (int pp = 0; pp < 32; ++pp) { a += lf[pp * 128 + tid]; lg[pp * 128 + tid] = a; } }
        __syncthreads();
        for (int e = tid; e < 4096; e += 512) { const int pp = e >> 7, d = e & 127;
            const float g = lg[e], gl = lg[31 * 128 + d], gr = lg[15 * 128 + d], kv = 1.0f - __expf(lf[e]), qv = qf[e];
            pack[1024 + e] = f2bf(qv * __expf(g)); pack[5120 + d * 32 + pp] = f2bf(kv * __expf(gl - g));
            qt[pp * 136 + d] = f2bf(qv * __expf(g - gr)); kt[pp * 136 + d] = f2bf(kv * __expf(gr - g));
            if (pp == 31) ((float*)((unsigned char*)pack + 18432))[d] = __expf(gl); }
        __syncthreads();
        if (wid < 4) { const int mt = wid >> 1, nt = wid & 1, r = lane & 15, q = lane >> 4;
            f32x4 acc = {0.f, 0.f, 0.f, 0.f};
            acc = mma16(qt + 16 * mt * 136, 136, kt + 16 * nt * 136, 136, 128, acc);
#pragma unroll
            for (int i = 0; i < 4; ++i) { const int pp = 16 * mt + 4 * q + i, s = 16 * nt + r; pack[pp * 32 + s] = f2bf(s <= pp ? acc[i] : 0.f); } }
        __syncthreads();
    }
}
DI void phase_prep(const Params& p, LAS unsigned char* lds) {
    for (int it = blockIdx.x; it < 2048; it += gridDim.x) {
        const int mixer = it & 1, h = (it >> 1) & 3, gc = it >> 3;
        if (mixer) gdn_prep_item(p, gc, h, lds); else hgrn_prep_item(p, gc, h, lds);
    }
}
template <bool GDN> DI void scan_item(const Params& p, int s, int h, int dir, LAS unsigned char* lds) {
    const int tid = threadIdx.x, wid = tid >> 6, lane = tid & 63, r = lane & 15, q = lane >> 4, dv0 = wid * 16;
    LAS bf16_t* A0 = (LAS bf16_t*)lds; LAS bf16_t* A1 = (LAS bf16_t*)(lds + 8704); LAS bf16_t* KT = (LAS bf16_t*)(lds + 17408);
    LAS bf16_t* AT = (LAS bf16_t*)(lds + 27648); LAS bf16_t* VT = (LAS bf16_t*)(lds + 30208); LAS float* av = (LAS float*)(lds + 40448);
    LAS bf16_t* ST = (LAS bf16_t*)(lds + 40960 + wid * 4352); LAS bf16_t* VN = (LAS bf16_t*)(lds + 75776 + wid * 1280);
    const int sstart = s < 16 ? s * 256 : 4096 + (s - 16) * 1024, N = s < 16 ? 8 : 32, gc0 = sstart >> 5;
    const bf16_t* proj = (const bf16_t*)(p.ws + OFF_PROJ);
    bf16_t* O = (bf16_t*)(p.ws + OFF_O) + (size_t)dir * NTOK * DM;
    f32x4 S[8];
    if (s >= 16) { const float* st = (GDN ? p.st_gdn : p.st_hgrn) + ((size_t)((s - 16) * 2 + dir) * 4 + h) * 16384;
#pragma unroll
        for (int i = 0; i < 8; ++i)
#pragma unroll
            for (int j = 0; j < 4; ++j) S[i][j] = st[(16 * i + 4 * q + j) * 128 + dv0 + r];
    } else {
#pragma unroll
        for (int i = 0; i < 8; ++i) S[i] = (f32x4){0.f, 0.f, 0.f, 0.f}; }
#pragma unroll
    for (int i = 0; i < 8; ++i)
#pragma unroll
        for (int j = 0; j < 4; ++j) ST[r * 136 + 16 * i + 4 * q + j] = f2bf(S[i][j]);
    for (int m = 0; m < N; ++m) {
        const int n = dir ? N - 1 - m : m, gc = gc0 + n;
        const unsigned char* packb = p.ws + OFF_PACK + (GDN ? 0 : SZ_GPACK) + ((size_t)(gc * 4 + h) * 2 + dir) * (GDN ? GDN_PACK_B : HG_PACK_B);
        const bf16_t* pack = (const bf16_t*)packb;
        __syncthreads();
        { const int row = tid >> 4, c8 = (tid & 15) * 8;
          if (GDN) { *(LAS u32x4*)(A0 + row * 136 + c8) = *(const u32x4*)(pack + tid * 8); *(LAS u32x4*)(A1 + row * 136 + c8) = *(const u32x4*)(pack + 4096 + tid * 8); }
          else *(LAS u32x4*)(A0 + row * 136 + c8) = *(const u32x4*)(pack + 1024 + tid * 8);
          const int kr = tid >> 2, k8 = (tid & 3) * 8;
          *(LAS u32x4*)(KT + kr * 40 + k8) = *(const u32x4*)(pack + (GDN ? 8192 : 5120) + tid * 8);
          if (tid < 128) { const int ar = tid >> 2; *(LAS u32x4*)(AT + ar * 40 + k8) = *(const u32x4*)(pack + (GDN ? 12288 : 0) + tid * 8); }
          if (!GDN) { if (tid < 128) av[tid] = ((const float*)(packb + 18432))[tid];
              for (int e = tid; e < 4096; e += 512) { const int pp = e >> 7, d = e & 127, ip = dir ? 31 - pp : pp;
                  VT[d * 40 + pp] = proj[(size_t)(sstart + 32 * n + ip) * NPROJ + 1536 + h * 128 + d]; } } }
        __syncthreads();
        if (GDN) {
            const float egl = *(const float*)(packb + 34816);
            const bf16_t* up = pack + 13312;
#pragma unroll
            for (int mt = 0; mt < 2; ++mt) { f32x4 acc = {0.f, 0.f, 0.f, 0.f};
                acc = mma16(A0 + 16 * mt * 136, 136, ST, 136, 128, acc);
#pragma unroll
                for (int i = 0; i < 4; ++i) { const int pp = 16 * mt + 4 * q + i; VN[r * 40 + pp] = f2bf(bf2f(up[pp * 128 + dv0 + r]) - acc[i]); } }
            __syncthreads();
#pragma unroll
            for (int mt = 0; mt < 2; ++mt) { f32x4 acc = {0.f, 0.f, 0.f, 0.f};
                acc = mma16(A1 + 16 * mt * 136, 136, ST, 136, 128, acc);
                acc = mma16(AT + 16 * mt * 40, 40, VN, 40, 32, acc);
#pragma unroll
                for (int i = 0; i < 4; ++i) { const int pp = 16 * mt + 4 * q + i, ip = dir ? 31 - pp : pp;
                    O[(size_t)(sstart + 32 * n + ip) * DM + 512 + h * 128 + dv0 + r] = f2bf(acc[i]); } }
#pragma unroll
            for (int i = 0; i < 8; ++i) { S[i] = S[i] * egl; S[i] = mma16(KT + 16 * i * 40, 40, VN, 40, 32, S[i]); }
        } else {
#pragma unroll
            for (int mt = 0; mt < 2; ++mt) { f32x4 acc = {0.f, 0.f, 0.f, 0.f};
                acc = mma16(AT + 16 * mt * 40, 40, VT + dv0 * 40, 40, 32, acc);
                acc = mma16(A0 + 16 * mt * 136, 136, ST, 136, 128, acc);
#pragma unroll
                for (int i = 0; i < 4; ++i) { const int pp = 16 * mt + 4 * q + i, ip = dir ? 31 - pp : pp;
                    O[(size_t)(sstart + 32 * n + ip) * DM + h * 128 + dv0 + r] = f2bf(acc[i]); } }
#pragma unroll
            for (int i = 0; i < 8; ++i) { const f32x4 a4 = *(const LAS f32x4*)(av + 16 * i + 4 * q); S[i] = S[i] * a4; S[i] = mma16(KT + 16 * i * 40, 40, VT + dv0 * 40, 40, 32, S[i]); }
        }
        __syncthreads();
#pragma unroll
        for (int i = 0; i < 8; ++i)
#pragma unroll
            for (int j = 0; j < 4; ++j) ST[r * 136 + 16 * i + 4 * q + j] = f2bf(S[i][j]);
    }
    if (s < 16) { float* so = p.out + (size_t)NTOK * DM + (GDN ? (size_t)2097152 : 0) + ((size_t)(s * 2 + dir) * 4 + h) * 16384;
#pragma unroll
        for (int i = 0; i < 8; ++i)
#pragma unroll
            for (int j = 0; j < 4; ++j) so[(16 * i + 4 * q + j) * 128 + dv0 + r] = S[i][j]; }
    __syncthreads();
}
DI void scan_dispatch(const Params& p, int it, LAS unsigned char* lds) {
    int mixer, dir, h, s;
    if (it < 64) { mixer = it & 1; dir = (it >> 1) & 1; h = (it >> 2) & 3; s = 16 + (it >> 4); }
    else { const int si = it - 64; mixer = si & 1; dir = (si >> 1) & 1; h = (si >> 2) & 3; s = si >> 4; }
    if (mixer) scan_item<true>(p, s, h, dir, lds); else scan_item<false>(p, s, h, dir, lds);
}
DI void phase_scan(const Params& p, LAS unsigned char* lds) {
    const int b = blockIdx.x, G = gridDim.x;
    if (G == 256) { scan_dispatch(p, b, lds); if (b >= 64 && b < 128) scan_dispatch(p, 256 + b - 64, lds); }
    else for (int it = b; it < 320; it += G) scan_dispatch(p, it, lds);
}
DI void phase_combine(const Params& p) {
    const int tid = threadIdx.x, wid = tid >> 6, lane = tid & 63;
    const bf16_t* O0 = (const bf16_t*)(p.ws + OFF_O); const bf16_t* O1 = O0 + (size_t)NTOK * DM;
    const bf16_t* proj = (const bf16_t*)(p.ws + OFF_PROJ);
    bf16_t* H = (bf16_t*)(p.ws + OFF_H);
    const int mixer = lane >> 5, d0 = (lane & 7) * 16, gcol = (mixer ? 4096 : 2048) + ((16 * lane) & 511);
    const float* gn = (mixer ? p.gn_gdn : p.gn_hgrn) + d0;
    for (int tok = blockIdx.x * 8 + wid; tok < NTOK; tok += gridDim.x * 8) {
        const u16x8 a0 = *(const u16x8*)(O0 + (size_t)tok * DM + 16 * lane), a1 = *(const u16x8*)(O0 + (size_t)tok * DM + 16 * lane + 8);
        const u16x8 b0 = *(const u16x8*)(O1 + (size_t)tok * DM + 16 * lane), b1 = *(const u16x8*)(O1 + (size_t)tok * DM + 16 * lane + 8);
        const u16x8 g0 = *(const u16x8*)(proj + (size_t)tok * NPROJ + gcol), g1 = *(const u16x8*)(proj + (size_t)tok * NPROJ + gcol + 8);
        float v[16]; float ss = 0.f;
#pragma unroll
        for (int j = 0; j < 8; ++j) { v[j] = bf2f(a0[j]) + bf2f(b0[j]); v[8 + j] = bf2f(a1[j]) + bf2f(b1[j]); }
#pragma unroll
        for (int j = 0; j < 16; ++j) ss += v[j] * v[j];
        ss += __shfl_xor(ss, 1); ss += __shfl_xor(ss, 2); ss += __shfl_xor(ss, 4);
        const float rs = rsqrtf(ss * (1.0f / 128.0f) + 1e-6f);
        unsigned w[8];
#pragma unroll
        for (int j = 0; j < 8; ++j) { const float ga = bf2f(j < 4 ? g0[2 * j] : g1[2 * j - 8]), gb = bf2f(j < 4 ? g0[2 * j + 1] : g1[2 * j - 7]);
            w[j] = pg8::cvt_pk_bf16(v[2 * j] * rs * gn[2 * j] * siluf_(ga), v[2 * j + 1] * rs * gn[2 * j + 1] * siluf_(gb)); }
        *(u32x4*)(H + (size_t)tok * DM + 16 * lane) = (u32x4){w[0], w[1], w[2], w[3]};
        *(u32x4*)(H + (size_t)tok * DM + 16 * lane + 8) = (u32x4){w[4], w[5], w[6], w[7]};
    }
}
DI void phase_qknorm(const Params& p) {
    const int tid = threadIdx.x, wid = tid >> 6, lane = tid & 63;
    const bf16_t* QKV = (const bf16_t*)(p.ws + OFF_PROJ);
    bf16_t* QN = (bf16_t*)(p.ws + OFF_O); bf16_t* KN = QN + (size_t)NTOK * DM;
    float* ck = p.out + (size_t)NTOK * DM + 2 * 2097152; float* cv = ck + 4194304;
    const int hd = lane >> 2, d0 = (lane & 3) * 16;
    for (int tok = blockIdx.x * 8 + wid; tok < NTOK; tok += gridDim.x * 8) {
#pragma unroll
        for (int part = 0; part < 2; ++part) {
            const bf16_t* src = QKV + (size_t)tok * 3072 + part * 1024 + 16 * lane;
            const u16x8 a0 = *(const u16x8*)src, a1 = *(const u16x8*)(src + 8);
            float v[16]; float ss = 0.f;
#pragma unroll
            for (int j = 0; j < 8; ++j) { v[j] = bf2f(a0[j]); v[8 + j] = bf2f(a1[j]); }
#pragma unroll
            for (int j = 0; j < 16; ++j) ss += v[j] * v[j];
            ss += __shfl_xor(ss, 1); ss += __shfl_xor(ss, 2);
            const float rs = rsqrtf(ss * (1.0f / 64.0f) + 1e-6f);
            const float* gw = (part ? p.kn : p.qn) + d0;
#pragma unroll
            for (int j = 0; j < 16; ++j) v[j] = v[j] * rs * gw[j];
            unsigned w[8];
#pragma unroll
            for (int j = 0; j < 8; ++j) w[j] = pg8::cvt_pk_bf16(v[2 * j], v[2 * j + 1]);
            bf16_t* dst = (part ? KN : QN) + (size_t)tok * DM + 16 * lane;
            *(u32x4*)dst = (u32x4){w[0], w[1], w[2], w[3]}; *(u32x4*)(dst + 8) = (u32x4){w[4], w[5], w[6], w[7]};
            if (part == 1 && tok < 4096) { float* o = ck + (((size_t)(tok >> 8) * 16 + hd) * 256 + (tok & 255)) * 64 + d0;
#pragma unroll
                for (int j4 = 0; j4 < 4; ++j4) *(f32x4*)(o + 4 * j4) = (f32x4){v[4 * j4], v[4 * j4 + 1], v[4 * j4 + 2], v[4 * j4 + 3]}; }
        }
        if (tok < 4096) { const bf16_t* src = QKV + (size_t)tok * 3072 + 2048 + 16 * lane;
            const u16x8 a0 = *(const u16x8*)src, a1 = *(const u16x8*)(src + 8);
            float* o = cv + (((size_t)(tok >> 8) * 16 + hd) * 256 + (tok & 255)) * 64 + d0;
            *(f32x4*)(o) = (f32x4){bf2f(a0[0]), bf2f(a0[1]), bf2f(a0[2]), bf2f(a0[3])}; *(f32x4*)(o + 4) = (f32x4){bf2f(a0[4]), bf2f(a0[5]), bf2f(a0[6]), bf2f(a0[7])};
            *(f32x4*)(o + 8) = (f32x4){bf2f(a1[0]), bf2f(a1[1]), bf2f(a1[2]), bf2f(a1[3])}; *(f32x4*)(o + 12) = (f32x4){bf2f(a1[4]), bf2f(a1[5]), bf2f(a1[6]), bf2f(a1[7])}; }
    }
}
struct AttnState { f32x4 o[4]; float m[4], l[4]; };
DI void attn_block(AttnState& st, const LAS bf16_t* QW, LAS bf16_t* PW, const LAS bf16_t* KB, const LAS bf16_t* VTb, f32x4 (&sc)[4]) {
    const int lane = threadIdx.x & 63, r = lane & 15, q = lane >> 4;
    float alpha[4];
#pragma unroll
    for (int i = 0; i < 4; ++i) {
        float mx = fmaxf(fmaxf(sc[0][i], sc[1][i]), fmaxf(sc[2][i], sc[3][i]));
        mx = fmaxf(mx, __shfl_xor(mx, 1)); mx = fmaxf(mx, __shfl_xor(mx, 2)); mx = fmaxf(mx, __shfl_xor(mx, 4)); mx = fmaxf(mx, __shfl_xor(mx, 8));
        const float mn = fmaxf(st.m[i], mx); alpha[i] = __expf(st.m[i] - mn); st.m[i] = mn;
        float rsum = 0.f;
#pragma unroll
        for (int n = 0; n < 4; ++n) { const float pv = __expf(sc[n][i] - mn); rsum += pv; PW[(4 * q + i) * 72 + 16 * n + r] = f2bf(pv); }
        rsum += __shfl_xor(rsum, 1); rsum += __shfl_xor(rsum, 2); rsum += __shfl_xor(rsum, 4); rsum += __shfl_xor(rsum, 8);
        st.l[i] = st.l[i] * alpha[i] + rsum;
    }
#pragma unroll
    for (int dt = 0; dt < 4; ++dt) {
#pragma unroll
        for (int i = 0; i < 4; ++i) st.o[dt][i] *= alpha[i]; }
    (void)QW; (void)KB; (void)VTb;
}
DI void attn_pv(AttnState& st, const LAS bf16_t* PW, const LAS bf16_t* VTb) {
#pragma unroll
    for (int dt = 0; dt < 4; ++dt) st.o[dt] = mma16(PW, 72, VTb + 16 * dt * 72, 72, 64, st.o[dt]);
}
DI void phase_attn(const Params& p, LAS unsigned char* lds) {
    const int tid = threadIdx.x, wid = tid >> 6, lane = tid & 63, r = lane & 15, q = lane >> 4;
    LAS bf16_t* KB = (LAS bf16_t*)lds; LAS bf16_t* VTb = (LAS bf16_t*)(lds + 9216);
    LAS bf16_t* QW = (LAS bf16_t*)(lds + 18432 + wid * 2304); LAS bf16_t* PW = (LAS bf16_t*)(lds + 36864 + wid * 2304);
    const bf16_t* QN = (const bf16_t*)(p.ws + OFF_O); const bf16_t* KN = QN + (size_t)NTOK * DM;
    const bf16_t* QKV = (const bf16_t*)(p.ws + OFF_PROJ);
    bf16_t* AO = (bf16_t*)(p.ws + OFF_H);
    for (int it = blockIdx.x; it < 1024; it += gridDim.x) {
        const bool latent = it >= 512; const int id = it & 511;
        int h, qtok0;
        int b = 0, r0 = 0, rw = 0, ct = 0, nblk;
        if (!latent) { b = id >> 5; h = (id >> 1) & 15; const int qb = id & 1; qtok0 = b * 256 + qb * 128 + wid * 16; nblk = 4; }
        else { b = id >> 7; h = (id >> 3) & 15; const int rp = id & 7; r0 = 2 * rp; rw = r0 + (wid >> 2); ct = wid & 3; qtok0 = 4096 + b * 1024 + rw * 64 + ct * 16; nblk = 0; }
        __syncthreads();
        { const int row = lane >> 2, c16 = (lane & 3) * 16; const bf16_t* src = QN + (size_t)(qtok0 + row) * DM + h * 64 + c16;
          *(LAS u32x4*)(QW + row * 72 + c16) = *(const u32x4*)src; *(LAS u32x4*)(QW + row * 72 + c16 + 8) = *(const u32x4*)(src + 8); }
        AttnState st;
#pragma unroll
        for (int i = 0; i < 4; ++i) { st.o[i] = (f32x4){0.f, 0.f, 0.f, 0.f}; st.m[i] = -1e30f; st.l[i] = 0.f; }
        int rsA = 0, rsW = 0, nwin = 0;
        if (latent) { rsA = r0 - 4 < 0 ? 0 : (r0 - 4 > 8 ? 8 : r0 - 4); const int r1 = r0 + 1; const int rsB = r1 - 4 < 0 ? 0 : (r1 - 4 > 8 ? 8 : r1 - 4);
            rsW = (wid >> 2) ? rsB : rsA; nwin = rsB + 8 - rsA; nblk = nwin + 4; }
        for (int kb = 0; kb < nblk; ++kb) {
            __syncthreads();
            { const int row = tid >> 3, c8 = (tid & 7) * 8;
              u32x4 kv4, vv4;
              if (!latent || kb < nwin) {
                  const int ktok = !latent ? b * 256 + kb * 64 + row : 4096 + b * 1024 + (rsA + kb) * 64 + row;
                  kv4 = *(const u32x4*)(KN + (size_t)ktok * DM + h * 64 + c8); vv4 = *(const u32x4*)(QKV + (size_t)ktok * 3072 + 2048 + h * 64 + c8);
              } else {
                  const size_t co = (((size_t)b * 16 + h) * 256 + (kb - nwin) * 64 + row) * 64 + c8;
                  const f32x4 k0 = *(const f32x4*)(p.cache_k + co), k1 = *(const f32x4*)(p.cache_k + co + 4), v0 = *(const f32x4*)(p.cache_v + co), v1 = *(const f32x4*)(p.cache_v + co + 4);
                  kv4 = (u32x4){pg8::cvt_pk_bf16(k0[0], k0[1]), pg8::cvt_pk_bf16(k0[2], k0[3]), pg8::cvt_pk_bf16(k1[0], k1[1]), pg8::cvt_pk_bf16(k1[2], k1[3])};
                  vv4 = (u32x4){pg8::cvt_pk_bf16(v0[0], v0[1]), pg8::cvt_pk_bf16(v0[2], v0[3]), pg8::cvt_pk_bf16(v1[0], v1[1]), pg8::cvt_pk_bf16(v1[2], v1[3])};
              }
              *(LAS u32x4*)(KB + row * 72 + c8) = kv4;
#pragma unroll
              for (int j = 0; j < 4; ++j) { VTb[(c8 + 2 * j) * 72 + row] = (bf16_t)(vv4[j] & 0xFFFFu); VTb[(c8 + 2 * j + 1) * 72 + row] = (bf16_t)(vv4[j] >> 16); } }
            __syncthreads();
            bool active = true; int krow = 0;
            if (latent && kb < nwin) { krow = rsA + kb; active = (krow >= rsW) && (krow < rsW + 8); }
            if (active) {
                f32x4 sc[4];
#pragma unroll
                for (int n = 0; n < 4; ++n) { sc[n] = (f32x4){0.f, 0.f, 0.f, 0.f}; sc[n] = mma16(QW, 72, KB + 16 * n * 72, 72, 64, sc[n]); }
                if (latent && kb < nwin) {
                    const float* rp = p.rpb + ((size_t)h * 15 + (krow - rw + 7)) * 31;
#pragma unroll
                    for (int n = 0; n < 4; ++n)
#pragma unroll
                        for (int i = 0; i < 4; ++i) { const int c = ct * 16 + 4 * q + i, kc = 16 * n + r; const int cs = c - 8 < 0 ? 0 : (c - 8 > 48 ? 48 : c - 8);
                            const bool valid = kc >= cs && kc < cs + 16;
                            sc[n][i] = valid ? sc[n][i] * 0.125f + rp[kc - c + 15 < 0 ? 0 : (kc - c + 15 > 30 ? 30 : kc - c + 15)] : -1e30f; }
                } else {
#pragma unroll
                    for (int n = 0; n < 4; ++n) sc[n] = sc[n] * 0.125f; }
                attn_block(st, QW, PW, KB, VTb, sc);
            }
            __syncthreads();
            if (active) attn_pv(st, PW, VTb);
        }
#pragma unroll
        for (int dt = 0; dt < 4; ++dt)
#pragma unroll
            for (int i = 0; i < 4; ++i) AO[(size_t)(qtok0 + 4 * q + i) * DM + h * 64 + 16 * dt + r] = f2bf(st.o[dt][i] / st.l[i]);
    }
}
template <class Epi> DI void gemm(LAS unsigned char* lds, const bf16_t* A, const bf16_t* Bt, int N, int K, const Epi& E) {
    pg8::Gemm g; g.A = A; g.Bt = Bt; g.M = NTOK; g.N = N; g.K = K;
    pg8::StaticOrder S; S.init(NTOK, N, gridDim.x, blockIdx.x);
    pg8::gemm_phase<Epi, pg8::StaticOrder, false>(lds, g, S, E, nullptr);
}
#define LAST_PHASE 99
#ifndef LAST_PHASE
#define LAST_PHASE 99
#endif
#define GSYNC(n) do { if (LAST_PHASE < (n)) return; grid.sync(); } while (0)
extern __shared__ __attribute__((aligned(16))) unsigned char smem_dyn[];
__global__ void __launch_bounds__(512, 2) fwd_megakernel(Params p) {
    cg::grid_group grid = cg::this_grid();
    LAS unsigned char* lds = (LAS unsigned char*)smem_dyn;
    unsigned char* ws = p.ws;
    const float* mod = (const float*)(ws + OFF_MOD);
    bf16_t* H = (bf16_t*)(ws + OFF_H);
    bf16_t* W0 = (bf16_t*)(ws + OFF_W0); bf16_t* W1 = (bf16_t*)(ws + OFF_W1);
    bf16_t* PROJ = (bf16_t*)(ws + OFF_PROJ);
    float* X1 = p.out;
    float* X2 = (float*)(ws + OFF_X2);
    phase_mod(p, lds); __syncthreads(); phase_w0(p, lds);
    GSYNC(1);
    phase_norm<true>(p, p.xp, p.xs, 0, 0, lds);
    GSYNC(2);
    { pg8::EpiBf<0> E; E.O = PROJ; E.ldc = NPROJ; gemm(lds, H, W0, NPROJ, 1024, E); }
    GSYNC(3);
    phase_prep(p, lds);
    GSYNC(4);
    phase_scan(p, lds);
    GSYNC(5);
    phase_combine(p); __syncthreads(); phase_w1(p, lds);
    GSYNC(6);
    { pg8::EpiRes E; E.out = X1; E.base_p = p.xp; E.base_s = p.xs; E.gate = mod + 2048; gemm(lds, H, W0 + (size_t)NPROJ * DM, 1024, 1024, E); }
    GSYNC(7);
    phase_norm<false>(p, X1, X1 + (size_t)4096 * DM, 0, 1, lds);
    GSYNC(8);
    { pg8::EpiBf<1> E; E.O = PROJ; E.ldc = DFF; gemm(lds, H, W0 + (size_t)NPROJ * DM + (size_t)DM * DM, DFF, 1024, E); }
    GSYNC(9);
    { pg8::EpiRes E; E.out = X2; E.base_p = X1; E.base_s = X1 + (size_t)4096 * DM; E.gate = mod + 5120; gemm(lds, PROJ, W0 + (size_t)NPROJ * DM + (size_t)DM * DM + (size_t)DFF * DM, 1024, DFF, E); }
    GSYNC(10);
    phase_norm<false>(p, X2, X2 + (size_t)4096 * DM, 1, 0, lds);
    GSYNC(11);
    { pg8::EpiBf<0> E; E.O = PROJ; E.ldc = 3072; gemm(lds, H, W1, 3072, 1024, E); }
    GSYNC(12);
    phase_qknorm(p);
    GSYNC(13);
    phase_attn(p, lds);
    GSYNC(14);
    { pg8::EpiRes E; E.out = X1; E.base_p = X2; E.base_s = X2 + (size_t)4096 * DM; E.gate = mod + 5 * NMOD + 2048; gemm(lds, H, W1 + (size_t)3072 * DM, 1024, 1024, E); }
    GSYNC(15);
    phase_norm<false>(p, X1, X1 + (size_t)4096 * DM, 1, 1, lds);
    GSYNC(16);
    { pg8::EpiBf<1> E; E.O = PROJ; E.ldc = DFF; gemm(lds, H, W1 + (size_t)3072 * DM + (size_t)DM * DM, DFF, 1024, E); }
    GSYNC(17);
    { pg8::EpiRes E; E.out = X1; E.base_p = X1; E.base_s = X1 + (size_t)4096 * DM; E.gate = mod + 5 * NMOD + 5120; gemm(lds, PROJ, W1 + (size_t)3072 * DM + (size_t)DM * DM + (size_t)DFF * DM, 1024, DFF, E); }
}

extern "C" void kernel_launch(void* const* d_in, const int* in_sizes, int n_in, void* d_out, int out_size, void* d_ws, size_t ws_size, hipStream_t stream) {
    (void)in_sizes; (void)n_in; (void)out_size;
    static int grid_blocks = 0;
    if (!grid_blocks) {
        int dev = 0, cus = 0, per_cu = 0;
        (void)hipGetDevice(&dev);
        (void)hipDeviceGetAttribute(&cus, hipDeviceAttributeMultiprocessorCount, dev);
        (void)hipFuncSetAttribute((const void*)fwd_megakernel, hipFuncAttributeMaxDynamicSharedMemorySize, LDS_BYTES);
        (void)hipOccupancyMaxActiveBlocksPerMultiprocessor(&per_cu, fwd_megakernel, 512, LDS_BYTES);
        if (per_cu > 1) per_cu = 1;
        grid_blocks = cus * per_cu;
        if (ws_size < WS_NEED) fprintf(stderr, "workspace too small: %zu < %zu\n", ws_size, (size_t)WS_NEED);
    }
    Params p{};
    const float* const* in = (const float* const*)d_in;
    p.xp = in[0]; p.xs = in[1]; p.st_hgrn = in[2]; p.st_gdn = in[3]; p.cache_k = in[4]; p.cache_v = in[5]; p.c = in[6]; p.c_ctx = in[7]; p.ada_w = in[8]; p.ada_b = in[9];
    p.norm_g = in[10]; p.w_in = in[11]; p.w_out_ab = in[12]; p.hgrn_lb = in[13]; p.gdn_conv = in[14]; p.a_log = in[15]; p.dt_bias = in[16]; p.gn_hgrn = in[17]; p.gn_gdn = in[18];
    p.w_qkv = in[19]; p.qn = in[20]; p.kn = in[21]; p.rpb = in[22]; p.w_out_na = in[23]; p.w_mlp1 = in[24]; p.w_mlp2 = in[25];
    p.out = (float*)d_out; p.ws = (unsigned char*)d_ws;
    void* args[] = {&p};
    hipError_t e = hipLaunchCooperativeKernel((const void*)fwd_megakernel, dim3(grid_blocks), dim3(512), args, LDS_BYTES, stream);
    if (e != hipSuccess) fprintf(stderr, "cooperative launch failed: %s (grid %d)\n", hipGetErrorString(e), grid_blocks);
}
```

```cpp
#include <hip/hip_runtime.h>
#include <hip/hip_cooperative_groups.h>
#include <cstdint>
#include <cstdio>
namespace cg = cooperative_groups;
namespace pg8 {
#define PG8_LAS __attribute__((address_space(3)))
typedef unsigned short bf16_t;
typedef short bf16x8 __attribute__((ext_vector_type(8)));
typedef float f32x4 __attribute__((ext_vector_type(4)));
typedef unsigned u32x4 __attribute__((ext_vector_type(4)));
constexpr int BM = 256, BK = 64, HALF = 128, HTB = HALF * BK * 2  , STAGE_BYTES = 8 * HTB, NXCD = 8, WGM = 8;

__host__ __device__ __forceinline__ int lds_byte(int r, int c) { const int st = (r >> 4) * 2 + (c >> 5), rr = r & 15, cc = c & 31, ob = rr * 64 + cc * 2; return st * 1024 + (ob ^ (((ob >> 9) & 1) << 5)); }
__host__ __device__ __forceinline__ void stage_rc(int b, int& R, int& C) { const int st = b / 1024, sb = b % 1024, swz = sb ^ (((sb >> 9) & 1) << 5); R = (st >> 1) * 16 + swz / 64; C = (st & 1) * 32 + (swz % 64) / 2; }
__host__ __device__ __forceinline__ int perm32(int rho) { const int n = rho >> 4, i = rho & 15; return 8 * (i >> 2) + 4 * n + (i & 3); }

struct Unit { int pm, pn; };
struct Gemm { const bf16_t* A; const bf16_t* Bt; int M, N, K; };

struct StaticOrder {
    int nM, nN, nwg, G, c;
    __host__ __device__ void init(int M, int N, int G_, int c_) { nM = M / BM; nN = N / BM; nwg = nM * nN; G = G_; c = c_; }
    __host__ __device__ bool next(int i, Unit& u) const {
        const long L = (long)i * G + c; if (L >= nwg) return false;
        int wgid = (int)L; { const int q = nwg / NXCD, r = nwg % NXCD, xcd = wgid % NXCD, off = wgid / NXCD; wgid = (xcd < r ? xcd * (q + 1) : r * (q + 1) + (xcd - r) * q) + off; }
        const int nig = WGM * nN, gid = wgid / nig, fm = gid * WGM, gsz = (nM - fm) < WGM ? (nM - fm) : WGM;
        u.pm = fm + ((wgid % nig) % gsz); u.pn = (wgid % nig) / gsz; return true;
    }
    __device__ __forceinline__ void a_ready(const Unit&) const {}
    __device__ __forceinline__ void done(const Unit&) const {}
};
__device__ __forceinline__ unsigned cvt_pk_bf16(float lo, float hi) { unsigned r; asm volatile("v_cvt_pk_bf16_f32 %0, %1, %2" : "=v"(r) : "v"(lo), "v"(hi)); return r; }
template <int ACT  > struct EpiBf {
    static constexpr bool PERM = true, AFTER_DRAIN = false;
    bf16_t* O; int ldc;
    __device__ __forceinline__ void operator()(const f32x4 (&acc)[2][2][4][2], const Unit& u, int wr, int wc, int fr, int fq) const {
        const int row0 = u.pm * BM + wr * 64 + fr, col0 = u.pn * BM + wc * 32 + 8 * fq;
#pragma unroll
        for (int ai = 0; ai < 2; ++ai)
#pragma unroll
            for (int m = 0; m < 4; ++m) { bf16_t* rowp = O + (size_t)(row0 + ai * HALF + m * 16) * ldc + col0;
#pragma unroll
                for (int bj = 0; bj < 2; ++bj) { f32x4 v0 = acc[ai][bj][m][0], v1 = acc[ai][bj][m][1];
                    if (ACT == 1) {
#pragma unroll
                        for (int e = 0; e < 4; ++e) { const float a = v0[e] > 0.f ? v0[e] : 0.f, b = v1[e] > 0.f ? v1[e] : 0.f; v0[e] = a * a; v1[e] = b * b; } }
                    u32x4 w; w.x = cvt_pk_bf16(v0[0], v0[1]); w.y = cvt_pk_bf16(v0[2], v0[3]); w.z = cvt_pk_bf16(v1[0], v1[1]); w.w = cvt_pk_bf16(v1[2], v1[3]);
                    *(u32x4*)(rowp + bj * HALF) = w; } }
    }
};
struct EpiRes {
    static constexpr bool PERM = false, AFTER_DRAIN = false;
    float* out; const float* base_p; const float* base_s; const float* gate;
    __device__ __forceinline__ void operator()(const f32x4 (&acc)[2][2][4][2], const Unit& u, int wr, int wc, int fr, int fq) const {
        const int row0 = u.pm * BM + wr * 64 + fr, col0 = u.pn * BM + wc * 32 + 4 * fq;
        const int t0 = u.pm * BM; const int mr = t0 < 4096 ? 0 : 1 + ((t0 - 4096) >> 10);
        const float* gp = gate + (size_t)mr * 6144 + col0;
        f32x4 gv[2][2];
#pragma unroll
        for (int bj = 0; bj < 2; ++bj)
#pragma unroll
            for (int n = 0; n < 2; ++n) gv[bj][n] = *(const f32x4*)(gp + bj * HALF + n * 16);
#pragma unroll
        for (int ai = 0; ai < 2; ++ai)
#pragma unroll
            for (int m = 0; m < 4; ++m) { const int row = row0 + ai * HALF + m * 16;
                const float* bp = (row < 4096 ? base_p + (size_t)row * 1024 : base_s + (size_t)(row - 4096) * 1024) + col0; float* op = out + (size_t)row * 1024 + col0;
#pragma unroll
                for (int bj = 0; bj < 2; ++bj)
#pragma unroll
                    for (int n = 0; n < 2; ++n) { const f32x4 b = *(const f32x4*)(bp + bj * HALF + n * 16); *(f32x4*)(op + bj * HALF + n * 16) = b + gv[bj][n] * acc[ai][bj][m][n]; } }
    }
};

template <class Epi, class Sched, bool STAMP = false>
__device__ __forceinline__ void gemm_phase(PG8_LAS unsigned char* lds, const Gemm g, const Sched& S, const Epi& E, unsigned long long* stamps) {
    const int tid = threadIdx.x, wid = __builtin_amdgcn_readfirstlane(tid >> 6), lane = tid & 63, wr = wid >> 2, wc = wid & 3, fr = lane & 15, fq = lane >> 4;
    const int K = g.K, nt = K / BK;
    int ts_lo = 0, ts_hi = 0, nts = 0; const unsigned long long rt_entry = STAMP ? (unsigned long long)wall_clock64() : 0ull;
#define PG8_STAMP() do { if (STAMP && wid == 0 && nts < 64) { const unsigned long long _c = (unsigned long long)clock64(); \
        ts_lo = (lane == nts) ? (int)(unsigned)_c : ts_lo; ts_hi = (lane == nts) ? (int)(unsigned)(_c >> 32) : ts_hi; ++nts; } } while (0)
    PG8_STAMP();
    unsigned voffA[2], voffB[2];
#pragma unroll
    for (int i = 0; i < 2; ++i) { int R, C; stage_rc(tid * 16 + i * 8192, R, C); const int Rb = Epi::PERM ? ((R & ~31) + perm32(R & 31)) : R;
        voffA[i] = (unsigned)(R * K + C) * 2u; voffB[i] = (unsigned)(Rb * K + C) * 2u; }
    const size_t kstep = (size_t)(BK * 2);
    const size_t hstep = (size_t)HALF * K * 2;
    const size_t tstep = 2 * hstep;
    const unsigned ldsw = (unsigned)wid * 1024u;
    const int aoff = lds_byte(wr * 64 + fr, fq * 8), boff = lds_byte(wc * 32 + fr, fq * 8);
#define PG8_SA(b, h) (((b) * 2 + (h)) * HTB)
#define PG8_SB(b, h) ((4 + (b) * 2 + (h)) * HTB)
#define PG8_STAGE(bufoff, gbase, voff) do { _Pragma("unroll") for (int _i = 0; _i < 2; ++_i) \
        __builtin_amdgcn_global_load_lds((const unsigned*)((const char*)(gbase) + (voff)[_i]), (PG8_LAS unsigned*)(lds + (bufoff) + ldsw + _i * 8192), 16, 0, 0); } while (0)
#define PG8_LDA(dst, b, h) do { _Pragma("unroll") for (int m = 0; m < 4; ++m) _Pragma("unroll") for (int k = 0; k < 2; ++k) dst[m][k] = *(const PG8_LAS bf16x8*)(lds + PG8_SA(b, h) + aoff + m * 2048 + k * 1024); } while (0)
#define PG8_LDB(dst, b, h) do { _Pragma("unroll") for (int n = 0; n < 2; ++n) _Pragma("unroll") for (int k = 0; k < 2; ++k) dst[n][k] = *(const PG8_LAS bf16x8*)(lds + PG8_SB(b, h) + boff + n * 2048 + k * 1024); } while (0)
#define PG8_MMA(ai, bj, At, Bt) do { __builtin_amdgcn_s_setprio(1); _Pragma("unroll") for (int m = 0; m < 4; ++m) _Pragma("unroll") for (int n = 0; n < 2; ++n) _Pragma("unroll") for (int k = 0; k < 2; ++k) \
        acc[ai][bj][m][n] = __builtin_amdgcn_mfma_f32_16x16x32_bf16(Bt[n][k], At[m][k], acc[ai][bj][m][n], 0, 0, 0); __builtin_amdgcn_s_setprio(0); } while (0)
#define PG8_WAIT_V(n) asm volatile("s_waitcnt vmcnt(" #n ")" ::: "memory")
#define PG8_WAIT_L(n) asm volatile("s_waitcnt lgkmcnt(" #n ")" ::: "memory")
#define PG8_BAR __builtin_amdgcn_s_barrier()
#define PG8_SCHED __builtin_amdgcn_sched_barrier(0)
    Unit cur, nxt; int ui = 0;
    if (!S.next(0, cur)) return;
    f32x4 acc[2][2][4][2];
#pragma unroll
    for (int a = 0; a < 2; ++a)
#pragma unroll
        for (int b = 0; b < 2; ++b)
#pragma unroll
            for (int m = 0; m < 4; ++m)
#pragma unroll
                for (int n = 0; n < 2; ++n) acc[a][b][m][n] = (f32x4){0.f, 0.f, 0.f, 0.f};
    bf16x8 At[4][2], B0[2][2], B1[2][2];
    const char* cA = (const char*)g.A + (size_t)cur.pm * tstep; const char* cB = (const char*)g.Bt + (size_t)cur.pn * tstep;
    S.a_ready(cur);
    PG8_STAGE(PG8_SB(0, 0), cB, voffB); PG8_STAGE(PG8_SA(0, 0), cA, voffA); PG8_STAGE(PG8_SB(0, 1), cB + hstep, voffB); PG8_STAGE(PG8_SA(0, 1), cA + hstep, voffA);
    if (wr == 1) PG8_BAR;
    PG8_WAIT_V(4); PG8_BAR;
    PG8_STAGE(PG8_SB(1, 0), cB + kstep, voffB); PG8_STAGE(PG8_SA(1, 0), cA + kstep, voffA); PG8_STAGE(PG8_SB(1, 1), cB + hstep + kstep, voffB);
    PG8_WAIT_V(6); PG8_BAR;
    PG8_STAMP();
    for (;;) {
        const bool has_next = S.next(ui + 1, nxt);
        const char* nA = has_next ? (const char*)g.A + (size_t)nxt.pm * tstep : cA; const char* nB = has_next ? (const char*)g.Bt + (size_t)nxt.pn * tstep : cB;
        for (int t = 0; t < nt; t += 2) {
            const bool last = (t == nt - 2);
            const char* a1 = cA + (size_t)(t + 1) * kstep;
            const char* a2 = last ? nA : cA + (size_t)(t + 2) * kstep; const char* b2 = last ? nB : cB + (size_t)(t + 2) * kstep;
            const char* a3 = a2 + kstep; const char* b3 = b2 + kstep;
            if (last && has_next) S.a_ready(nxt);
            PG8_LDB(B0, 0, 0); PG8_SCHED; PG8_LDA(At, 0, 0); PG8_STAGE(PG8_SA(1, 1), a1 + hstep, voffA);
            PG8_WAIT_L(8); PG8_BAR; PG8_WAIT_L(0); PG8_MMA(0, 0, At, B0); PG8_BAR; PG8_SCHED;
            PG8_LDB(B1, 0, 1); PG8_STAGE(PG8_SB(0, 0), b2, voffB);
            PG8_BAR; PG8_WAIT_L(0); PG8_MMA(0, 1, At, B1); PG8_BAR;
            PG8_LDA(At, 0, 1); PG8_STAGE(PG8_SA(0, 0), a2, voffA);
            PG8_BAR; PG8_WAIT_L(0); PG8_MMA(1, 0, At, B0); PG8_BAR; PG8_SCHED;
            PG8_STAGE(PG8_SB(0, 1), b2 + hstep, voffB);
            PG8_WAIT_V(6); PG8_BAR; PG8_MMA(1, 1, At, B1); PG8_BAR;
            PG8_LDB(B0, 1, 0); PG8_SCHED; PG8_LDA(At, 1, 0); PG8_STAGE(PG8_SA(0, 1), a2 + hstep, voffA);
            PG8_WAIT_L(8); PG8_BAR; PG8_WAIT_L(0); PG8_MMA(0, 0, At, B0); PG8_BAR; PG8_SCHED;
            PG8_LDB(B1, 1, 1); PG8_STAGE(PG8_SB(1, 0), b3, voffB);
            PG8_BAR; PG8_WAIT_L(0); PG8_MMA(0, 1, At, B1); PG8_BAR;
            PG8_LDA(At, 1, 1); PG8_STAGE(PG8_SA(1, 0), a3, voffA);
            PG8_BAR; PG8_WAIT_L(0); PG8_MMA(1, 0, At, B0); PG8_BAR; PG8_SCHED;
            PG8_STAGE(PG8_SB(1, 1), b3 + hstep, voffB);
            PG8_WAIT_V(6); PG8_BAR; PG8_MMA(1, 1, At, B1); PG8_BAR;
        }
        PG8_STAMP();
        if constexpr (!Epi::AFTER_DRAIN) { E(acc, cur, wr, wc, fr, fq); S.done(cur); }
        PG8_STAMP();
        if (!has_next) break;
#pragma unroll
        for (int a = 0; a < 2; ++a)
#pragma unroll
            for (int b = 0; b < 2; ++b)
#pragma unroll
                for (int m = 0; m < 4; ++m)
#pragma unroll
                    for (int n = 0; n < 2; ++n) acc[a][b][m][n] = (f32x4){0.f, 0.f, 0.f, 0.f};
        cur = nxt; cA = nA; cB = nB; ++ui;
    }
    PG8_WAIT_V(0);
    if (wr == 0) PG8_BAR;
    PG8_BAR;
    if constexpr (Epi::AFTER_DRAIN) { E.fused(acc, cur, wr, wc, fr, fq, lds, wid, lane); S.done(cur); }
    PG8_STAMP();
    if (STAMP && wid == 0) { stamps[lane] = lane < nts ? (((unsigned long long)(unsigned)ts_hi << 32) | (unsigned)ts_lo) : 0ull;
        if (lane == 62) stamps[62] = rt_entry; if (lane == 63) stamps[63] = (unsigned long long)wall_clock64(); }
#undef PG8_STAMP
#undef PG8_SA
#undef PG8_SB
#undef PG8_STAGE
#undef PG8_LDA
#undef PG8_LDB
#undef PG8_MMA
#undef PG8_WAIT_V
#undef PG8_WAIT_L
#undef PG8_BAR
#undef PG8_SCHED
}
}

using pg8::bf16_t; using pg8::bf16x8; using pg8::f32x4; using pg8::u32x4;
#define LAS __attribute__((address_space(3)))
#define DI __device__ __forceinline__
typedef float f32x2 __attribute__((ext_vector_type(2)));
typedef unsigned short u16x8 __attribute__((ext_vector_type(8)));
typedef unsigned short u16x4 __attribute__((ext_vector_type(4)));

constexpr int NTOK = 8192, DM = 1024, DFF = 4096, NPROJ = 4608, NPROJ_ALL = 4624, NMOD = 6144;
constexpr int LDS_BYTES = 147456;
constexpr int GDN_PACK_B = 34880, HG_PACK_B = 18944;
constexpr size_t OFF_MOD = 0;
constexpr size_t OFF_LBS = 262144;
constexpr size_t OFF_AB = OFF_LBS + 4096;
constexpr size_t OFF_W0 = OFF_AB + (size_t)NTOK * 16 * 4;
constexpr size_t SZ_WIN = (size_t)NPROJ * DM * 2, SZ_WSQ = (size_t)DM * DM * 2, SZ_WFF = (size_t)DFF * DM * 2;
constexpr size_t OFF_H = OFF_W0 + SZ_WIN + SZ_WSQ + 2 * SZ_WFF;
constexpr size_t OFF_PROJ = OFF_H + (size_t)NTOK * DM * 2;
constexpr size_t OFF_PACK = OFF_PROJ + (size_t)NTOK * NPROJ * 2;
constexpr size_t SZ_GPACK = (size_t)2048 * GDN_PACK_B, SZ_HPACK = (size_t)2048 * HG_PACK_B;
constexpr size_t OFF_O = OFF_PACK + SZ_GPACK + SZ_HPACK;
constexpr size_t WS_NEED = OFF_O + (size_t)2 * NTOK * DM * 2;
constexpr size_t OFF_W1 = OFF_PACK;
constexpr size_t SZ_WQKV = (size_t)3072 * DM * 2;
constexpr size_t OFF_X2 = OFF_W1 + SZ_WQKV + SZ_WSQ + 2 * SZ_WFF;
static_assert(OFF_X2 + (size_t)NTOK * DM * 4 <= OFF_O, "overlay");
static_assert(WS_NEED <= 268435456ull, "workspace");

struct Params {
    const float *xp, *xs, *st_hgrn, *st_gdn, *cache_k, *cache_v, *c, *c_ctx, *ada_w, *ada_b, *norm_g, *w_in, *w_out_ab, *hgrn_lb, *gdn_conv, *a_log, *dt_bias,
        *gn_hgrn, *gn_gdn, *w_qkv, *qn, *kn, *rpb, *w_out_na, *w_mlp1, *w_mlp2;
    float* out; unsigned char* ws;
};

DI bf16_t f2bf(float f) { unsigned u = __float_as_uint(f); u += 0x7FFFu + ((u >> 16) & 1u); return (bf16_t)(u >> 16); }
DI float bf2f(bf16_t h) { return __uint_as_float((unsigned)h << 16); }
DI float sigmoidf_(float x) { return 1.0f / (1.0f + __expf(-x)); }
DI float siluf_(float x) { return x / (1.0f + __expf(-x)); }
DI float softplusf_(float x) { return x > 20.f ? x : log1pf(__expf(x)); }
DI float wave_sum(float v) { for (int o = 32; o > 0; o >>= 1) v += __shfl_xor(v, o); return v; }
DI int modrow(int tok) { return tok < 4096 ? 0 : 1 + ((tok - 4096) >> 10); }
DI const float* xrow(const Params& p, int tok) { return tok < 4096 ? p.xp + (size_t)tok * DM : p.xs + (size_t)(tok - 4096) * DM; }

DI f32x4 mma16(const LAS bf16_t* A, int lda, const LAS bf16_t* Bt, int ldb, int K, f32x4 acc) {
    const int lane = threadIdx.x & 63, r = lane & 15, q = lane >> 4;
    const LAS bf16_t* pa = A + r * lda + 8 * q; const LAS bf16_t* pb = Bt + r * ldb + 8 * q;
    for (int k0 = 0; k0 < K; k0 += 32) {
        const bf16x8 a = *(const LAS bf16x8*)(pa + k0), b = *(const LAS bf16x8*)(pb + k0);
        acc = __builtin_amdgcn_mfma_f32_16x16x32_bf16(a, b, acc, 0, 0, 0);
    }
    return acc;
}
DI void phase_mod(const Params& p, LAS unsigned char* lds) {
    LAS float* sc = (LAS float*)lds;
    LAS float* red = (LAS float*)(lds + 20480);
    const int tid = threadIdx.x;
    float* mod = (float*)(p.ws + OFF_MOD);
    for (int e = tid; e < 5 * 1024; e += 512) { const int m = e >> 10, k = e & 1023; const float v = m == 0 ? p.c_ctx[k] : p.c[(m - 1) * 1024 + k]; sc[e] = siluf_(v); }
    __syncthreads();
    for (int cb = blockIdx.x; cb < 256; cb += gridDim.x) {
        const int l = cb >> 7, n0 = (cb & 127) * 48;
        const float* W = p.ada_w + (size_t)l * 1024 * NMOD + n0;
        const int cq = tid % 12, ks = tid / 12;
        float acc[5][4];
#pragma unroll
        for (int m = 0; m < 5; ++m)
#pragma unroll
            for (int j = 0; j < 4; ++j) acc[m][j] = 0.f;
        if (ks < 42) {
            const int k0 = ks * 25, k1 = (k0 + 25 < 1024) ? k0 + 25 : 1024;
            for (int k = k0; k < k1; ++k) {
                const f32x4 w = *(const f32x4*)(W + (size_t)k * NMOD + 4 * cq);
#pragma unroll
                for (int m = 0; m < 5; ++m) { const float s = sc[m * 1024 + k];
#pragma unroll
                    for (int j = 0; j < 4; ++j) acc[m][j] += s * w[j]; }
            }
#pragma unroll
            for (int m = 0; m < 5; ++m)
#pragma unroll
                for (int j = 0; j < 4; ++j) red[(ks * 5 + m) * 48 + 4 * cq + j] = acc[m][j];
        }
        __syncthreads();
        if (tid < 240) { const int m = tid / 48, j = tid % 48; float s = 0.f; for (int k = 0; k < 42; ++k) s += red[(k * 5 + m) * 48 + j];
            mod[((size_t)l * 5 + m) * NMOD + n0 + j] = s + p.ada_b[l * NMOD + n0 + j]; }
        __syncthreads();
    }
    if (blockIdx.x == gridDim.x - 1) {
        float* lbs = (float*)(p.ws + OFF_LBS);
        const float a = p.hgrn_lb[tid], b = p.hgrn_lb[512 + tid], c = p.hgrn_lb[1024 + tid];
        const float mx = fmaxf(a, fmaxf(b, c)); const float ea = __expf(a - mx), eb = __expf(b - mx), ec = __expf(c - mx);
        lbs[tid] = ea / (ea + eb + ec);
    }
}
DI void transpose_tiles(const float* W, int K, int N, int ldw, bf16_t* Wt, int tbase, int ttotal, LAS unsigned char* lds) {
    LAS float* tile = (LAS float*)lds;
    const int tid = threadIdx.x, nk = K / 64, nn = N / 64, nt = nk * nn;
    int g = blockIdx.x; if (g < tbase) g += ((tbase - g + gridDim.x - 1) / gridDim.x) * gridDim.x;
    for (; g < tbase + nt; g += gridDim.x) {
        const int t = g - tbase, tk = t % nk, tn = t / nk, k0 = tk * 64, n0 = tn * 64;
#pragma unroll
        for (int ps = 0; ps < 2; ++ps) { const int row = (tid >> 4) + ps * 32, c4 = tid & 15;
            const f32x4 v = *(const f32x4*)(W + (size_t)(k0 + row) * ldw + n0 + 4 * c4);
            tile[row * 65 + 4 * c4 + 0] = v[0]; tile[row * 65 + 4 * c4 + 1] = v[1]; tile[row * 65 + 4 * c4 + 2] = v[2]; tile[row * 65 + 4 * c4 + 3] = v[3]; }
        __syncthreads();
        { const int n = tid >> 3, k8 = tid & 7; u32x4 w;
          w.x = pg8::cvt_pk_bf16(tile[(k8 * 8 + 0) * 65 + n], tile[(k8 * 8 + 1) * 65 + n]); w.y = pg8::cvt_pk_bf16(tile[(k8 * 8 + 2) * 65 + n], tile[(k8 * 8 + 3) * 65 + n]);
          w.z = pg8::cvt_pk_bf16(tile[(k8 * 8 + 4) * 65 + n], tile[(k8 * 8 + 5) * 65 + n]); w.w = pg8::cvt_pk_bf16(tile[(k8 * 8 + 6) * 65 + n], tile[(k8 * 8 + 7) * 65 + n]);
          *(u32x4*)(Wt + (size_t)(n0 + n) * K + k0 + k8 * 8) = w; }
        __syncthreads();
    }
    (void)ttotal;
}
DI void phase_w0(const Params& p, LAS unsigned char* lds) {
    bf16_t* w = (bf16_t*)(p.ws + OFF_W0);
    int tb = 0;
    transpose_tiles(p.w_in, 1024, NPROJ, NPROJ_ALL, w, tb, 0, lds); tb += 16 * 72;
    transpose_tiles(p.w_out_ab, 1024, 1024, 1024, w + (size_t)NPROJ * DM, tb, 0, lds); tb += 256;
    transpose_tiles(p.w_mlp1, 1024, 4096, 4096, w + (size_t)NPROJ * DM + (size_t)DM * DM, tb, 0, lds); tb += 1024;
    transpose_tiles(p.w_mlp2, 4096, 1024, 1024, w + (size_t)NPROJ * DM + (size_t)DM * DM + (size_t)DFF * DM, tb, 0, lds);
}
DI void phase_w1(const Params& p, LAS unsigned char* lds) {
    bf16_t* w = (bf16_t*)(p.ws + OFF_W1);
    int tb = 0;
    transpose_tiles(p.w_qkv, 1024, 3072, 3072, w, tb, 0, lds); tb += 16 * 48;
    transpose_tiles(p.w_out_na, 1024, 1024, 1024, w + (size_t)3072 * DM, tb, 0, lds); tb += 256;
    transpose_tiles(p.w_mlp1 + (size_t)DM * DFF, 1024, 4096, 4096, w + (size_t)3072 * DM + (size_t)DM * DM, tb, 0, lds); tb += 1024;
    transpose_tiles(p.w_mlp2 + (size_t)DFF * DM, 4096, 1024, 1024, w + (size_t)3072 * DM + (size_t)DM * DM + (size_t)DFF * DM, tb, 0, lds);
}
template <bool AB> DI void phase_norm(const Params& p, const float* srcp, const float* srcs, int l, int sub, LAS unsigned char* lds) {
    const int tid = threadIdx.x, wid = tid >> 6, lane = tid & 63;
    const float* mod = (const float*)(p.ws + OFF_MOD) + (size_t)l * 5 * NMOD;
    const float* gw = p.norm_g + (l * 2 + sub) * 1024;
    bf16_t* H = (bf16_t*)(p.ws + OFF_H);
    LAS float* wab = (LAS float*)lds;
    if (AB) { for (int e = tid; e < 1024 * 16; e += 512) { const int k = e >> 4, j = e & 15; wab[e] = p.w_in[(size_t)k * NPROJ_ALL + NPROJ + j]; } __syncthreads(); }
    float* ab = (float*)(p.ws + OFF_AB);
    for (int tok = blockIdx.x * 8 + wid; tok < NTOK; tok += gridDim.x * 8) {
        const float* xr = tok < 4096 ? srcp + (size_t)tok * 1024 : srcs + (size_t)(tok - 4096) * 1024;
        const int mr = modrow(tok);
        const float* sh = mod + (size_t)mr * NMOD + sub * 3072; const float* scp = sh + 1024;
        f32x4 x[4]; float ss = 0.f;
#pragma unroll
        for (int i = 0; i < 4; ++i) { x[i] = *(const f32x4*)(xr + i * 256 + lane * 4); ss += x[i][0] * x[i][0] + x[i][1] * x[i][1] + x[i][2] * x[i][2] + x[i][3] * x[i][3]; }
        ss = wave_sum(ss);
        const float rs = rsqrtf(ss * (1.0f / 1024.0f) + 1e-6f);
        float pa[16];
        if (AB) {
#pragma unroll
            for (int j = 0; j < 16; ++j) pa[j] = 0.f; }
#pragma unroll
        for (int i = 0; i < 4; ++i) { const int k = i * 256 + lane * 4;
            const f32x4 g4 = *(const f32x4*)(gw + k), s4 = *(const f32x4*)(scp + k), h4 = *(const f32x4*)(sh + k);
            f32x4 hv;
#pragma unroll
            for (int e = 0; e < 4; ++e) hv[e] = x[i][e] * rs * g4[e] * (1.0f + s4[e]) + h4[e];
            uint2 w; w.x = pg8::cvt_pk_bf16(hv[0], hv[1]); w.y = pg8::cvt_pk_bf16(hv[2], hv[3]);
            *(uint2*)(H + (size_t)tok * 1024 + k) = w;
            if (AB) {
#pragma unroll
                for (int e = 0; e < 4; ++e) {
#pragma unroll
                    for (int j4 = 0; j4 < 4; ++j4) { const f32x4 wv = *(const LAS f32x4*)(wab + (k + e) * 16 + 4 * j4);
                        pa[4 * j4 + 0] += hv[e] * wv[0]; pa[4 * j4 + 1] += hv[e] * wv[1]; pa[4 * j4 + 2] += hv[e] * wv[2]; pa[4 * j4 + 3] += hv[e] * wv[3]; } } }
        }
        if (AB) {
            float mine = 0.f;
#pragma unroll
            for (int j = 0; j < 16; ++j) { const float s = wave_sum(pa[j]); if (lane == j) mine = s; }
            if (lane < 16) ab[(size_t)tok * 16 + lane] = mine;
        }
    }
}
DI int chunk_seq_start(int gc) { return gc < 128 ? (gc >> 3) * 256 : 4096 + ((gc - 128) >> 5) * 1024; }
DI int chunk_seq_len(int gc) { return gc < 128 ? 256 : 1024; }
DI void gdn_prep_item(const Params& p, int gc, int h, LAS unsigned char* lds) {
    const int tid = threadIdx.x, wid = tid >> 6, lane = tid & 63;
    LAS float* qf = (LAS float*)lds; LAS float* kf = (LAS float*)(lds + 16384); LAS float* vf = (LAS float*)(lds + 32768);
    LAS bf16_t* qb = (LAS bf16_t*)(lds + 49152); LAS bf16_t* kb = (LAS bf16_t*)(lds + 57856);
    LAS float* KK = (LAS float*)(lds + 66560); LAS float* QK = (LAS float*)(lds + 70784); LAS float* Am = (LAS float*)(lds + 75008);
    LAS bf16_t* Tm = (LAS bf16_t*)(lds + 79232); LAS bf16_t* RT = (LAS bf16_t*)(lds + 81792);
    LAS float* gs = (LAS float*)(lds + 102272);
    const bf16_t* proj = (const bf16_t*)(p.ws + OFF_PROJ);
    const float* ab = (const float*)(p.ws + OFF_AB);
    const int t0 = gc * 32, sb = chunk_seq_start(gc), se = sb + chunk_seq_len(gc);
    for (int e = tid; e < 32 * 384; e += 512) {
        const int i = e / 384, c = e % 384, part = c >> 7, d = c & 127, ch = part * 512 + h * 128 + d;
        float a = 0.f;
#pragma unroll
        for (int j = 0; j < 5; ++j) { const int tk = t0 + i + j - 2; if (tk >= sb && tk < se) a += bf2f(proj[(size_t)tk * NPROJ + 2560 + ch]) * p.gdn_conv[j * 1536 + ch]; }
        const float v = siluf_(a);
        (part == 0 ? qf : part == 1 ? kf : vf)[i * 128 + d] = v;
    }
    __syncthreads();
    for (int i = wid * 4; i < wid * 4 + 4; ++i) {
        const float q0 = qf[i * 128 + lane], q1 = qf[i * 128 + 64 + lane], k0 = kf[i * 128 + lane], k1 = kf[i * 128 + 64 + lane];
        const float sq = wave_sum(q0 * q0 + q1 * q1), sk = wave_sum(k0 * k0 + k1 * k1);
        const float rq = rsqrtf(sq + 1e-6f) * 0.08838834764831845f, rk = rsqrtf(sk + 1e-6f);
        qf[i * 128 + lane] = q0 * rq; qf[i * 128 + 64 + lane] = q1 * rq; kf[i * 128 + lane] = k0 * rk; kf[i * 128 + 64 + lane] = k1 * rk;
        qb[i * 136 + lane] = f2bf(q0 * rq); qb[i * 136 + 64 + lane] = f2bf(q1 * rq); kb[i * 136 + lane] = f2bf(k0 * rk); kb[i * 136 + 64 + lane] = f2bf(k1 * rk);
    }
    __syncthreads();
    { const int w4 = wid & 3, mt = w4 >> 1, nt = w4 & 1, r = lane & 15, q = lane >> 4;
      f32x4 acc = {0.f, 0.f, 0.f, 0.f};
      acc = mma16((wid < 4 ? kb : qb) + 16 * mt * 136, 136, kb + 16 * nt * 136, 136, 128, acc);
      LAS float* D = wid < 4 ? KK : QK;
#pragma unroll
      for (int i = 0; i < 4; ++i) D[(16 * mt + 4 * q + i) * 33 + 16 * nt + r] = acc[i]; }
    __syncthreads();
    for (int dir = 0; dir < 2; ++dir) {
        bf16_t* pack = (bf16_t*)(p.ws + OFF_PACK + ((size_t)(gc * 4 + h) * 2 + dir) * GDN_PACK_B);
        if (wid == 0) {
            const int pp = lane & 31, i = dir ? 31 - pp : pp, tk = t0 + i;
            const float araw = ab[(size_t)tk * 16 + dir * 4 + h], braw = ab[(size_t)tk * 16 + 8 + dir * 4 + h];
            const float beta = sigmoidf_(braw);
            float g = -__expf(p.a_log[dir * 4 + h]) * softplusf_(araw + p.dt_bias[dir * 4 + h]);
#pragma unroll
            for (int o = 1; o < 32; o <<= 1) { const float t = __shfl_up(g, o, 32); if (pp >= o) g += t; }
            if (lane < 32) { gs[pp] = g; gs[32 + pp] = beta; }
        }
        __syncthreads();
        for (int e = tid; e < 1024; e += 512) { const int pp = e >> 5, s = e & 31, ip = dir ? 31 - pp : pp, is = dir ? 31 - s : s;
            const float dec = s <= pp ? __expf(gs[pp] - gs[s]) : 0.f;
            Am[pp * 33 + s] = s < pp ? gs[32 + pp] * KK[ip * 33 + is] * dec : 0.f;
            pack[12288 + e] = f2bf(s <= pp ? QK[ip * 33 + is] * dec : 0.f); }
        { const float gl = gs[31];
          for (int e = tid; e < 4096; e += 512) { const int pp = e >> 7, d = e & 127, ip = dir ? 31 - pp : pp;
            const float g = gs[pp], beta = gs[32 + pp], eg = __expf(g);
            const float kv = kf[ip * 128 + d], qv = qf[ip * 128 + d], vv = vf[ip * 128 + d];
            RT[d * 40 + pp] = f2bf(kv * beta * eg); RT[(128 + d) * 40 + pp] = f2bf(vv * beta);
            pack[4096 + e] = f2bf(qv * eg); pack[8192 + d * 32 + pp] = f2bf(kv * __expf(gl - g)); }
          if (tid == 0) *(float*)((unsigned char*)pack + 34816) = __expf(gl); }
        __syncthreads();
        if (wid == 0 && lane < 32) {
            float x[32];
#pragma unroll
            for (int pp = 0; pp < 32; ++pp) {
                float a = (pp == lane) ? 1.f : 0.f;
#pragma unroll
                for (int j = 0; j < pp; ++j) a -= Am[pp * 33 + j] * x[j];
                x[pp] = a; Tm[pp * 40 + lane] = f2bf(a);
            }
        }
        __syncthreads();
#pragma unroll
        for (int t = 0; t < 4; ++t) { const int id = wid * 4 + t, which = id >> 4, mt = (id >> 3) & 1, nt = id & 7, r = lane & 15, q = lane >> 4;
            f32x4 acc = {0.f, 0.f, 0.f, 0.f};
            acc = mma16(Tm + 16 * mt * 40, 40, RT + (which * 128 + 16 * nt) * 40, 40, 32, acc);
            bf16_t* dst = pack + (which ? 13312 : 0);
#pragma unroll
            for (int i = 0; i < 4; ++i) dst[(16 * mt + 4 * q + i) * 128 + 16 * nt + r] = f2bf(acc[i]); }
        __syncthreads();
    }
}
DI void hgrn_prep_item(const Params& p, int gc, int h, LAS unsigned char* lds) {
    const int tid = threadIdx.x, wid = tid >> 6, lane = tid & 63;
    LAS float* qf = (LAS float*)lds; LAS float* lg = (LAS float*)(lds + 16384); LAS float* lf = (LAS float*)(lds + 32768);
    LAS bf16_t* qt = (LAS bf16_t*)(lds + 49152); LAS bf16_t* kt = (LAS bf16_t*)(lds + 57856);
    const bf16_t* proj = (const bf16_t*)(p.ws + OFF_PROJ);
    const float* lbs = (const float*)(p.ws + OFF_LBS);
    const int t0 = gc * 32;
    for (int dir = 0; dir < 2; ++dir) {
        bf16_t* pack = (bf16_t*)(p.ws + OFF_PACK + SZ_GPACK + ((size_t)(gc * 4 + h) * 2 + dir) * HG_PACK_B);
        for (int e = tid; e < 4096; e += 512) { const int pp = e >> 7, d = e & 127, ip = dir ? 31 - pp : pp; const size_t ro = (size_t)(t0 + ip) * NPROJ;
            const float qraw = bf2f(proj[ro + h * 128 + d]), fraw = bf2f(proj[ro + 512 + dir * 512 + h * 128 + d]), lb = lbs[h * 128 + d];
            const float f = lb + (1.0f - lb) * sigmoidf_(fraw);
            lf[e] = __logf(f); qf[e] = siluf_(qraw) * 0.08838834764831845f; }
        __syncthreads();
        if (tid < 128) { float a = 0.f; for (int pp = 0; pp < 32; ++pp) { a += lf[pp * 128 + tid]; lg[pp * 128 + tid] = a; } }
        __syncthreads();
        for (int e = tid; e < 4096; e += 512) { const int pp = e >> 7, d = e & 127;
            const float g = lg[e], gl = lg[31 * 128 + d], gr = lg[15 * 128 + d], kv = 1.0f - __expf(lf[e]), qv = qf[e];
            pack[1024 + e] = f2bf(qv * __expf(g)); pack[5120 + d * 32 + pp] = f2bf(kv * __expf(gl - g));
            qt[pp * 136 + d] = f2bf(qv * __expf(g - gr)); kt[pp * 136 + d] = f2bf(kv * __expf(gr - g));
            if (pp == 31) ((float*)((unsigned char*)pack + 18432))[d] = __expf(gl); }
        __syncthreads();
        if (wid < 4) { const int mt = wid >> 1, nt = wid & 1, r = lane & 15, q = lane >> 4;
            f32x4 acc = {0.f, 0.f, 0.f, 0.f};
            acc = mma16(qt + 16 * mt * 136, 136, kt + 16 * nt * 136, 136, 128, acc);
#pragma unroll
            for (int i = 0; i < 4; ++i) { const int pp = 16 * mt + 4 * q + i, s = 16 * nt + r; pack[pp * 32 + s] = f2bf(s <= pp ? acc[i] : 0.f); } }
        __syncthreads();
    }
}
DI void phase_prep(const Params& p, LAS unsigned char* lds) {
    for (int it = blockIdx.x; it < 2048; it += gridDim.x) {
        const int mixer = it & 1, h = (it >> 1) & 3, gc = it >> 3;
        if (mixer) gdn_prep_item(p, gc, h, lds); else hgrn_prep_item(p, gc, h, lds);
    }
}
template <bool GDN> DI void scan_item(const Params& p, int s, int h, int dir, LAS unsigned char* lds) {
    const int tid = threadIdx.x, wid = tid >> 6, lane = tid & 63, r = lane & 15, q = lane >> 4, dv0 = wid * 16;
    LAS bf16_t* A0 = (LAS bf16_t*)lds; LAS bf16_t* A1 = (LAS bf16_t*)(lds + 8704); LAS bf16_t* KT = (LAS bf16_t*)(lds + 17408);
    LAS bf16_t* AT = (LAS bf16_t*)(lds + 27648); LAS bf16_t* VT = (LAS bf16_t*)(lds + 30208); LAS float* av = (LAS float*)(lds + 40448);
    LAS bf16_t* ST = (LAS bf16_t*)(lds + 40960 + wid * 4352); LAS bf16_t* VN = (LAS bf16_t*)(lds + 75776 + wid * 1280);
    const int sstart = s < 16 ? s * 256 : 4096 + (s - 16) * 1024, N = s < 16 ? 8 : 32, gc0 = sstart >> 5;
    const bf16_t* proj = (const bf16_t*)(p.ws + OFF_PROJ);
    bf16_t* O = (bf16_t*)(p.ws + OFF_O) + (size_t)dir * NTOK * DM;
    f32x4 S[8];
    if (s >= 16) { const float* st = (GDN ? p.st_gdn : p.st_hgrn) + ((size_t)((s - 16) * 2 + dir) * 4 + h) * 16384;
#pragma unroll
        for (int i = 0; i < 8; ++i)
#pragma unroll
            for (int j = 0; j < 4; ++j) S[i][j] = st[(16 * i + 4 * q + j) * 128 + dv0 + r];
    } else {
#pragma unroll
        for (int i = 0; i < 8; ++i) S[i] = (f32x4){0.f, 0.f, 0.f, 0.f}; }
#pragma unroll
    for (int i = 0; i < 8; ++i)
#pragma unroll
        for (int j = 0; j < 4; ++j) ST[r * 136 + 16 * i + 4 * q + j] = f2bf(S[i][j]);
    for (int m = 0; m < N; ++m) {
        const int n = dir ? N - 1 - m : m, gc = gc0 + n;
        const unsigned char* packb = p.ws + OFF_PACK + (GDN ? 0 : SZ_GPACK) + ((size_t)(gc * 4 + h) * 2 + dir) * (GDN ? GDN_PACK_B : HG_PACK_B);
        const bf16_t* pack = (const bf16_t*)packb;
        __syncthreads();
        { const int row = tid >> 4, c8 = (tid & 15) * 8;
          if (GDN) { *(LAS u32x4*)(A0 + row * 136 + c8) = *(const u32x4*)(pack + tid * 8); *(LAS u32x4*)(A1 + row * 136 + c8) = *(const u32x4*)(pack + 4096 + tid * 8); }
          else *(LAS u32x4*)(A0 + row * 136 + c8) = *(const u32x4*)(pack + 1024 + tid * 8);
          const int kr = tid >> 2, k8 = (tid & 3) * 8;
          *(LAS u32x4*)(KT + kr * 40 + k8) = *(const u32x4*)(pack + (GDN ? 8192 : 5120) + tid * 8);
          if (tid < 128) { const int ar = tid >> 2; *(LAS u32x4*)(AT + ar * 40 + k8) = *(const u32x4*)(pack + (GDN ? 12288 : 0) + tid * 8); }
          if (!GDN) { if (tid < 128) av[tid] = ((const float*)(packb + 18432))[tid];
              for (int e = tid; e < 4096; e += 512) { const int pp = e >> 7, d = e & 127, ip = dir ? 31 - pp : pp;
                  VT[d * 40 + pp] = proj[(size_t)(sstart + 32 * n + ip) * NPROJ + 1536 + h * 128 + d]; } } }
        __syncthreads();
        if (GDN) {
            const float egl = *(const float*)(packb + 34816);
            const bf16_t* up = pack + 13312;
#pragma unroll
            for (int mt = 0; mt < 2; ++mt) { f32x4 acc = {0.f, 0.f, 0.f, 0.f};
                acc = mma16(A0 + 16 * mt * 136, 136, ST, 136, 128, acc);
#pragma unroll
                for (int i = 0; i < 4; ++i) { const int pp = 16 * mt + 4 * q + i; VN[r * 40 + pp] = f2bf(bf2f(up[pp * 128 + dv0 + r]) - acc[i]); } }
            __syncthreads();
#pragma unroll
            for (int mt = 0; mt < 2; ++mt) { f32x4 acc = {0.f, 0.f, 0.f, 0.f};
                acc = mma16(A1 + 16 * mt * 136, 136, ST, 136, 128, acc);
                acc = mma16(AT + 16 * mt * 40, 40, VN, 40, 32, acc);
#pragma unroll
                for (int i = 0; i < 4; ++i) { const int pp = 16 * mt + 4 * q + i, ip = dir ? 31 - pp : pp;
                    O[(size_t)(sstart + 32 * n + ip) * DM + 512 + h * 128 + dv0 + r] = f2bf(acc[i]); } }
#pragma unroll
            for (int i = 0; i < 8; ++i) { S[i] = S[i] * egl; S[i] = mma16(KT + 16 * i * 40, 40, VN, 40, 32, S[i]); }
        } else {
#pragma unroll
            for (int mt = 0; mt < 2; ++mt) { f32x4 acc = {0.f, 0.f, 0.f, 0.f};
                acc = mma16(AT + 16 * mt * 40, 40, VT + dv0 * 40, 40, 32, acc);
                acc = mma16(A0 + 16 * mt * 136, 136, ST, 136, 128, acc);
#pragma unroll
                for (int i = 0; i < 4; ++i) { const int pp = 16 * mt + 4 * q + i, ip = dir ? 31 - pp : pp;
                    O[(size_t)(sstart + 32 * n + ip) * DM + h * 128 + dv0 + r] = f2bf(acc[i]); } }
#pragma unroll
            for (int i = 0; i < 8; ++i) { const f32x4 a4 = *(const LAS f32x4*)(av + 16 * i + 4 * q); S[i] = S[i] * a4; S[i] = mma16(KT + 16 * i * 40, 40, VT + dv0 * 40, 40, 32, S[i]); }
        }
        __syncthreads();
#pragma unroll
        for (int i = 0; i < 8; ++i)
#pragma unroll
            for (int j = 0; j < 4; ++j) ST[r * 136 + 16 * i + 4 * q + j] = f2bf(S[i][j]);
    }
    if (s < 16) { float* so = p.out + (size_t)NTOK * DM + (GDN ? (size_t)2097152 : 0) + ((size_t)(s * 2 + dir) * 4 + h) * 16384;
#pragma unroll
        for (int i = 0; i < 8; ++i)
#pragma unroll
            for (int j = 0; j < 4; ++j) so[(16 * i + 4 * q + j) * 128 + dv0 + r] = S[i][j]; }
    __syncthreads();
}
DI void scan_dispatch(const Params& p, int it, LAS unsigned char* lds) {
    int mixer, dir, h, s;
    if (it < 64) { mixer = it & 1; dir = (it >> 1) & 1; h = (it >> 2) & 3; s = 16 + (it >> 4); }
    else { const int si = it - 64; mixer = si & 1; dir = (si >> 1) & 1; h = (si >> 2) & 3; s = si >> 4; }
    if (mixer) scan_item<true>(p, s, h, dir, lds); else scan_item<false>(p, s, h, dir, lds);
}
DI void phase_scan(const Params& p, LAS unsigned char* lds) {
    const int b = blockIdx.x, G = gridDim.x;
    if (G == 256) { scan_dispatch(p, b, lds); if (b >= 64 && b < 128) scan_dispatch(p, 256 + b - 64, lds); }
    else for (int it = b; it < 320; it += G) scan_dispatch(p, it, lds);
}
DI void phase_combine(const Params& p) {
    const int tid = threadIdx.x, wid = tid >> 6, lane = tid & 63;
    const bf16_t* O0 = (const bf16_t*)(p.ws + OFF_O); const bf16_t* O1 = O0 + (size_t)NTOK * DM;
    const bf16_t* proj = (const bf16_t*)(p.ws + OFF_PROJ);
    bf16_t* H = (bf16_t*)(p.ws + OFF_H);
    const int mixer = lane >> 5, d0 = (lane & 7) * 16, gcol = (mixer ? 4096 : 2048) + ((16 * lane) & 511);
    const float* gn = (mixer ? p.gn_gdn : p.gn_hgrn) + d0;
    for (int tok = blockIdx.x * 8 + wid; tok < NTOK; tok += gridDim.x * 8) {
        const u16x8 a0 = *(const u16x8*)(O0 + (size_t)tok * DM + 16 * lane), a1 = *(const u16x8*)(O0 + (size_t)tok * DM + 16 * lane + 8);
        const u16x8 b0 = *(const u16x8*)(O1 + (size_t)tok * DM + 16 * lane), b1 = *(const u16x8*)(O1 + (size_t)tok * DM + 16 * lane + 8);
        const u16x8 g0 = *(const u16x8*)(proj + (size_t)tok * NPROJ + gcol), g1 = *(const u16x8*)(proj + (size_t)tok * NPROJ + gcol + 8);
        float v[16]; float ss = 0.f;
#pragma unroll
        for (int j = 0; j < 8; ++j) { v[j] = bf2f(a0[j]) + bf2f(b0[j]); v[8 + j] = bf2f(a1[j]) + bf2f(b1[j]); }
#pragma unroll
        for (int j = 0; j < 16; ++j) ss += v[j] * v[j];
        ss += __shfl_xor(ss, 1); ss += __shfl_xor(ss, 2); ss += __shfl_xor(ss, 4);
        const float rs = rsqrtf(ss * (1.0f / 128.0f) + 1e-6f);
        unsigned w[8];
#pragma unroll
        for (int j = 0; j < 8; ++j) { const float ga = bf2f(j < 4 ? g0[2 * j] : g1[2 * j - 8]), gb = bf2f(j < 4 ? g0[2 * j + 1] : g1[2 * j - 7]);
            w[j] = pg8::cvt_pk_bf16(v[2 * j] * rs * gn[2 * j] * siluf_(ga), v[2 * j + 1] * rs * gn[2 * j + 1] * siluf_(gb)); }
        *(u32x4*)(H + (size_t)tok * DM + 16 * lane) = (u32x4){w[0], w[1], w[2], w[3]};
        *(u32x4*)(H + (size_t)tok * DM + 16 * lane + 8) = (u32x4){w[4], w[5], w[6], w[7]};
    }
}
DI void phase_qknorm(const Params& p) {
    const int tid = threadIdx.x, wid = tid >> 6, lane = tid & 63;
    const bf16_t* QKV = (const bf16_t*)(p.ws + OFF_PROJ);
    bf16_t* QN = (bf16_t*)(p.ws + OFF_O); bf16_t* KN = QN + (size_t)NTOK * DM;
    float* ck = p.out + (size_t)NTOK * DM + 2 * 2097152; float* cv = ck + 4194304;
    const int hd = lane >> 2, d0 = (lane & 3) * 16;
    for (int tok = blockIdx.x * 8 + wid; tok < NTOK; tok += gridDim.x * 8) {
#pragma unroll
        for (int part = 0; part < 2; ++part) {
            const bf16_t* src = QKV + (size_t)tok * 3072 + part * 1024 + 16 * lane;
            const u16x8 a0 = *(const u16x8*)src, a1 = *(const u16x8*)(src + 8);
            float v[16]; float ss = 0.f;
#pragma unroll
            for (int j = 0; j < 8; ++j) { v[j] = bf2f(a0[j]); v[8 + j] = bf2f(a1[j]); }
#pragma unroll
            for (int j = 0; j < 16; ++j) ss += v[j] * v[j];
            ss += __shfl_xor(ss, 1); ss += __shfl_xor(ss, 2);
            const float rs = rsqrtf(ss * (1.0f / 64.0f) + 1e-6f);
            const float* gw = (part ? p.kn : p.qn) + d0;
#pragma unroll
            for (int j = 0; j < 16; ++j) v[j] = v[j] * rs * gw[j];
            unsigned w[8];
#pragma unroll
            for (int j = 0; j < 8; ++j) w[j] = pg8::cvt_pk_bf16(v[2 * j], v[2 * j + 1]);
            bf16_t* dst = (part ? KN : QN) + (size_t)tok * DM + 16 * lane;
            *(u32x4*)dst = (u32x4){w[0], w[1], w[2], w[3]}; *(u32x4*)(dst + 8) = (u32x4){w[4], w[5], w[6], w[7]};
            if (part == 1 && tok < 4096) { float* o = ck + (((size_t)(tok >> 8) * 16 + hd) * 256 + (tok & 255)) * 64 + d0;
#pragma unroll
                for (int j4 = 0; j4 < 4; ++j4) *(f32x4*)(o + 4 * j4) = (f32x4){v[4 * j4], v[4 * j4 + 1], v[4 * j4 + 2], v[4 * j4 + 3]}; }
        }
        if (tok < 4096) { const bf16_t* src = QKV + (size_t)tok * 3072 + 2048 + 16 * lane;
            const u16x8 a0 = *(const u16x8*)src, a1 = *(const u16x8*)(src + 8);
            float* o = cv + (((size_t)(tok >> 8) * 16 + hd) * 256 + (tok & 255)) * 64 + d0;
            *(f32x4*)(o) = (f32x4){bf2f(a0[0]), bf2f(a0[1]), bf2f(a0[2]), bf2f(a0[3])}; *(f32x4*)(o + 4) = (f32x4){bf2f(a0[4]), bf2f(a0[5]), bf2f(a0[6]), bf2f(a0[7])};
            *(f32x4*)(o + 8) = (f32x4){bf2f(a1[0]), bf2f(a1[1]), bf2f(a1[2]), bf2f(a1[3])}; *(f32x4*)(o + 12) = (f32x4){bf2f(a1[4]), bf2f(a1[5]), bf2f(a1[6]), bf2f(a1[7])}; }
    }
}
struct AttnState { f32x4 o[4]; float m[4], l[4]; };
DI void attn_block(AttnState& st, const LAS bf16_t* QW, LAS bf16_t* PW, const LAS bf16_t* KB, const LAS bf16_t* VTb, f32x4 (&sc)[4]) {
    const int lane = threadIdx.x & 63, r = lane & 15, q = lane >> 4;
    float alpha[4];
#pragma unroll
    for (int i = 0; i < 4; ++i) {
        float mx = fmaxf(fmaxf(sc[0][i], sc[1][i]), fmaxf(sc[2][i], sc[3][i]));
        mx = fmaxf(mx, __shfl_xor(mx, 1)); mx = fmaxf(mx, __shfl_xor(mx, 2)); mx = fmaxf(mx, __shfl_xor(mx, 4)); mx = fmaxf(mx, __shfl_xor(mx, 8));
        const float mn = fmaxf(st.m[i], mx); alpha[i] = __expf(st.m[i] - mn); st.m[i] = mn;
        float rsum = 0.f;
#pragma unroll
        for (int n = 0; n < 4; ++n) { const float pv = __expf(sc[n][i] - mn); rsum += pv; PW[(4 * q + i) * 72 + 16 * n + r] = f2bf(pv); }
        rsum += __shfl_xor(rsum, 1); rsum += __shfl_xor(rsum, 2); rsum += __shfl_xor(rsum, 4); rsum += __shfl_xor(rsum, 8);
        st.l[i] = st.l[i] * alpha[i] + rsum;
    }
#pragma unroll
    for (int dt = 0; dt < 4; ++dt) {
#pragma unroll
        for (int i = 0; i < 4; ++i) st.o[dt][i] *= alpha[i]; }
    (void)QW; (void)KB; (void)VTb;
}
DI void attn_pv(AttnState& st, const LAS bf16_t* PW, const LAS bf16_t* VTb) {
#pragma unroll
    for (int dt = 0; dt < 4; ++dt) st.o[dt] = mma16(PW, 72, VTb + 16 * dt * 72, 72, 64, st.o[dt]);
}
DI void phase_attn(const Params& p, LAS unsigned char* lds) {
    const int tid = threadIdx.x, wid = tid >> 6, lane = tid & 63, r = lane & 15, q = lane >> 4;
    LAS bf16_t* KB = (LAS bf16_t*)lds; LAS bf16_t* VTb = (LAS bf16_t*)(lds + 9216);
    LAS bf16_t* QW = (LAS bf16_t*)(lds + 18432 + wid * 2304); LAS bf16_t* PW = (LAS bf16_t*)(lds + 36864 + wid * 2304);
    const bf16_t* QN = (const bf16_t*)(p.ws + OFF_O); const bf16_t* KN = QN + (size_t)NTOK * DM;
    const bf16_t* QKV = (const bf16_t*)(p.ws + OFF_PROJ);
    bf16_t* AO = (bf16_t*)(p.ws + OFF_H);
    for (int it = blockIdx.x; it < 1024; it += gridDim.x) {
        const bool latent = it >= 512; const int id = it & 511;
        int h, qtok0;
        int b = 0, r0 = 0, rw = 0, ct = 0, nblk;
        if (!latent) { b = id >> 5; h = (id >> 1) & 15; const int qb = id & 1; qtok0 = b * 256 + qb * 128 + wid * 16; nblk = 4; }
        else { b = id >> 7; h = (id >> 3) & 15; const int rp = id & 7; r0 = 2 * rp; rw = r0 + (wid >> 2); ct = wid & 3; qtok0 = 4096 + b * 1024 + rw * 64 + ct * 16; nblk = 0; }
        __syncthreads();
        { const int row = lane >> 2, c16 = (lane & 3) * 16; const bf16_t* src = QN + (size_t)(qtok0 + row) * DM + h * 64 + c16;
          *(LAS u32x4*)(QW + row * 72 + c16) = *(const u32x4*)src; *(LAS u32x4*)(QW + row * 72 + c16 + 8) = *(const u32x4*)(src + 8); }
        AttnState st;
#pragma unroll
        for (int i = 0; i < 4; ++i) { st.o[i] = (f32x4){0.f, 0.f, 0.f, 0.f}; st.m[i] = -1e30f; st.l[i] = 0.f; }
        int rsA = 0, rsW = 0, nwin = 0;
        if (latent) { rsA = r0 - 4 < 0 ? 0 : (r0 - 4 > 8 ? 8 : r0 - 4); const int r1 = r0 + 1; const int rsB = r1 - 4 < 0 ? 0 : (r1 - 4 > 8 ? 8 : r1 - 4);
            rsW = (wid >> 2) ? rsB : rsA; nwin = rsB + 8 - rsA; nblk = nwin + 4; }
        for (int kb = 0; kb < nblk; ++kb) {
            __syncthreads();
            { const int row = tid >> 3, c8 = (tid & 7) * 8;
              u32x4 kv4, vv4;
              if (!latent || kb < nwin) {
                  const int ktok = !latent ? b * 256 + kb * 64 + row : 4096 + b * 1024 + (rsA + kb) * 64 + row;
                  kv4 = *(const u32x4*)(KN + (size_t)ktok * DM + h * 64 + c8); vv4 = *(const u32x4*)(QKV + (size_t)ktok * 3072 + 2048 + h * 64 + c8);
              } else {
                  const size_t co = (((size_t)b * 16 + h) * 256 + (kb - nwin) * 64 + row) * 64 + c8;
                  const f32x4 k0 = *(const f32x4*)(p.cache_k + co), k1 = *(const f32x4*)(p.cache_k + co + 4), v0 = *(const f32x4*)(p.cache_v + co), v1 = *(const f32x4*)(p.cache_v + co + 4);
                  kv4 = (u32x4){pg8::cvt_pk_bf16(k0[0], k0[1]), pg8::cvt_pk_bf16(k0[2], k0[3]), pg8::cvt_pk_bf16(k1[0], k1[1]), pg8::cvt_pk_bf16(k1[2], k1[3])};
                  vv4 = (u32x4){pg8::cvt_pk_bf16(v0[0], v0[1]), pg8::cvt_pk_bf16(v0[2], v0[3]), pg8::cvt_pk_bf16(v1[0], v1[1]), pg8::cvt_pk_bf16(v1[2], v1[3])};
              }
              *(LAS u32x4*)(KB + row * 72 + c8) = kv4;
#pragma unroll
              for (int j = 0; j < 4; ++j) { VTb[(c8 + 2 * j) * 72 + row] = (bf16_t)(vv4[j] & 0xFFFFu); VTb[(c8 + 2 * j + 1) * 72 + row] = (bf16_t)(vv4[j] >> 16); } }
            __syncthreads();
            bool active = true; int krow = 0;
            if (latent && kb < nwin) { krow = rsA + kb; active = (krow >= rsW) && (krow < rsW + 8); }
            if (active) {
                f32x4 sc[4];
#pragma unroll
                for (int n = 0; n < 4; ++n) { sc[n] = (f32x4){0.f, 0.f, 0.f, 0.f}; sc[n] = mma16(QW, 72, KB + 16 * n * 72, 72, 64, sc[n]); }
                if (latent && kb < nwin) {
                    const float* rp = p.rpb + ((size_t)h * 15 + (krow - rw + 7)) * 31;
#pragma unroll
                    for (int n = 0; n < 4; ++n)
#pragma unroll
                        for (int i = 0; i < 4; ++i) { const int c = ct * 16 + 4 * q + i, kc = 16 * n + r; const int cs = c - 8 < 0 ? 0 : (c - 8 > 48 ? 48 : c - 8);
                            const bool valid = kc >= cs && kc < cs + 16;
                            sc[n][i] = valid ? sc[n][i] * 0.125f + rp[kc - c + 15 < 0 ? 0 : (kc - c + 15 > 30 ? 30 : kc - c + 15)] : -1e30f; }
                } else {
#pragma unroll
                    for (int n = 0; n < 4; ++n) sc[n] = sc[n] * 0.125f; }
                attn_block(st, QW, PW, KB, VTb, sc);
            }
            __syncthreads();
            if (active) attn_pv(st, PW, VTb);
        }
#pragma unroll
        for (int dt = 0; dt < 4; ++dt)
#pragma unroll
            for (int i = 0; i < 4; ++i) AO[(size_t)(qtok0 + 4 * q + i) * DM + h * 64 + 16 * dt + r] = f2bf(st.o[dt][i] / st.l[i]);
    }
}
#define XB_TMO      128
#define XB_XCNT(j)  (256  + 64 * (j))
#define XB_XSUB(j)  (1280 + 64 * (j))
#define XB_XGEN(j)  (2304 + 64 * (j))
#define XB_TOP      3328
#define XB_TOPGEN   3392
#define XCD_BAR_WORDS 3456
#define XB_SPIN_CAP (1u << 18)

__device__ __forceinline__ unsigned xb_ld(unsigned* p)              { return __hip_atomic_load(p, __ATOMIC_RELAXED, __HIP_MEMORY_SCOPE_AGENT); }
__device__ __forceinline__ unsigned xb_add(unsigned* p, unsigned v) { return __hip_atomic_fetch_add(p, v, __ATOMIC_RELAXED, __HIP_MEMORY_SCOPE_AGENT); }
__device__ __forceinline__ unsigned xb_xcc_id() { return (unsigned)__builtin_amdgcn_s_getreg((3 << 11) | 20) & 0xFu; }
#define XB_SPIN(cond, bar) do { unsigned _sp = 0; while (cond) { __builtin_amdgcn_s_sleep(1); \
    if ((++_sp & 255u) == 0u) { if (xb_ld(&(bar)[XB_TMO])) break; if (_sp > XB_SPIN_CAP) { atomicAdd(&(bar)[XB_TMO], 1u); break; } } } } while (0)

struct XcdBarrier {
    unsigned* bar; unsigned x;
    volatile LAS unsigned* st;
};

__device__ __forceinline__ XcdBarrier xcd_barrier_post(unsigned* bar, volatile LAS unsigned* st) {
    XcdBarrier b; b.bar = bar; b.x = xb_xcc_id(); b.st = st;
    if (threadIdx.x == 0) (void)xb_add(&bar[XB_XCNT(b.x)], 1u);
    return b;
}
__device__ __forceinline__ void xcd_barrier_complete(unsigned* bar, unsigned x, unsigned& nloc, unsigned& nx) {
    const unsigned G = gridDim.x * gridDim.y * gridDim.z;
    unsigned sum, cnt, mine, sp = 0u;
    for (;;) {
        sum = 0u; cnt = 0u; mine = 0u;
#pragma unroll
        for (unsigned j = 0; j < 16; ++j) { const unsigned c = xb_ld(&bar[XB_XCNT(j)]); sum += c; cnt += (c > 0u) ? 1u : 0u; mine = (j == x) ? c : mine; }
        if (sum == G) break;
        __builtin_amdgcn_s_sleep(1);
        if ((++sp & 255u) == 0u) { if (xb_ld(&bar[XB_TMO])) break; if (sp > XB_SPIN_CAP) { atomicAdd(&bar[XB_TMO], 1u); break; } }
    }
    nloc = mine > 0u ? mine : 1u; nx = cnt > 0u ? cnt : 1u;
}

__device__ __forceinline__ void xcd_barrier(const XcdBarrier& b) {
    asm volatile("s_waitcnt vmcnt(0)" ::: "memory");
    __syncthreads();
    if (threadIdx.x == 0) {
        unsigned* bar = b.bar;
        __builtin_amdgcn_s_waitcnt(0);
        unsigned nloc = b.st[0], nx = b.st[1];
        if (nloc == 0u) { xcd_barrier_complete(bar, b.x, nloc, nx); b.st[0] = nloc; b.st[1] = nx; }
        const unsigned old = xb_add(&bar[XB_XSUB(b.x)], 1u);
        const unsigned gen = old / nloc;
        if (old + 1u == (gen + 1u) * nloc) {
            __builtin_amdgcn_fence(__ATOMIC_RELEASE, "agent");
            asm volatile("s_waitcnt vmcnt(0)" ::: "memory");
            const unsigned og = xb_add(&bar[XB_TOP], 1u);
            const unsigned tg = og / nx;
            if (og + 1u == (tg + 1u) * nx) xb_add(&bar[XB_TOPGEN], 1u);
            else XB_SPIN(xb_ld(&bar[XB_TOPGEN]) == tg, bar);
            __builtin_amdgcn_fence(__ATOMIC_ACQUIRE, "agent");
            xb_add(&bar[XB_XGEN(b.x)], 1u);
            asm volatile("s_waitcnt vmcnt(0)" ::: "memory");
        } else {
            XB_SPIN(xb_ld(&bar[XB_XGEN(b.x)]) == gen, bar);
            __builtin_amdgcn_fence(__ATOMIC_ACQUIRE, "agent");
            asm volatile("s_waitcnt vmcnt(0)" ::: "memory");
        }
    }
    __syncthreads();
}

template <class Epi> DI void gemm(LAS unsigned char* lds, const bf16_t* A, const bf16_t* Bt, int N, int K, const Epi& E) {
    pg8::Gemm g; g.A = A; g.Bt = Bt; g.M = NTOK; g.N = N; g.K = K;
    pg8::StaticOrder S; S.init(NTOK, N, gridDim.x, blockIdx.x);
    pg8::gemm_phase<Epi, pg8::StaticOrder, false>(lds, g, S, E, nullptr);
}
#define GSYNC(n) xcd_barrier(xb)
constexpr size_t OFF_BAR = 245760;
static_assert(OFF_BAR + XCD_BAR_WORDS * 4 <= OFF_LBS, "bar");
extern __shared__ __attribute__((aligned(16))) unsigned char smem_dyn[];
__global__ void __launch_bounds__(512, 2) fwd_megakernel(Params p) {
    LAS unsigned char* lds = (LAS unsigned char*)smem_dyn;
    if (p.ws == nullptr) { cg::grid_group grid = cg::this_grid(); grid.sync(); }
    volatile LAS unsigned* xst = (volatile LAS unsigned*)(lds + LDS_BYTES - 16);
    if (threadIdx.x < 4) xst[threadIdx.x] = 0u;
    __syncthreads();
    const XcdBarrier xb = xcd_barrier_post((unsigned*)(p.ws + OFF_BAR), xst);
    unsigned char* ws = p.ws;
    const float* mod = (const float*)(ws + OFF_MOD);
    bf16_t* H = (bf16_t*)(ws + OFF_H);
    bf16_t* W0 = (bf16_t*)(ws + OFF_W0); bf16_t* W1 = (bf16_t*)(ws + OFF_W1);
    bf16_t* PROJ = (bf16_t*)(ws + OFF_PROJ);
    float* X1 = p.out;
    float* X2 = (float*)(ws + OFF_X2);
    phase_mod(p, lds); __syncthreads(); phase_w0(p, lds);
    GSYNC(1);
    phase_norm<true>(p, p.xp, p.xs, 0, 0, lds);
    GSYNC(2);
    { pg8::EpiBf<0> E; E.O = PROJ; E.ldc = NPROJ; gemm(lds, H, W0, NPROJ, 1024, E); }
    GSYNC(3);
    phase_prep(p, lds);
    GSYNC(4);
    phase_scan(p, lds);
    GSYNC(5);
    phase_combine(p); __syncthreads(); phase_w1(p, lds);
    GSYNC(6);
    { pg8::EpiRes E; E.out = X1; E.base_p = p.xp; E.base_s = p.xs; E.gate = mod + 2048; gemm(lds, H, W0 + (size_t)NPROJ * DM, 1024, 1024, E); }
    GSYNC(7);
    phase_norm<false>(p, X1, X1 + (size_t)4096 * DM, 0, 1, lds);
    GSYNC(8);
    { pg8::EpiBf<1> E; E.O = PROJ; E.ldc = DFF; gemm(lds, H, W0 + (size_t)NPROJ * DM + (size_t)DM * DM, DFF, 1024, E); }
    GSYNC(9);
    { pg8::EpiRes E; E.out = X2; E.base_p = X1; E.base_s = X1 + (size_t)4096 * DM; E.gate = mod + 5120; gemm(lds, PROJ, W0 + (size_t)NPROJ * DM + (size_t)DM * DM + (size_t)DFF * DM, 1024, DFF, E); }
    GSYNC(10);
    phase_norm<false>(p, X2, X2 + (size_t)4096 * DM, 1, 0, lds);
    GSYNC(11);
    { pg8::EpiBf<0> E; E.O = PROJ; E.ldc = 3072; gemm(lds, H, W1, 3072, 1024, E); }
    GSYNC(12);
    phase_qknorm(p);
    GSYNC(13);
    phase_attn(p, lds);
    GSYNC(14);
    { pg8::EpiRes E; E.out = X1; E.base_p = X2; E.base_s = X2 + (size_t)4096 * DM; E.gate = mod + 5 * NMOD + 2048; gemm(lds, H, W1 + (size_t)3072 * DM, 1024, 1024, E); }
    GSYNC(15);
    phase_norm<false>(p, X1, X1 + (size_t)4096 * DM, 1, 1, lds);
    GSYNC(16);
    { pg8::EpiBf<1> E; E.O = PROJ; E.ldc = DFF; gemm(lds, H, W1 + (size_t)3072 * DM + (size_t)DM * DM, DFF, 1024, E); }
    GSYNC(17);
    { pg8::EpiRes E; E.out = X1; E.base_p = X1; E.base_s = X1 + (size_t)4096 * DM; E.gate = mod + 5 * NMOD + 5120; gemm(lds, PROJ, W1 + (size_t)3072 * DM + (size_t)DM * DM + (size_t)DFF * DM, 1024, DFF, E); }
}

extern "C" void kernel_launch(void* const* d_in, const int* in_sizes, int n_in, void* d_out, int out_size, void* d_ws, size_t ws_size, hipStream_t stream) {
    (void)in_sizes; (void)n_in; (void)out_size;
    static int grid_blocks = 0;
    if (!grid_blocks) {
        int dev = 0, cus = 0, per_cu = 0;
        (void)hipGetDevice(&dev);
        (void)hipDeviceGetAttribute(&cus, hipDeviceAttributeMultiprocessorCount, dev);
        (void)hipFuncSetAttribute((const void*)fwd_megakernel, hipFuncAttributeMaxDynamicSharedMemorySize, LDS_BYTES);
        (void)hipOccupancyMaxActiveBlocksPerMultiprocessor(&per_cu, fwd_megakernel, 512, LDS_BYTES);
        if (per_cu > 1) per_cu = 1;
        grid_blocks = cus * per_cu;
        if (ws_size < WS_NEED) fprintf(stderr, "workspace too small: %zu < %zu\n", ws_size, (size_t)WS_NEED);
    }
    Params p{};
    const float* const* in = (const float* const*)d_in;
    p.xp = in[0]; p.xs = in[1]; p.st_hgrn = in[2]; p.st_gdn = in[3]; p.cache_k = in[4]; p.cache_v = in[5]; p.c = in[6]; p.c_ctx = in[7]; p.ada_w = in[8]; p.ada_b = in[9];
    p.norm_g = in[10]; p.w_in = in[11]; p.w_out_ab = in[12]; p.hgrn_lb = in[13]; p.gdn_conv = in[14]; p.a_log = in[15]; p.dt_bias = in[16]; p.gn_hgrn = in[17]; p.gn_gdn = in[18];
    p.w_qkv = in[19]; p.qn = in[20]; p.kn = in[21]; p.rpb = in[22]; p.w_out_na = in[23]; p.w_mlp1 = in[24]; p.w_mlp2 = in[25];
    p.out = (float*)d_out; p.ws = (unsigned char*)d_ws;
    (void)hipMemsetAsync((unsigned char*)d_ws + OFF_BAR, 0, XCD_BAR_WORDS * 4, stream);
    void* args[] = {&p};
    hipError_t e = hipLaunchCooperativeKernel((const void*)fwd_megakernel, dim3(grid_blocks), dim3(512), args, LDS_BYTES, stream);
    if (e != hipSuccess) fprintf(stderr, "cooperative launch failed: %s (grid %d)\n", hipGetErrorString(e), grid_blocks);
}
```

```cpp
#include <hip/hip_runtime.h>
#include <hip/hip_cooperative_groups.h>
#include <cstdint>
#include <cstdio>
namespace cg = cooperative_groups;
namespace pg8 {
#define PG8_LAS __attribute__((address_space(3)))
typedef unsigned short bf16_t;
typedef short bf16x8 __attribute__((ext_vector_type(8)));
typedef float f32x4 __attribute__((ext_vector_type(4)));
typedef unsigned u32x4 __attribute__((ext_vector_type(4)));
constexpr int BM = 256, BK = 64, HALF = 128, HTB = HALF * BK * 2  , STAGE_BYTES = 8 * HTB, NXCD = 8, WGM = 8;

__host__ __device__ __forceinline__ int lds_byte(int r, int c) { const int st = (r >> 4) * 2 + (c >> 5), rr = r & 15, cc = c & 31, ob = rr * 64 + cc * 2; return st * 1024 + (ob ^ (((ob >> 9) & 1) << 5)); }
__host__ __device__ __forceinline__ void stage_rc(int b, int& R, int& C) { const int st = b / 1024, sb = b % 1024, swz = sb ^ (((sb >> 9) & 1) << 5); R = (st >> 1) * 16 + swz / 64; C = (st & 1) * 32 + (swz % 64) / 2; }
__host__ __device__ __forceinline__ int perm32(int rho) { const int n = rho >> 4, i = rho & 15; return 8 * (i >> 2) + 4 * n + (i & 3); }

struct Unit { int pm, pn; };
struct Gemm { const bf16_t* A; const bf16_t* Bt; int M, N, K; };

struct StaticOrder {
    int nM, nN, nwg, G, c;
    __host__ __device__ void init(int M, int N, int G_, int c_) { nM = M / BM; nN = N / BM; nwg = nM * nN; G = G_; c = c_; }
    __host__ __device__ bool next(int i, Unit& u) const {
        const long L = (long)i * G + c; if (L >= nwg) return false;
        int wgid = (int)L; { const int q = nwg / NXCD, r = nwg % NXCD, xcd = wgid % NXCD, off = wgid / NXCD; wgid = (xcd < r ? xcd * (q + 1) : r * (q + 1) + (xcd - r) * q) + off; }
        const int nig = WGM * nN, gid = wgid / nig, fm = gid * WGM, gsz = (nM - fm) < WGM ? (nM - fm) : WGM;
        u.pm = fm + ((wgid % nig) % gsz); u.pn = (wgid % nig) / gsz; return true;
    }
    __device__ __forceinline__ void a_ready(const Unit&) const {}
    __device__ __forceinline__ void done(const Unit&) const {}
};
__device__ __forceinline__ unsigned cvt_pk_bf16(float lo, float hi) { unsigned r; asm volatile("v_cvt_pk_bf16_f32 %0, %1, %2" : "=v"(r) : "v"(lo), "v"(hi)); return r; }
template <int ACT  > struct EpiBf {
    static constexpr bool PERM = true, AFTER_DRAIN = false;
    bf16_t* O; int ldc;
    __device__ __forceinline__ void operator()(const f32x4 (&acc)[2][2][4][2], const Unit& u, int wr, int wc, int fr, int fq) const {
        const int row0 = u.pm * BM + wr * 64 + fr, col0 = u.pn * BM + wc * 32 + 8 * fq;
#pragma unroll
        for (int ai = 0; ai < 2; ++ai)
#pragma unroll
            for (int m = 0; m < 4; ++m) { bf16_t* rowp = O + (size_t)(row0 + ai * HALF + m * 16) * ldc + col0;
#pragma unroll
                for (int bj = 0; bj < 2; ++bj) { f32x4 v0 = acc[ai][bj][m][0], v1 = acc[ai][bj][m][1];
                    if (ACT == 1) {
#pragma unroll
                        for (int e = 0; e < 4; ++e) { const float a = v0[e] > 0.f ? v0[e] : 0.f, b = v1[e] > 0.f ? v1[e] : 0.f; v0[e] = a * a; v1[e] = b * b; } }
                    u32x4 w; w.x = cvt_pk_bf16(v0[0], v0[1]); w.y = cvt_pk_bf16(v0[2], v0[3]); w.z = cvt_pk_bf16(v1[0], v1[1]); w.w = cvt_pk_bf16(v1[2], v1[3]);
                    *(u32x4*)(rowp + bj * HALF) = w; } }
    }
};
struct EpiRes {
    static constexpr bool PERM = false, AFTER_DRAIN = false;
    float* out; const float* base_p; const float* base_s; const float* gate;
    __device__ __forceinline__ void operator()(const f32x4 (&acc)[2][2][4][2], const Unit& u, int wr, int wc, int fr, int fq) const {
        const int row0 = u.pm * BM + wr * 64 + fr, col0 = u.pn * BM + wc * 32 + 4 * fq;
        const int t0 = u.pm * BM; const int mr = t0 < 4096 ? 0 : 1 + ((t0 - 4096) >> 10);
        const float* gp = gate + (size_t)mr * 6144 + col0;
        f32x4 gv[2][2];
#pragma unroll
        for (int bj = 0; bj < 2; ++bj)
#pragma unroll
            for (int n = 0; n < 2; ++n) gv[bj][n] = *(const f32x4*)(gp + bj * HALF + n * 16);
#pragma unroll
        for (int ai = 0; ai < 2; ++ai)
#pragma unroll
            for (int m = 0; m < 4; ++m) { const int row = row0 + ai * HALF + m * 16;
                const float* bp = (row < 4096 ? base_p + (size_t)row * 1024 : base_s + (size_t)(row - 4096) * 1024) + col0; float* op = out + (size_t)row * 1024 + col0;
#pragma unroll
                for (int bj = 0; bj < 2; ++bj)
#pragma unroll
                    for (int n = 0; n < 2; ++n) { const f32x4 b = *(const f32x4*)(bp + bj * HALF + n * 16); *(f32x4*)(op + bj * HALF + n * 16) = b + gv[bj][n] * acc[ai][bj][m][n]; } }
    }
};

template <class Epi, class Sched, bool STAMP = false>
__device__ __forceinline__ void gemm_phase(PG8_LAS unsigned char* lds, const Gemm g, const Sched& S, const Epi& E, unsigned long long* stamps) {
    const int tid = threadIdx.x, wid = __builtin_amdgcn_readfirstlane(tid >> 6), lane = tid & 63, wr = wid >> 2, wc = wid & 3, fr = lane & 15, fq = lane >> 4;
    const int K = g.K, nt = K / BK;
    int ts_lo = 0, ts_hi = 0, nts = 0; const unsigned long long rt_entry = STAMP ? (unsigned long long)wall_clock64() : 0ull;
#define PG8_STAMP() do { if (STAMP && wid == 0 && nts < 64) { const unsigned long long _c = (unsigned long long)clock64(); \
        ts_lo = (lane == nts) ? (int)(unsigned)_c : ts_lo; ts_hi = (lane == nts) ? (int)(unsigned)(_c >> 32) : ts_hi; ++nts; } } while (0)
    PG8_STAMP();
    unsigned voffA[2], voffB[2];
#pragma unroll
    for (int i = 0; i < 2; ++i) { int R, C; stage_rc(tid * 16 + i * 8192, R, C); const int Rb = Epi::PERM ? ((R & ~31) + perm32(R & 31)) : R;
        voffA[i] = (unsigned)(R * K + C) * 2u; voffB[i] = (unsigned)(Rb * K + C) * 2u; }
    const size_t kstep = (size_t)(BK * 2);
    const size_t hstep = (size_t)HALF * K * 2;
    const size_t tstep = 2 * hstep;
    const unsigned ldsw = (unsigned)wid * 1024u;
    const int aoff = lds_byte(wr * 64 + fr, fq * 8), boff = lds_byte(wc * 32 + fr, fq * 8);
#define PG8_SA(b, h) (((b) * 2 + (h)) * HTB)
#define PG8_SB(b, h) ((4 + (b) * 2 + (h)) * HTB)
#define PG8_STAGE(bufoff, gbase, voff) do { _Pragma("unroll") for (int _i = 0; _i < 2; ++_i) \
        __builtin_amdgcn_global_load_lds((const unsigned*)((const char*)(gbase) + (voff)[_i]), (PG8_LAS unsigned*)(lds + (bufoff) + ldsw + _i * 8192), 16, 0, 0); } while (0)
#define PG8_LDA(dst, b, h) do { _Pragma("unroll") for (int m = 0; m < 4; ++m) _Pragma("unroll") for (int k = 0; k < 2; ++k) dst[m][k] = *(const PG8_LAS bf16x8*)(lds + PG8_SA(b, h) + aoff + m * 2048 + k * 1024); } while (0)
#define PG8_LDB(dst, b, h) do { _Pragma("unroll") for (int n = 0; n < 2; ++n) _Pragma("unroll") for (int k = 0; k < 2; ++k) dst[n][k] = *(const PG8_LAS bf16x8*)(lds + PG8_SB(b, h) + boff + n * 2048 + k * 1024); } while (0)
#define PG8_MMA(ai, bj, At, Bt) do { __builtin_amdgcn_s_setprio(1); _Pragma("unroll") for (int m = 0; m < 4; ++m) _Pragma("unroll") for (int n = 0; n < 2; ++n) _Pragma("unroll") for (int k = 0; k < 2; ++k) \
        acc[ai][bj][m][n] = __builtin_amdgcn_mfma_f32_16x16x32_bf16(Bt[n][k], At[m][k], acc[ai][bj][m][n], 0, 0, 0); __builtin_amdgcn_s_setprio(0); } while (0)
#define PG8_WAIT_V(n) asm volatile("s_waitcnt vmcnt(" #n ")" ::: "memory")
#define PG8_WAIT_L(n) asm volatile("s_waitcnt lgkmcnt(" #n ")" ::: "memory")
#define PG8_BAR __builtin_amdgcn_s_barrier()
#define PG8_SCHED __builtin_amdgcn_sched_barrier(0)
    Unit cur, nxt; int ui = 0;
    if (!S.next(0, cur)) return;
    f32x4 acc[2][2][4][2];
#pragma unroll
    for (int a = 0; a < 2; ++a)
#pragma unroll
        for (int b = 0; b < 2; ++b)
#pragma unroll
            for (int m = 0; m < 4; ++m)
#pragma unroll
                for (int n = 0; n < 2; ++n) acc[a][b][m][n] = (f32x4){0.f, 0.f, 0.f, 0.f};
    bf16x8 At[4][2], B0[2][2], B1[2][2];
    const char* cA = (const char*)g.A + (size_t)cur.pm * tstep; const char* cB = (const char*)g.Bt + (size_t)cur.pn * tstep;
    S.a_ready(cur);
    PG8_STAGE(PG8_SB(0, 0), cB, voffB); PG8_STAGE(PG8_SA(0, 0), cA, voffA); PG8_STAGE(PG8_SB(0, 1), cB + hstep, voffB); PG8_STAGE(PG8_SA(0, 1), cA + hstep, voffA);
    if (wr == 1) PG8_BAR;
    PG8_WAIT_V(4); PG8_BAR;
    PG8_STAGE(PG8_SB(1, 0), cB + kstep, voffB); PG8_STAGE(PG8_SA(1, 0), cA + kstep, voffA); PG8_STAGE(PG8_SB(1, 1), cB + hstep + kstep, voffB);
    PG8_WAIT_V(6); PG8_BAR;
    PG8_STAMP();
    for (;;) {
        const bool has_next = S.next(ui + 1, nxt);
        const char* nA = has_next ? (const char*)g.A + (size_t)nxt.pm * tstep : cA; const char* nB = has_next ? (const char*)g.Bt + (size_t)nxt.pn * tstep : cB;
        for (int t = 0; t < nt; t += 2) {
            const bool last = (t == nt - 2);
            const char* a1 = cA + (size_t)(t + 1) * kstep;
            const char* a2 = last ? nA : cA + (size_t)(t + 2) * kstep; const char* b2 = last ? nB : cB + (size_t)(t + 2) * kstep;
            const char* a3 = a2 + kstep; const char* b3 = b2 + kstep;
            if (last && has_next) S.a_ready(nxt);
            PG8_LDB(B0, 0, 0); PG8_SCHED; PG8_LDA(At, 0, 0); PG8_STAGE(PG8_SA(1, 1), a1 + hstep, voffA);
            PG8_WAIT_L(8); PG8_BAR; PG8_WAIT_L(0); PG8_MMA(0, 0, At, B0); PG8_BAR; PG8_SCHED;
            PG8_LDB(B1, 0, 1); PG8_STAGE(PG8_SB(0, 0), b2, voffB);
            PG8_BAR; PG8_WAIT_L(0); PG8_MMA(0, 1, At, B1); PG8_BAR;
            PG8_LDA(At, 0, 1); PG8_STAGE(PG8_SA(0, 0), a2, voffA);
            PG8_BAR; PG8_WAIT_L(0); PG8_MMA(1, 0, At, B0); PG8_BAR; PG8_SCHED;
            PG8_STAGE(PG8_SB(0, 1), b2 + hstep, voffB);
            PG8_WAIT_V(6); PG8_BAR; PG8_MMA(1, 1, At, B1); PG8_BAR;
            PG8_LDB(B0, 1, 0); PG8_SCHED; PG8_LDA(At, 1, 0); PG8_STAGE(PG8_SA(0, 1), a2 + hstep, voffA);
            PG8_WAIT_L(8); PG8_BAR; PG8_WAIT_L(0); PG8_MMA(0, 0, At, B0); PG8_BAR; PG8_SCHED;
            PG8_LDB(B1, 1, 1); PG8_STAGE(PG8_SB(1, 0), b3, voffB);
            PG8_BAR; PG8_WAIT_L(0); PG8_MMA(0, 1, At, B1); PG8_BAR;
            PG8_LDA(At, 1, 1); PG8_STAGE(PG8_SA(1, 0), a3, voffA);
            PG8_BAR; PG8_WAIT_L(0); PG8_MMA(1, 0, At, B0); PG8_BAR; PG8_SCHED;
            PG8_STAGE(PG8_SB(1, 1), b3 + hstep, voffB);
            PG8_WAIT_V(6); PG8_BAR; PG8_MMA(1, 1, At, B1); PG8_BAR;
        }
        PG8_STAMP();
        if constexpr (!Epi::AFTER_DRAIN) { E(acc, cur, wr, wc, fr, fq); S.done(cur); }
        PG8_STAMP();
        if (!has_next) break;
#pragma unroll
        for (int a = 0; a < 2; ++a)
#pragma unroll
            for (int b = 0; b < 2; ++b)
#pragma unroll
                for (int m = 0; m < 4; ++m)
#pragma unroll
                    for (int n = 0; n < 2; ++n) acc[a][b][m][n] = (f32x4){0.f, 0.f, 0.f, 0.f};
        cur = nxt; cA = nA; cB = nB; ++ui;
    }
    PG8_WAIT_V(0);
    if (wr == 0) PG8_BAR;
    PG8_BAR;
    if constexpr (Epi::AFTER_DRAIN) { E.fused(acc, cur, wr, wc, fr, fq, lds, wid, lane); S.done(cur); }
    PG8_STAMP();
    if (STAMP && wid == 0) { stamps[lane] = lane < nts ? (((unsigned long long)(unsigned)ts_hi << 32) | (unsigned)ts_lo) : 0ull;
        if (lane == 62) stamps[62] = rt_entry; if (lane == 63) stamps[63] = (unsigned long long)wall_clock64(); }
#undef PG8_STAMP
#undef PG8_SA
#undef PG8_SB
#undef PG8_STAGE
#undef PG8_LDA
#undef PG8_LDB
#undef PG8_MMA
#undef PG8_WAIT_V
#undef PG8_WAIT_L
#undef PG8_BAR
#undef PG8_SCHED
}
}

using pg8::bf16_t; using pg8::bf16x8; using pg8::f32x4; using pg8::u32x4;
#define LAS __attribute__((address_space(3)))
#define DI __device__ __forceinline__
typedef float f32x2 __attribute__((ext_vector_type(2)));
typedef unsigned short u16x8 __attribute__((ext_vector_type(8)));
typedef unsigned short u16x4 __attribute__((ext_vector_type(4)));

constexpr int NTOK = 8192, DM = 1024, DFF = 4096, NPROJ = 4608, NPROJ_ALL = 4624, NMOD = 6144;
constexpr int LDS_BYTES = 147456;
constexpr int GDN_PACK_B = 34880, HG_PACK_B = 18944;
constexpr size_t OFF_MOD = 0;
constexpr size_t OFF_LBS = 262144;
constexpr size_t OFF_AB = OFF_LBS + 4096;
constexpr size_t OFF_W0 = OFF_AB + (size_t)NTOK * 16 * 4;
constexpr size_t SZ_WIN = (size_t)NPROJ * DM * 2, SZ_WSQ = (size_t)DM * DM * 2, SZ_WFF = (size_t)DFF * DM * 2;
constexpr size_t OFF_H = OFF_W0 + SZ_WIN + SZ_WSQ + 2 * SZ_WFF;
constexpr size_t OFF_PROJ = OFF_H + (size_t)NTOK * DM * 2;
constexpr size_t OFF_PACK = OFF_PROJ + (size_t)NTOK * NPROJ * 2;
constexpr size_t SZ_GPACK = (size_t)2048 * GDN_PACK_B, SZ_HPACK = (size_t)2048 * HG_PACK_B;
constexpr size_t OFF_O = OFF_PACK + SZ_GPACK + SZ_HPACK;
constexpr size_t WS_NEED = OFF_O + (size_t)2 * NTOK * DM * 2;
constexpr size_t OFF_W1 = OFF_PACK;
constexpr size_t SZ_WQKV = (size_t)3072 * DM * 2;
constexpr size_t OFF_X2 = OFF_W1 + SZ_WQKV + SZ_WSQ + 2 * SZ_WFF;
static_assert(OFF_X2 + (size_t)NTOK * DM * 4 <= OFF_O, "overlay");
static_assert(WS_NEED <= 268435456ull, "workspace");

struct Params {
    const float *xp, *xs, *st_hgrn, *st_gdn, *cache_k, *cache_v, *c, *c_ctx, *ada_w, *ada_b, *norm_g, *w_in, *w_out_ab, *hgrn_lb, *gdn_conv, *a_log, *dt_bias,
        *gn_hgrn, *gn_gdn, *w_qkv, *qn, *kn, *rpb, *w_out_na, *w_mlp1, *w_mlp2;
    float* out; unsigned char* ws;
};

DI bf16_t f2bf(float f) { unsigned u = __float_as_uint(f); u += 0x7FFFu + ((u >> 16) & 1u); return (bf16_t)(u >> 16); }
DI unsigned pack2_safe(float lo, float hi) { return (unsigned)f2bf(lo) | ((unsigned)f2bf(hi) << 16); }
DI float bf2f(bf16_t h) { return __uint_as_float((unsigned)h << 16); }
DI float sigmoidf_(float x) { return 1.0f / (1.0f + __expf(-x)); }
DI float siluf_(float x) { return x / (1.0f + __expf(-x)); }
DI float softplusf_(float x) { return x > 20.f ? x : log1pf(__expf(x)); }
DI float wave_sum(float v) { for (int o = 32; o > 0; o >>= 1) v += __shfl_xor(v, o); return v; }
DI int modrow(int tok) { return tok < 4096 ? 0 : 1 + ((tok - 4096) >> 10); }
DI const float* xrow(const Params& p, int tok) { return tok < 4096 ? p.xp + (size_t)tok * DM : p.xs + (size_t)(tok - 4096) * DM; }

DI f32x4 mma16(const LAS bf16_t* A, int lda, const LAS bf16_t* Bt, int ldb, int K, f32x4 acc) {
    const int lane = threadIdx.x & 63, r = lane & 15, q = lane >> 4;
    const LAS bf16_t* pa = A + r * lda + 8 * q; const LAS bf16_t* pb = Bt + r * ldb + 8 * q;
    for (int k0 = 0; k0 < K; k0 += 32) {
        const bf16x8 a = *(const LAS bf16x8*)(pa + k0), b = *(const LAS bf16x8*)(pb + k0);
        acc = __builtin_amdgcn_mfma_f32_16x16x32_bf16(a, b, acc, 0, 0, 0);
    }
    return acc;
}
DI void phase_mod(const Params& p, LAS unsigned char* lds) {
    LAS float* sc = (LAS float*)lds;
    LAS float* red = (LAS float*)(lds + 20480);
    const int tid = threadIdx.x;
    float* mod = (float*)(p.ws + OFF_MOD);
    for (int e = tid; e < 5 * 1024; e += 512) { const int m = e >> 10, k = e & 1023; const float v = m == 0 ? p.c_ctx[k] : p.c[(m - 1) * 1024 + k]; sc[e] = siluf_(v); }
    __syncthreads();
    for (int cb = blockIdx.x; cb < 256; cb += gridDim.x) {
        const int l = cb >> 7, n0 = (cb & 127) * 48;
        const float* W = p.ada_w + (size_t)l * 1024 * NMOD + n0;
        const int cq = tid % 12, ks = tid / 12;
        float acc[5][4];
#pragma unroll
        for (int m = 0; m < 5; ++m)
#pragma unroll
            for (int j = 0; j < 4; ++j) acc[m][j] = 0.f;
        if (ks < 42) {
            const int k0 = ks * 25, k1 = (k0 + 25 < 1024) ? k0 + 25 : 1024;
            for (int k = k0; k < k1; ++k) {
                const f32x4 w = *(const f32x4*)(W + (size_t)k * NMOD + 4 * cq);
#pragma unroll
                for (int m = 0; m < 5; ++m) { const float s = sc[m * 1024 + k];
#pragma unroll
                    for (int j = 0; j < 4; ++j) acc[m][j] += s * w[j]; }
            }
#pragma unroll
            for (int m = 0; m < 5; ++m)
#pragma unroll
                for (int j = 0; j < 4; ++j) red[(ks * 5 + m) * 48 + 4 * cq + j] = acc[m][j];
        }
        __syncthreads();
        if (tid < 240) { const int m = tid / 48, j = tid % 48; float s = 0.f; for (int k = 0; k < 42; ++k) s += red[(k * 5 + m) * 48 + j];
            mod[((size_t)l * 5 + m) * NMOD + n0 + j] = s + p.ada_b[l * NMOD + n0 + j]; }
        __syncthreads();
    }
    if (blockIdx.x == gridDim.x - 1) {
        float* lbs = (float*)(p.ws + OFF_LBS);
        const float a = p.hgrn_lb[tid], b = p.hgrn_lb[512 + tid], c = p.hgrn_lb[1024 + tid];
        const float mx = fmaxf(a, fmaxf(b, c)); const float ea = __expf(a - mx), eb = __expf(b - mx), ec = __expf(c - mx);
        lbs[tid] = ea / (ea + eb + ec);
    }
}
DI void transpose_tiles(const float* W, int K, int N, int ldw, bf16_t* Wt, int tbase, int ttotal, LAS unsigned char* lds) {
    LAS float* tile = (LAS float*)lds;
    const int tid = threadIdx.x, nk = K / 64, nn = N / 64, nt = nk * nn;
    int g = blockIdx.x; if (g < tbase) g += ((tbase - g + gridDim.x - 1) / gridDim.x) * gridDim.x;
    for (; g < tbase + nt; g += gridDim.x) {
        const int t = g - tbase, tk = t % nk, tn = t / nk, k0 = tk * 64, n0 = tn * 64;
#pragma unroll
        for (int ps = 0; ps < 2; ++ps) { const int row = (tid >> 4) + ps * 32, c4 = tid & 15;
            const f32x4 v = *(const f32x4*)(W + (size_t)(k0 + row) * ldw + n0 + 4 * c4);
            tile[row * 65 + 4 * c4 + 0] = v[0]; tile[row * 65 + 4 * c4 + 1] = v[1]; tile[row * 65 + 4 * c4 + 2] = v[2]; tile[row * 65 + 4 * c4 + 3] = v[3]; }
        __syncthreads();
        { const int n = tid >> 3, k8 = tid & 7; u32x4 w;
          w.x = pg8::cvt_pk_bf16(tile[(k8 * 8 + 0) * 65 + n], tile[(k8 * 8 + 1) * 65 + n]); w.y = pg8::cvt_pk_bf16(tile[(k8 * 8 + 2) * 65 + n], tile[(k8 * 8 + 3) * 65 + n]);
          w.z = pg8::cvt_pk_bf16(tile[(k8 * 8 + 4) * 65 + n], tile[(k8 * 8 + 5) * 65 + n]); w.w = pg8::cvt_pk_bf16(tile[(k8 * 8 + 6) * 65 + n], tile[(k8 * 8 + 7) * 65 + n]);
          *(u32x4*)(Wt + (size_t)(n0 + n) * K + k0 + k8 * 8) = w; }
        __syncthreads();
    }
    (void)ttotal;
}
DI void phase_w0(const Params& p, LAS unsigned char* lds) {
    bf16_t* w = (bf16_t*)(p.ws + OFF_W0);
    int tb = 0;
    transpose_tiles(p.w_in, 1024, NPROJ, NPROJ_ALL, w, tb, 0, lds); tb += 16 * 72;
    transpose_tiles(p.w_out_ab, 1024, 1024, 1024, w + (size_t)NPROJ * DM, tb, 0, lds); tb += 256;
    transpose_tiles(p.w_mlp1, 1024, 4096, 4096, w + (size_t)NPROJ * DM + (size_t)DM * DM, tb, 0, lds); tb += 1024;
    transpose_tiles(p.w_mlp2, 4096, 1024, 1024, w + (size_t)NPROJ * DM + (size_t)DM * DM + (size_t)DFF * DM, tb, 0, lds);
}
DI void phase_w1(const Params& p, LAS unsigned char* lds) {
    bf16_t* w = (bf16_t*)(p.ws + OFF_W1);
    int tb = 0;
    transpose_tiles(p.w_qkv, 1024, 3072, 3072, w, tb, 0, lds); tb += 16 * 48;
    transpose_tiles(p.w_out_na, 1024, 1024, 1024, w + (size_t)3072 * DM, tb, 0, lds); tb += 256;
    transpose_tiles(p.w_mlp1 + (size_t)DM * DFF, 1024, 4096, 4096, w + (size_t)3072 * DM + (size_t)DM * DM, tb, 0, lds); tb += 1024;
    transpose_tiles(p.w_mlp2 + (size_t)DFF * DM, 4096, 1024, 1024, w + (size_t)3072 * DM + (size_t)DM * DM + (size_t)DFF * DM, tb, 0, lds);
}
template <bool AB> DI void phase_norm(const Params& p, const float* srcp, const float* srcs, int l, int sub, LAS unsigned char* lds) {
    const int tid = threadIdx.x, wid = tid >> 6, lane = tid & 63;
    const float* mod = (const float*)(p.ws + OFF_MOD) + (size_t)l * 5 * NMOD;
    const float* gw = p.norm_g + (l * 2 + sub) * 1024;
    bf16_t* H = (bf16_t*)(p.ws + OFF_H);
    LAS float* wab = (LAS float*)lds;
    if (AB) { for (int e = tid; e < 1024 * 16; e += 512) { const int k = e >> 4, j = e & 15; wab[e] = p.w_in[(size_t)k * NPROJ_ALL + NPROJ + j]; } __syncthreads(); }
    float* ab = (float*)(p.ws + OFF_AB);
    for (int tok = blockIdx.x * 8 + wid; tok < NTOK; tok += gridDim.x * 8) {
        const float* xr = tok < 4096 ? srcp + (size_t)tok * 1024 : srcs + (size_t)(tok - 4096) * 1024;
        const int mr = modrow(tok);
        const float* sh = mod + (size_t)mr * NMOD + sub * 3072; const float* scp = sh + 1024;
        f32x4 x[4]; float ss = 0.f;
#pragma unroll
        for (int i = 0; i < 4; ++i) { x[i] = *(const f32x4*)(xr + i * 256 + lane * 4); ss += x[i][0] * x[i][0] + x[i][1] * x[i][1] + x[i][2] * x[i][2] + x[i][3] * x[i][3]; }
        ss = wave_sum(ss);
        const float rs = rsqrtf(ss * (1.0f / 1024.0f) + 1e-6f);
        float pa[16];
        if (AB) {
#pragma unroll
            for (int j = 0; j < 16; ++j) pa[j] = 0.f; }
#pragma unroll
        for (int i = 0; i < 4; ++i) { const int k = i * 256 + lane * 4;
            const f32x4 g4 = *(const f32x4*)(gw + k), s4 = *(const f32x4*)(scp + k), h4 = *(const f32x4*)(sh + k);
            f32x4 hv;
#pragma unroll
            for (int e = 0; e < 4; ++e) hv[e] = x[i][e] * rs * g4[e] * (1.0f + s4[e]) + h4[e];
            uint2 w; w.x = pg8::cvt_pk_bf16(hv[0], hv[1]); w.y = pg8::cvt_pk_bf16(hv[2], hv[3]);
            *(uint2*)(H + (size_t)tok * 1024 + k) = w;
            if (AB) {
#pragma unroll
                for (int e = 0; e < 4; ++e) {
#pragma unroll
                    for (int j4 = 0; j4 < 4; ++j4) { const f32x4 wv = *(const LAS f32x4*)(wab + (k + e) * 16 + 4 * j4);
                        pa[4 * j4 + 0] += hv[e] * wv[0]; pa[4 * j4 + 1] += hv[e] * wv[1]; pa[4 * j4 + 2] += hv[e] * wv[2]; pa[4 * j4 + 3] += hv[e] * wv[3]; } } }
        }
        if (AB) {
            float mine = 0.f;
#pragma unroll
            for (int j = 0; j < 16; ++j) { const float s = wave_sum(pa[j]); if (lane == j) mine = s; }
            if (lane < 16) ab[(size_t)tok * 16 + lane] = mine;
        }
    }
}
DI int chunk_seq_start(int gc) { return gc < 128 ? (gc >> 3) * 256 : 4096 + ((gc - 128) >> 5) * 1024; }
DI int chunk_seq_len(int gc) { return gc < 128 ? 256 : 1024; }
struct PrepRaw { u32x4 v[4]; float ab; };
DI void prep_fetch(const Params& p, int pi, int kind, PrepRaw& R) {
    const int tid = threadIdx.x, h = pi & 3, gc = pi >> 2, t0 = gc * 32;
    const bf16_t* proj = (const bf16_t*)(p.ws + OFF_PROJ);
    if (kind == 0) {
        const int sb = chunk_seq_start(gc), se = sb + chunk_seq_len(gc);
#pragma unroll
        for (int k = 0; k < 4; ++k) { const int pc = tid + k * 512; R.v[k] = (u32x4){0u, 0u, 0u, 0u};
            if (pc < 1728) { const int row = pc / 48, rem = pc % 48, part = rem >> 4, c8 = rem & 15, tk = t0 - 2 + row;
                if (tk >= sb && tk < se) R.v[k] = *(const u32x4*)(proj + (size_t)tk * NPROJ + 2560 + part * 512 + h * 128 + c8 * 8); } }
        R.ab = 0.f;
        if (tid < 128) { const int i = tid >> 2, w = tid & 3;
            R.ab = ((const float*)(p.ws + OFF_AB))[(size_t)(t0 + i) * 16 + w * 4 + h]; }
    } else {
#pragma unroll
        for (int k = 0; k < 3; ++k) { const int pc = tid + k * 512, row = pc / 48, rem = pc % 48, which = rem >> 4, c8 = rem & 15;
            R.v[k] = *(const u32x4*)(proj + (size_t)(t0 + row) * NPROJ + which * 512 + h * 128 + c8 * 8); }
    }
}
DI void gdn_prep_item(const Params& p, int gc, int h, const PrepRaw& R, LAS unsigned char* lds) {
    int tid_ = threadIdx.x; asm volatile("" : "+v"(tid_));
    const int tid = tid_, wid = __builtin_amdgcn_readfirstlane(tid >> 6), lane = tid & 63;
    LAS bf16_t* RAW = (LAS bf16_t*)lds;
    LAS bf16_t* QB = (LAS bf16_t*)(lds + 27648); LAS bf16_t* KB = (LAS bf16_t*)(lds + 36352); LAS bf16_t* VB = (LAS bf16_t*)(lds + 45056);
    LAS float* KK = (LAS float*)(lds + 53760); LAS float* QK = (LAS float*)(lds + 57984);
    LAS float* CW = (LAS float*)(lds + 117248); LAS float* ABL = (LAS float*)(lds + 124928);
#pragma unroll
    for (int k = 0; k < 4; ++k) { const int pc = tid + k * 512; if (pc < 1728) *(LAS u32x4*)(RAW + pc * 8) = R.v[k]; }
    if (tid < 128) ABL[tid] = R.ab;
    __syncthreads();
    { const int i = tid >> 4, cg = tid & 15;
#pragma unroll 1
      for (int part = 0; part < 3; ++part) {
          float a[8];
#pragma unroll
          for (int e = 0; e < 8; ++e) a[e] = 0.f;
#pragma unroll
          for (int j = 0; j < 5; ++j) { const u16x8 x = *(const LAS u16x8*)(RAW + (i + j) * 384 + part * 128 + cg * 8);
              const f32x4 w0 = *(const LAS f32x4*)(CW + j * 384 + part * 128 + cg * 8), w1 = *(const LAS f32x4*)(CW + j * 384 + part * 128 + cg * 8 + 4);
#pragma unroll
              for (int e = 0; e < 4; ++e) { a[e] += bf2f(x[e]) * w0[e]; a[4 + e] += bf2f(x[4 + e]) * w1[e]; } }
          float ss = 0.f;
#pragma unroll
          for (int e = 0; e < 8; ++e) { a[e] = siluf_(a[e]); ss += a[e] * a[e]; }
          float sc = 1.f;
          if (part < 2) { ss += __shfl_xor(ss, 1); ss += __shfl_xor(ss, 2); ss += __shfl_xor(ss, 4); ss += __shfl_xor(ss, 8);
              sc = rsqrtf(ss + 1e-6f) * (part == 0 ? 0.08838834764831845f : 1.f); }
          u32x4 w; w.x = pg8::cvt_pk_bf16(a[0] * sc, a[1] * sc); w.y = pg8::cvt_pk_bf16(a[2] * sc, a[3] * sc); w.z = pg8::cvt_pk_bf16(a[4] * sc, a[5] * sc); w.w = pg8::cvt_pk_bf16(a[6] * sc, a[7] * sc);
          *(LAS u32x4*)(QB + part * 4352 + i * 136 + cg * 8) = w;
      } }
    __syncthreads();
    { const int w4 = wid & 3, mt = w4 >> 1, nt = w4 & 1, r = lane & 15, q = lane >> 4;
      f32x4 acc = {0.f, 0.f, 0.f, 0.f};
      acc = mma16((wid < 4 ? KB : QB) + 16 * mt * 136, 136, KB + 16 * nt * 136, 136, 128, acc);
      LAS float* D = wid < 4 ? KK : QK;
#pragma unroll
      for (int i = 0; i < 4; ++i) D[(16 * mt + 4 * q + i) * 33 + 16 * nt + r] = acc[i]; }
    const int dir = wid >> 2, ht = tid & 255, hw = wid & 3;
    LAS float* GS = (LAS float*)(lds + 62208 + dir * 256); LAS float* AM = (LAS float*)(lds + 62720 + dir * 4224);
    LAS bf16_t* TM = (LAS bf16_t*)(lds + 71168 + dir * 2560); LAS bf16_t* RT = (LAS bf16_t*)(lds + 76288 + dir * 20480);
    bf16_t* pack = (bf16_t*)(p.ws + OFF_PACK + ((size_t)(gc * 4 + h) * 2 + dir) * GDN_PACK_B);
    if (hw == 0) {
        const int pp = lane & 31, i = dir ? 31 - pp : pp;
        const float araw = ABL[i * 4 + dir], braw = ABL[i * 4 + 2 + dir];
        const float beta = sigmoidf_(braw);
        float g = -__expf(p.a_log[dir * 4 + h]) * softplusf_(araw + p.dt_bias[dir * 4 + h]);
#pragma unroll
        for (int o = 1; o < 32; o <<= 1) { const float t = __shfl_up(g, o, 32); if (pp >= o) g += t; }
        if (lane < 32) { GS[pp] = g; GS[32 + pp] = beta; }
    }
    __syncthreads();
    { const int pp = ht >> 3, s0 = (ht & 7) * 4, ip = dir ? 31 - pp : pp; const float gp = GS[pp], bp = GS[32 + pp];
      float at[4];
#pragma unroll
      for (int e = 0; e < 4; ++e) { const int s = s0 + e, is = dir ? 31 - s : s; const float dec = s <= pp ? __expf(gp - GS[s]) : 0.f;
          AM[pp * 33 + s] = s < pp ? bp * KK[ip * 33 + is] * dec : 0.f; at[e] = s <= pp ? QK[ip * 33 + is] * dec : 0.f; }
      uint2 w; w.x = pg8::cvt_pk_bf16(at[0], at[1]); w.y = pg8::cvt_pk_bf16(at[2], at[3]);
      *(uint2*)(pack + 12288 + pp * 32 + s0) = w; }
    __syncthreads();
    if (hw == 0) {
        if (lane < 32) {
            float x[32];
#pragma unroll
            for (int pp = 0; pp < 32; ++pp) {
                float a0 = (pp == lane) ? 1.f : 0.f, a1 = 0.f;
#pragma unroll
                for (int j4 = 0; j4 < (pp + 3) / 4; ++j4) { const LAS float* ar = AM + pp * 33 + 4 * j4;
#pragma unroll
                    for (int e = 0; e < 4; ++e) { const int j = 4 * j4 + e; if (j < pp) { if (e & 1) a1 -= ar[e] * x[j]; else a0 -= ar[e] * x[j]; } } }
                x[pp] = a0 + a1; TM[pp * 40 + lane] = f2bf(a0 + a1);
            }
        }
    } else {
        const float gl = GS[31];
        if (ht == 64) *(float*)((unsigned char*)pack + 34816) = __expf(gl);
        for (int task = ht - 64; task < 2048; task += 192) {
            if (task < 1024) {
                const int row = task >> 2, p0 = (task & 3) * 8, d = row & 127; const LAS bf16_t* src = row < 128 ? KB : VB;
                float o[8];
#pragma unroll
                for (int e = 0; e < 8; ++e) { const int pp = p0 + e, ip = dir ? 31 - pp : pp; const float sc = GS[32 + pp] * (row < 128 ? __expf(GS[pp]) : 1.f); o[e] = bf2f(src[ip * 136 + d]) * sc; }
                u32x4 w; w.x = pg8::cvt_pk_bf16(o[0], o[1]); w.y = pg8::cvt_pk_bf16(o[2], o[3]); w.z = pg8::cvt_pk_bf16(o[4], o[5]); w.w = pg8::cvt_pk_bf16(o[6], o[7]);
                *(LAS u32x4*)(RT + row * 40 + p0) = w;
            } else if (task < 1536) {
                const int t2 = task - 1024, pp = t2 >> 4, d0 = (t2 & 15) * 8, ip = dir ? 31 - pp : pp; const float eg = __expf(GS[pp]);
                const u16x8 x = *(const LAS u16x8*)(QB + ip * 136 + d0);
                u32x4 w; w.x = pg8::cvt_pk_bf16(bf2f(x[0]) * eg, bf2f(x[1]) * eg); w.y = pg8::cvt_pk_bf16(bf2f(x[2]) * eg, bf2f(x[3]) * eg);
                w.z = pg8::cvt_pk_bf16(bf2f(x[4]) * eg, bf2f(x[5]) * eg); w.w = pg8::cvt_pk_bf16(bf2f(x[6]) * eg, bf2f(x[7]) * eg);
                *(u32x4*)(pack + 4096 + pp * 128 + d0) = w;
            } else {
                const int t2 = task - 1536, d = t2 >> 2, p0 = (t2 & 3) * 8;
                float o[8];
#pragma unroll
                for (int e = 0; e < 8; ++e) { const int pp = p0 + e, ip = dir ? 31 - pp : pp; o[e] = bf2f(KB[ip * 136 + d]) * __expf(gl - GS[pp]); }
                u32x4 w; w.x = pg8::cvt_pk_bf16(o[0], o[1]); w.y = pg8::cvt_pk_bf16(o[2], o[3]); w.z = pg8::cvt_pk_bf16(o[4], o[5]); w.w = pg8::cvt_pk_bf16(o[6], o[7]);
                *(u32x4*)(pack + 8192 + d * 32 + p0) = w;
            }
        }
    }
    __syncthreads();
#pragma unroll
    for (int t = 0; t < 8; ++t) { const int id = hw * 8 + t, which = id >> 4, dt = (id >> 1) & 7, pt = id & 1, r = lane & 15, q = lane >> 4;
        f32x4 acc = {0.f, 0.f, 0.f, 0.f};
        acc = mma16(RT + (which * 128 + 16 * dt) * 40, 40, TM + 16 * pt * 40, 40, 32, acc);
        uint2 w; w.x = pack2_safe(acc[0], acc[1]); w.y = pack2_safe(acc[2], acc[3]);
        *(uint2*)(pack + (which ? 13312 : 0) + (16 * pt + r) * 128 + 16 * dt + 4 * q) = w; }
    __syncthreads();
}
template <int PH> DI void hgrn_cols(const Params& p, const LAS bf16_t* RAW, LAS bf16_t* QT, LAS bf16_t* KT, bf16_t* pack, const float* lbs, int h, int dir, int d) {
    const float lb = lbs[h * 128 + d];
    float g[32];
    float acc = 0.f;
#pragma unroll
    for (int pp = 0; pp < 32; ++pp) { const int ip = dir ? 31 - pp : pp; const float fraw = bf2f(RAW[ip * 384 + 128 + dir * 128 + d]);
        acc += __logf(lb + (1.0f - lb) * sigmoidf_(fraw)); g[pp] = acc; }
    const float gl = g[31], gr = g[15];
    if (PH == 1) ((float*)((unsigned char*)pack + 18432))[d] = __expf(gl);
    float kh[16];
#pragma unroll
    for (int e = 0; e < 16; ++e) {
        const int pp = PH * 16 + e, ip = dir ? 31 - pp : pp;
        const float ge = g[pp], gm = pp ? g[pp - 1] : 0.f;
        const float qv = siluf_(bf2f(RAW[ip * 384 + d])) * 0.08838834764831845f, kv = 1.0f - __expf(ge - gm);
        pack[1024 + pp * 128 + d] = f2bf(qv * __expf(ge));
        kh[e] = kv * __expf(gl - ge);
        QT[pp * 136 + d] = f2bf(qv * __expf(ge - gr)); KT[pp * 136 + d] = f2bf(kv * __expf(gr - ge));
    }
    u32x4 w0, w1;
    w0.x = pg8::cvt_pk_bf16(kh[0], kh[1]); w0.y = pg8::cvt_pk_bf16(kh[2], kh[3]); w0.z = pg8::cvt_pk_bf16(kh[4], kh[5]); w0.w = pg8::cvt_pk_bf16(kh[6], kh[7]);
    w1.x = pg8::cvt_pk_bf16(kh[8], kh[9]); w1.y = pg8::cvt_pk_bf16(kh[10], kh[11]); w1.z = pg8::cvt_pk_bf16(kh[12], kh[13]); w1.w = pg8::cvt_pk_bf16(kh[14], kh[15]);
    *(u32x4*)(pack + 5120 + d * 32 + PH * 16) = w0; *(u32x4*)(pack + 5120 + d * 32 + PH * 16 + 8) = w1;
}
DI void hgrn_prep_item(const Params& p, int gc, int h, const PrepRaw& R, LAS unsigned char* lds) {
    int tid_ = threadIdx.x; asm volatile("" : "+v"(tid_));
    const int tid = tid_, wid = __builtin_amdgcn_readfirstlane(tid >> 6), lane = tid & 63;
    LAS bf16_t* RAW = (LAS bf16_t*)lds;
    const float* lbs = (const float*)(p.ws + OFF_LBS);
#pragma unroll
    for (int k = 0; k < 3; ++k) *(LAS u32x4*)(RAW + (tid + k * 512) * 8) = R.v[k];
    __syncthreads();
    const int dir = wid >> 2, ht = tid & 255, hw = wid & 3, d = ht & 127, ph = ht >> 7;
    LAS bf16_t* QT = (LAS bf16_t*)(lds + 24576 + dir * 17408); LAS bf16_t* KT = (LAS bf16_t*)(lds + 33280 + dir * 17408);
    bf16_t* pack = (bf16_t*)(p.ws + OFF_PACK + SZ_GPACK + ((size_t)(gc * 4 + h) * 2 + dir) * HG_PACK_B);
    if (ph == 0) hgrn_cols<0>(p, RAW, QT, KT, pack, lbs, h, dir, d); else hgrn_cols<1>(p, RAW, QT, KT, pack, lbs, h, dir, d);
    __syncthreads();
    { const int mt = hw >> 1, nt = hw & 1, r = lane & 15, q = lane >> 4;
      f32x4 acc = {0.f, 0.f, 0.f, 0.f};
      acc = mma16(QT + 16 * mt * 136, 136, KT + 16 * nt * 136, 136, 128, acc);
#pragma unroll
      for (int i = 0; i < 4; ++i) { const int pp = 16 * mt + 4 * q + i, s = 16 * nt + r; pack[pp * 32 + s] = f2bf(s <= pp ? acc[i] : 0.f); } }
    __syncthreads();
}
DI void phase_prep(const Params& p, LAS unsigned char* lds) {
    const int G = gridDim.x, tid = threadIdx.x;
    LAS float* CW = (LAS float*)(lds + 117248);
    int cwh = -1;
    PrepRaw R;
    int pi = blockIdx.x;
    if (pi < 1024) prep_fetch(p, pi, 0, R);
#pragma unroll 1
    for (; pi < 1024; pi += G) {
        const int h = pi & 3, gc = pi >> 2;
        if (h != cwh) { __syncthreads(); for (int e = tid; e < 5 * 384; e += 512) { const int j = e / 384, c = e % 384; CW[e] = p.gdn_conv[j * 1536 + (c >> 7) * 512 + h * 128 + (c & 127)]; } cwh = h; }
        PrepRaw R2; prep_fetch(p, pi, 1, R2);
        gdn_prep_item(p, gc, h, R, lds);
        if (pi + G < 1024) prep_fetch(p, pi + G, 0, R);
        hgrn_prep_item(p, gc, h, R2, lds);
    }
}
template <bool GDN> DI void scan_item(const Params& p, int s, int h, int dir, LAS unsigned char* lds) {
    const int tid = threadIdx.x, wid = tid >> 6, lane = tid & 63, r = lane & 15, q = lane >> 4, dv0 = wid * 16;
    LAS bf16_t* A0 = (LAS bf16_t*)lds; LAS bf16_t* A1 = (LAS bf16_t*)(lds + 8704); LAS bf16_t* KT = (LAS bf16_t*)(lds + 17408);
    LAS bf16_t* AT = (LAS bf16_t*)(lds + 27648); LAS bf16_t* VT = (LAS bf16_t*)(lds + 30208); LAS float* av = (LAS float*)(lds + 40448);
    LAS bf16_t* ST = (LAS bf16_t*)(lds + 40960 + wid * 4352); LAS bf16_t* VN = (LAS bf16_t*)(lds + 75776 + wid * 1280);
    const int sstart = s < 16 ? s * 256 : 4096 + (s - 16) * 1024, N = s < 16 ? 8 : 32, gc0 = sstart >> 5;
    const bf16_t* proj = (const bf16_t*)(p.ws + OFF_PROJ);
    bf16_t* O = (bf16_t*)(p.ws + OFF_O) + (size_t)dir * NTOK * DM;
    f32x4 S[8];
    if (s >= 16) { const float* st = (GDN ? p.st_gdn : p.st_hgrn) + ((size_t)((s - 16) * 2 + dir) * 4 + h) * 16384;
#pragma unroll
        for (int i = 0; i < 8; ++i)
#pragma unroll
            for (int j = 0; j < 4; ++j) S[i][j] = st[(16 * i + 4 * q + j) * 128 + dv0 + r];
    } else {
#pragma unroll
        for (int i = 0; i < 8; ++i) S[i] = (f32x4){0.f, 0.f, 0.f, 0.f}; }
#pragma unroll
    for (int i = 0; i < 8; ++i)
#pragma unroll
        for (int j = 0; j < 4; ++j) ST[r * 136 + 16 * i + 4 * q + j] = f2bf(S[i][j]);
    for (int m = 0; m < N; ++m) {
        const int n = dir ? N - 1 - m : m, gc = gc0 + n;
        const unsigned char* packb = p.ws + OFF_PACK + (GDN ? 0 : SZ_GPACK) + ((size_t)(gc * 4 + h) * 2 + dir) * (GDN ? GDN_PACK_B : HG_PACK_B);
        const bf16_t* pack = (const bf16_t*)packb;
        __syncthreads();
        { const int row = tid >> 4, c8 = (tid & 15) * 8;
          if (GDN) { *(LAS u32x4*)(A0 + row * 136 + c8) = *(const u32x4*)(pack + tid * 8); *(LAS u32x4*)(A1 + row * 136 + c8) = *(const u32x4*)(pack + 4096 + tid * 8); }
          else *(LAS u32x4*)(A0 + row * 136 + c8) = *(const u32x4*)(pack + 1024 + tid * 8);
          const int kr = tid >> 2, k8 = (tid & 3) * 8;
          *(LAS u32x4*)(KT + kr * 40 + k8) = *(const u32x4*)(pack + (GDN ? 8192 : 5120) + tid * 8);
          if (tid < 128) { const int ar = tid >> 2; *(LAS u32x4*)(AT + ar * 40 + k8) = *(const u32x4*)(pack + (GDN ? 12288 : 0) + tid * 8); }
          if (!GDN) { if (tid < 128) av[tid] = ((const float*)(packb + 18432))[tid];
              for (int e = tid; e < 4096; e += 512) { const int pp = e >> 7, d = e & 127, ip = dir ? 31 - pp : pp;
                  VT[d * 40 + pp] = proj[(size_t)(sstart + 32 * n + ip) * NPROJ + 1536 + h * 128 + d]; } } }
        __syncthreads();
        if (GDN) {
            const float egl = *(const float*)(packb + 34816);
            const bf16_t* up = pack + 13312;
#pragma unroll
            for (int mt = 0; mt < 2; ++mt) { f32x4 acc = {0.f, 0.f, 0.f, 0.f};
                acc = mma16(A0 + 16 * mt * 136, 136, ST, 136, 128, acc);
#pragma unroll
                for (int i = 0; i < 4; ++i) { const int pp = 16 * mt + 4 * q + i; VN[r * 40 + pp] = f2bf(bf2f(up[pp * 128 + dv0 + r]) - acc[i]); } }
            __syncthreads();
#pragma unroll
            for (int mt = 0; mt < 2; ++mt) { f32x4 acc = {0.f, 0.f, 0.f, 0.f};
                acc = mma16(A1 + 16 * mt * 136, 136, ST, 136, 128, acc);
                acc = mma16(AT + 16 * mt * 40, 40, VN, 40, 32, acc);
#pragma unroll
                for (int i = 0; i < 4; ++i) { const int pp = 16 * mt + 4 * q + i, ip = dir ? 31 - pp : pp;
                    O[(size_t)(sstart + 32 * n + ip) * DM + 512 + h * 128 + dv0 + r] = f2bf(acc[i]); } }
#pragma unroll
            for (int i = 0; i < 8; ++i) { S[i] = S[i] * egl; S[i] = mma16(KT + 16 * i * 40, 40, VN, 40, 32, S[i]); }
        } else {
#pragma unroll
            for (int mt = 0; mt < 2; ++mt) { f32x4 acc = {0.f, 0.f, 0.f, 0.f};
                acc = mma16(AT + 16 * mt * 40, 40, VT + dv0 * 40, 40, 32, acc);
                acc = mma16(A0 + 16 * mt * 136, 136, ST, 136, 128, acc);
#pragma unroll
                for (int i = 0; i < 4; ++i) { const int pp = 16 * mt + 4 * q + i, ip = dir ? 31 - pp : pp;
                    O[(size_t)(sstart + 32 * n + ip) * DM + h * 128 + dv0 + r] = f2bf(acc[i]); } }
#pragma unroll
            for (int i = 0; i < 8; ++i) { const f32x4 a4 = *(const LAS f32x4*)(av + 16 * i + 4 * q); S[i] = S[i] * a4; S[i] = mma16(KT + 16 * i * 40, 40, VT + dv0 * 40, 40, 32, S[i]); }
        }
        __syncthreads();
#pragma unroll
        for (int i = 0; i < 8; ++i)
#pragma unroll
            for (int j = 0; j < 4; ++j) ST[r * 136 + 16 * i + 4 * q + j] = f2bf(S[i][j]);
    }
    if (s < 16) { float* so = p.out + (size_t)NTOK * DM + (GDN ? (size_t)2097152 : 0) + ((size_t)(s * 2 + dir) * 4 + h) * 16384;
#pragma unroll
        for (int i = 0; i < 8; ++i)
#pragma unroll
            for (int j = 0; j < 4; ++j) so[(16 * i + 4 * q + j) * 128 + dv0 + r] = S[i][j]; }
    __syncthreads();
}
DI void scan_dispatch(const Params& p, int it, LAS unsigned char* lds) {
    int mixer, dir, h, s;
    if (it < 64) { mixer = it & 1; dir = (it >> 1) & 1; h = (it >> 2) & 3; s = 16 + (it >> 4); }
    else { const int si = it - 64; mixer = si & 1; dir = (si >> 1) & 1; h = (si >> 2) & 3; s = si >> 4; }
    if (mixer) scan_item<true>(p, s, h, dir, lds); else scan_item<false>(p, s, h, dir, lds);
}
DI void phase_scan(const Params& p, LAS unsigned char* lds) {
    const int b = blockIdx.x, G = gridDim.x;
    if (G == 256) { scan_dispatch(p, b, lds); if (b >= 64 && b < 128) scan_dispatch(p, 256 + b - 64, lds); }
    else for (int it = b; it < 320; it += G) scan_dispatch(p, it, lds);
}
DI void phase_combine(const Params& p) {
    const int tid = threadIdx.x, wid = tid >> 6, lane = tid & 63;
    const bf16_t* O0 = (const bf16_t*)(p.ws + OFF_O); const bf16_t* O1 = O0 + (size_t)NTOK * DM;
    const bf16_t* proj = (const bf16_t*)(p.ws + OFF_PROJ);
    bf16_t* H = (bf16_t*)(p.ws + OFF_H);
    const int mixer = lane >> 5, d0 = (lane & 7) * 16, gcol = (mixer ? 4096 : 2048) + ((16 * lane) & 511);
    const float* gn = (mixer ? p.gn_gdn : p.gn_hgrn) + d0;
    for (int tok = blockIdx.x * 8 + wid; tok < NTOK; tok += gridDim.x * 8) {
        const u16x8 a0 = *(const u16x8*)(O0 + (size_t)tok * DM + 16 * lane), a1 = *(const u16x8*)(O0 + (size_t)tok * DM + 16 * lane + 8);
        const u16x8 b0 = *(const u16x8*)(O1 + (size_t)tok * DM + 16 * lane), b1 = *(const u16x8*)(O1 + (size_t)tok * DM + 16 * lane + 8);
        const u16x8 g0 = *(const u16x8*)(proj + (size_t)tok * NPROJ + gcol), g1 = *(const u16x8*)(proj + (size_t)tok * NPROJ + gcol + 8);
        float v[16]; float ss = 0.f;
#pragma unroll
        for (int j = 0; j < 8; ++j) { v[j] = bf2f(a0[j]) + bf2f(b0[j]); v[8 + j] = bf2f(a1[j]) + bf2f(b1[j]); }
#pragma unroll
        for (int j = 0; j < 16; ++j) ss += v[j] * v[j];
        ss += __shfl_xor(ss, 1); ss += __shfl_xor(ss, 2); ss += __shfl_xor(ss, 4);
        const float rs = rsqrtf(ss * (1.0f / 128.0f) + 1e-6f);
        unsigned w[8];
#pragma unroll
        for (int j = 0; j < 8; ++j) { const float ga = bf2f(j < 4 ? g0[2 * j] : g1[2 * j - 8]), gb = bf2f(j < 4 ? g0[2 * j + 1] : g1[2 * j - 7]);
            w[j] = pg8::cvt_pk_bf16(v[2 * j] * rs * gn[2 * j] * siluf_(ga), v[2 * j + 1] * rs * gn[2 * j + 1] * siluf_(gb)); }
        *(u32x4*)(H + (size_t)tok * DM + 16 * lane) = (u32x4){w[0], w[1], w[2], w[3]};
        *(u32x4*)(H + (size_t)tok * DM + 16 * lane + 8) = (u32x4){w[4], w[5], w[6], w[7]};
    }
}
DI void phase_qknorm(const Params& p) {
    const int tid = threadIdx.x, wid = tid >> 6, lane = tid & 63;
    const bf16_t* QKV = (const bf16_t*)(p.ws + OFF_PROJ);
    bf16_t* QN = (bf16_t*)(p.ws + OFF_O); bf16_t* KN = QN + (size_t)NTOK * DM;
    float* ck = p.out + (size_t)NTOK * DM + 2 * 2097152; float* cv = ck + 4194304;
    const int hd = lane >> 2, d0 = (lane & 3) * 16;
    for (int tok = blockIdx.x * 8 + wid; tok < NTOK; tok += gridDim.x * 8) {
#pragma unroll
        for (int part = 0; part < 2; ++part) {
            const bf16_t* src = QKV + (size_t)tok * 3072 + part * 1024 + 16 * lane;
            const u16x8 a0 = *(const u16x8*)src, a1 = *(const u16x8*)(src + 8);
            float v[16]; float ss = 0.f;
#pragma unroll
            for (int j = 0; j < 8; ++j) { v[j] = bf2f(a0[j]); v[8 + j] = bf2f(a1[j]); }
#pragma unroll
            for (int j = 0; j < 16; ++j) ss += v[j] * v[j];
            ss += __shfl_xor(ss, 1); ss += __shfl_xor(ss, 2);
            const float rs = rsqrtf(ss * (1.0f / 64.0f) + 1e-6f);
            const float* gw = (part ? p.kn : p.qn) + d0;
#pragma unroll
            for (int j = 0; j < 16; ++j) v[j] = v[j] * rs * gw[j];
            unsigned w[8];
#pragma unroll
            for (int j = 0; j < 8; ++j) w[j] = pg8::cvt_pk_bf16(v[2 * j], v[2 * j + 1]);
            bf16_t* dst = (part ? KN : QN) + (size_t)tok * DM + 16 * lane;
            *(u32x4*)dst = (u32x4){w[0], w[1], w[2], w[3]}; *(u32x4*)(dst + 8) = (u32x4){w[4], w[5], w[6], w[7]};
            if (part == 1 && tok < 4096) { float* o = ck + (((size_t)(tok >> 8) * 16 + hd) * 256 + (tok & 255)) * 64 + d0;
#pragma unroll
                for (int j4 = 0; j4 < 4; ++j4) *(f32x4*)(o + 4 * j4) = (f32x4){v[4 * j4], v[4 * j4 + 1], v[4 * j4 + 2], v[4 * j4 + 3]}; }
        }
        if (tok < 4096) { const bf16_t* src = QKV + (size_t)tok * 3072 + 2048 + 16 * lane;
            const u16x8 a0 = *(const u16x8*)src, a1 = *(const u16x8*)(src + 8);
            float* o = cv + (((size_t)(tok >> 8) * 16 + hd) * 256 + (tok & 255)) * 64 + d0;
            *(f32x4*)(o) = (f32x4){bf2f(a0[0]), bf2f(a0[1]), bf2f(a0[2]), bf2f(a0[3])}; *(f32x4*)(o + 4) = (f32x4){bf2f(a0[4]), bf2f(a0[5]), bf2f(a0[6]), bf2f(a0[7])};
            *(f32x4*)(o + 8) = (f32x4){bf2f(a1[0]), bf2f(a1[1]), bf2f(a1[2]), bf2f(a1[3])}; *(f32x4*)(o + 12) = (f32x4){bf2f(a1[4]), bf2f(a1[5]), bf2f(a1[6]), bf2f(a1[7])}; }
    }
}
struct AttnState { f32x4 o[4]; float m[4], l[4]; };
DI void attn_block(AttnState& st, const LAS bf16_t* QW, LAS bf16_t* PW, const LAS bf16_t* KB, const LAS bf16_t* VTb, f32x4 (&sc)[4]) {
    const int lane = threadIdx.x & 63, r = lane & 15, q = lane >> 4;
    float alpha[4];
#pragma unroll
    for (int i = 0; i < 4; ++i) {
        float mx = fmaxf(fmaxf(sc[0][i], sc[1][i]), fmaxf(sc[2][i], sc[3][i]));
        mx = fmaxf(mx, __shfl_xor(mx, 1)); mx = fmaxf(mx, __shfl_xor(mx, 2)); mx = fmaxf(mx, __shfl_xor(mx, 4)); mx = fmaxf(mx, __shfl_xor(mx, 8));
        const float mn = fmaxf(st.m[i], mx); alpha[i] = __expf(st.m[i] - mn); st.m[i] = mn;
        float rsum = 0.f;
#pragma unroll
        for (int n = 0; n < 4; ++n) { const float pv = __expf(sc[n][i] - mn); rsum += pv; PW[(4 * q + i) * 72 + 16 * n + r] = f2bf(pv); }
        rsum += __shfl_xor(rsum, 1); rsum += __shfl_xor(rsum, 2); rsum += __shfl_xor(rsum, 4); rsum += __shfl_xor(rsum, 8);
        st.l[i] = st.l[i] * alpha[i] + rsum;
    }
#pragma unroll
    for (int dt = 0; dt < 4; ++dt) {
#pragma unroll
        for (int i = 0; i < 4; ++i) st.o[dt][i] *= alpha[i]; }
    (void)QW; (void)KB; (void)VTb;
}
DI void attn_pv(AttnState& st, const LAS bf16_t* PW, const LAS bf16_t* VTb) {
#pragma unroll
    for (int dt = 0; dt < 4; ++dt) st.o[dt] = mma16(PW, 72, VTb + 16 * dt * 72, 72, 64, st.o[dt]);
}
DI void phase_attn(const Params& p, LAS unsigned char* lds) {
    const int tid = threadIdx.x, wid = tid >> 6, lane = tid & 63, r = lane & 15, q = lane >> 4;
    LAS bf16_t* KB = (LAS bf16_t*)lds; LAS bf16_t* VTb = (LAS bf16_t*)(lds + 9216);
    LAS bf16_t* QW = (LAS bf16_t*)(lds + 18432 + wid * 2304); LAS bf16_t* PW = (LAS bf16_t*)(lds + 36864 + wid * 2304);
    const bf16_t* QN = (const bf16_t*)(p.ws + OFF_O); const bf16_t* KN = QN + (size_t)NTOK * DM;
    const bf16_t* QKV = (const bf16_t*)(p.ws + OFF_PROJ);
    bf16_t* AO = (bf16_t*)(p.ws + OFF_H);
    for (int it = blockIdx.x; it < 1024; it += gridDim.x) {
        const bool latent = it >= 512; const int id = it & 511;
        int h, qtok0;
        int b = 0, r0 = 0, rw = 0, ct = 0, nblk;
        if (!latent) { b = id >> 5; h = (id >> 1) & 15; const int qb = id & 1; qtok0 = b * 256 + qb * 128 + wid * 16; nblk = 4; }
        else { b = id >> 7; h = (id >> 3) & 15; const int rp = id & 7; r0 = 2 * rp; rw = r0 + (wid >> 2); ct = wid & 3; qtok0 = 4096 + b * 1024 + rw * 64 + ct * 16; nblk = 0; }
        __syncthreads();
        { const int row = lane >> 2, c16 = (lane & 3) * 16; const bf16_t* src = QN + (size_t)(qtok0 + row) * DM + h * 64 + c16;
          *(LAS u32x4*)(QW + row * 72 + c16) = *(const u32x4*)src; *(LAS u32x4*)(QW + row * 72 + c16 + 8) = *(const u32x4*)(src + 8); }
        AttnState st;
#pragma unroll
        for (int i = 0; i < 4; ++i) { st.o[i] = (f32x4){0.f, 0.f, 0.f, 0.f}; st.m[i] = -1e30f; st.l[i] = 0.f; }
        int rsA = 0, rsW = 0, nwin = 0;
        if (latent) { rsA = r0 - 4 < 0 ? 0 : (r0 - 4 > 8 ? 8 : r0 - 4); const int r1 = r0 + 1; const int rsB = r1 - 4 < 0 ? 0 : (r1 - 4 > 8 ? 8 : r1 - 4);
            rsW = (wid >> 2) ? rsB : rsA; nwin = rsB + 8 - rsA; nblk = nwin + 4; }
        for (int kb = 0; kb < nblk; ++kb) {
            __syncthreads();
            { const int row = tid >> 3, c8 = (tid & 7) * 8;
              u32x4 kv4, vv4;
              if (!latent || kb < nwin) {
                  const int ktok = !latent ? b * 256 + kb * 64 + row : 4096 + b * 1024 + (rsA + kb) * 64 + row;
                  kv4 = *(const u32x4*)(KN + (size_t)ktok * DM + h * 64 + c8); vv4 = *(const u32x4*)(QKV + (size_t)ktok * 3072 + 2048 + h * 64 + c8);
              } else {
                  const size_t co = (((size_t)b * 16 + h) * 256 + (kb - nwin) * 64 + row) * 64 + c8;
                  const f32x4 k0 = *(const f32x4*)(p.cache_k + co), k1 = *(const f32x4*)(p.cache_k + co + 4), v0 = *(const f32x4*)(p.cache_v + co), v1 = *(const f32x4*)(p.cache_v + co + 4);
                  kv4 = (u32x4){pg8::cvt_pk_bf16(k0[0], k0[1]), pg8::cvt_pk_bf16(k0[2], k0[3]), pg8::cvt_pk_bf16(k1[0], k1[1]), pg8::cvt_pk_bf16(k1[2], k1[3])};
                  vv4 = (u32x4){pg8::cvt_pk_bf16(v0[0], v0[1]), pg8::cvt_pk_bf16(v0[2], v0[3]), pg8::cvt_pk_bf16(v1[0], v1[1]), pg8::cvt_pk_bf16(v1[2], v1[3])};
              }
              *(LAS u32x4*)(KB + row * 72 + c8) = kv4;
#pragma unroll
              for (int j = 0; j < 4; ++j) { VTb[(c8 + 2 * j) * 72 + row] = (bf16_t)(vv4[j] & 0xFFFFu); VTb[(c8 + 2 * j + 1) * 72 + row] = (bf16_t)(vv4[j] >> 16); } }
            __syncthreads();
            bool active = true; int krow = 0;
            if (latent && kb < nwin) { krow = rsA + kb; active = (krow >= rsW) && (krow < rsW + 8); }
            if (active) {
                f32x4 sc[4];
#pragma unroll
                for (int n = 0; n < 4; ++n) { sc[n] = (f32x4){0.f, 0.f, 0.f, 0.f}; sc[n] = mma16(QW, 72, KB + 16 * n * 72, 72, 64, sc[n]); }
                if (latent && kb < nwin) {
                    const float* rp = p.rpb + ((size_t)h * 15 + (krow - rw + 7)) * 31;
#pragma unroll
                    for (int n = 0; n < 4; ++n)
#pragma unroll
                        for (int i = 0; i < 4; ++i) { const int c = ct * 16 + 4 * q + i, kc = 16 * n + r; const int cs = c - 8 < 0 ? 0 : (c - 8 > 48 ? 48 : c - 8);
                            const bool valid = kc >= cs && kc < cs + 16;
                            sc[n][i] = valid ? sc[n][i] * 0.125f + rp[kc - c + 15 < 0 ? 0 : (kc - c + 15 > 30 ? 30 : kc - c + 15)] : -1e30f; }
                } else {
#pragma unroll
                    for (int n = 0; n < 4; ++n) sc[n] = sc[n] * 0.125f; }
                attn_block(st, QW, PW, KB, VTb, sc);
            }
            __syncthreads();
            if (active) attn_pv(st, PW, VTb);
        }
#pragma unroll
        for (int dt = 0; dt < 4; ++dt)
#pragma unroll
            for (int i = 0; i < 4; ++i) AO[(size_t)(qtok0 + 4 * q + i) * DM + h * 64 + 16 * dt + r] = f2bf(st.o[dt][i] / st.l[i]);
    }
}
#define XB_TMO      128
#define XB_XCNT(j)  (256  + 64 * (j))
#define XB_XSUB(j)  (1280 + 64 * (j))
#define XB_XGEN(j)  (2304 + 64 * (j))
#define XB_TOP      3328
#define XB_TOPGEN   3392
#define XCD_BAR_WORDS 3456
#define XB_SPIN_CAP (1u << 18)

__device__ __forceinline__ unsigned xb_ld(unsigned* p)              { return __hip_atomic_load(p, __ATOMIC_RELAXED, __HIP_MEMORY_SCOPE_AGENT); }
__device__ __forceinline__ unsigned xb_add(unsigned* p, unsigned v) { return __hip_atomic_fetch_add(p, v, __ATOMIC_RELAXED, __HIP_MEMORY_SCOPE_AGENT); }
__device__ __forceinline__ unsigned xb_xcc_id() { return (unsigned)__builtin_amdgcn_s_getreg((3 << 11) | 20) & 0xFu; }
#define XB_SPIN(cond, bar) do { unsigned _sp = 0; while (cond) { __builtin_amdgcn_s_sleep(1); \
    if ((++_sp & 255u) == 0u) { if (xb_ld(&(bar)[XB_TMO])) break; if (_sp > XB_SPIN_CAP) { atomicAdd(&(bar)[XB_TMO], 1u); break; } } } } while (0)

struct XcdBarrier {
    unsigned* bar; unsigned x;
    volatile LAS unsigned* st;
};

__device__ __forceinline__ XcdBarrier xcd_barrier_post(unsigned* bar, volatile LAS unsigned* st) {
    XcdBarrier b; b.bar = bar; b.x = xb_xcc_id(); b.st = st;
    if (threadIdx.x == 0) (void)xb_add(&bar[XB_XCNT(b.x)], 1u);
    return b;
}
__device__ __forceinline__ void xcd_barrier_complete(unsigned* bar, unsigned x, unsigned& nloc, unsigned& nx) {
    const unsigned G = gridDim.x * gridDim.y * gridDim.z;
    unsigned sum, cnt, mine, sp = 0u;
    for (;;) {
        sum = 0u; cnt = 0u; mine = 0u;
#pragma unroll
        for (unsigned j = 0; j < 16; ++j) { const unsigned c = xb_ld(&bar[XB_XCNT(j)]); sum += c; cnt += (c > 0u) ? 1u : 0u; mine = (j == x) ? c : mine; }
        if (sum == G) break;
        __builtin_amdgcn_s_sleep(1);
        if ((++sp & 255u) == 0u) { if (xb_ld(&bar[XB_TMO])) break; if (sp > XB_SPIN_CAP) { atomicAdd(&bar[XB_TMO], 1u); break; } }
    }
    nloc = mine > 0u ? mine : 1u; nx = cnt > 0u ? cnt : 1u;
}

__device__ __forceinline__ void xcd_barrier(const XcdBarrier& b) {
    asm volatile("s_waitcnt vmcnt(0)" ::: "memory");
    __syncthreads();
    if (threadIdx.x == 0) {
        unsigned* bar = b.bar;
        __builtin_amdgcn_s_waitcnt(0);
        unsigned nloc = b.st[0], nx = b.st[1];
        if (nloc == 0u) { xcd_barrier_complete(bar, b.x, nloc, nx); b.st[0] = nloc; b.st[1] = nx; }
        const unsigned old = xb_add(&bar[XB_XSUB(b.x)], 1u);
        const unsigned gen = old / nloc;
        if (old + 1u == (gen + 1u) * nloc) {
            __builtin_amdgcn_fence(__ATOMIC_RELEASE, "agent");
            asm volatile("s_waitcnt vmcnt(0)" ::: "memory");
            const unsigned og = xb_add(&bar[XB_TOP], 1u);
            const unsigned tg = og / nx;
            if (og + 1u == (tg + 1u) * nx) xb_add(&bar[XB_TOPGEN], 1u);
            else XB_SPIN(xb_ld(&bar[XB_TOPGEN]) == tg, bar);
            __builtin_amdgcn_fence(__ATOMIC_ACQUIRE, "agent");
            xb_add(&bar[XB_XGEN(b.x)], 1u);
            asm volatile("s_waitcnt vmcnt(0)" ::: "memory");
        } else {
            XB_SPIN(xb_ld(&bar[XB_XGEN(b.x)]) == gen, bar);
            __builtin_amdgcn_fence(__ATOMIC_ACQUIRE, "agent");
            asm volatile("s_waitcnt vmcnt(0)" ::: "memory");
        }
    }
    __syncthreads();
}

template <class Epi> DI void gemm(LAS unsigned char* lds, const bf16_t* A, const bf16_t* Bt, int N, int K, const Epi& E) {
    pg8::Gemm g; g.A = A; g.Bt = Bt; g.M = NTOK; g.N = N; g.K = K;
    pg8::StaticOrder S; S.init(NTOK, N, gridDim.x, blockIdx.x);
    pg8::gemm_phase<Epi, pg8::StaticOrder, false>(lds, g, S, E, nullptr);
}
#define GSYNC(n) xcd_barrier(xb)
#ifndef REPEAT_MASK
#define REPEAT_MASK 0
#endif
#define PH(n, ...) do { __VA_ARGS__; if ((REPEAT_MASK >> (n)) & 1) { xcd_barrier(xb); __VA_ARGS__; } } while (0)
constexpr size_t OFF_BAR = 245760;
static_assert(OFF_BAR + XCD_BAR_WORDS * 4 <= OFF_LBS, "bar");
extern __shared__ __attribute__((aligned(16))) unsigned char smem_dyn[];
__global__ void __launch_bounds__(512, 2) fwd_megakernel(Params p) {
    LAS unsigned char* lds = (LAS unsigned char*)smem_dyn;
    if (p.ws == nullptr) { cg::grid_group grid = cg::this_grid(); grid.sync(); }
    volatile LAS unsigned* xst = (volatile LAS unsigned*)(lds + LDS_BYTES - 16);
    if (threadIdx.x < 4) xst[threadIdx.x] = 0u;
    __syncthreads();
    const XcdBarrier xb = xcd_barrier_post((unsigned*)(p.ws + OFF_BAR), xst);
    unsigned char* ws = p.ws;
    const float* mod = (const float*)(ws + OFF_MOD);
    bf16_t* H = (bf16_t*)(ws + OFF_H);
    bf16_t* W0 = (bf16_t*)(ws + OFF_W0); bf16_t* W1 = (bf16_t*)(ws + OFF_W1);
    bf16_t* PROJ = (bf16_t*)(ws + OFF_PROJ);
    float* X1 = p.out;
    float* X2 = (float*)(ws + OFF_X2);
    PH(0, phase_mod(p, lds); __syncthreads(); phase_w0(p, lds));
    GSYNC(1);
    PH(1, phase_norm<true>(p, p.xp, p.xs, 0, 0, lds));
    GSYNC(2);
    PH(2, { pg8::EpiBf<0> E; E.O = PROJ; E.ldc = NPROJ; gemm(lds, H, W0, NPROJ, 1024, E); });
    GSYNC(3);
    PH(3, phase_prep(p, lds));
    GSYNC(4);
    PH(4, phase_scan(p, lds));
    GSYNC(5);
    PH(5, phase_combine(p); __syncthreads(); phase_w1(p, lds));
    GSYNC(6);
    PH(6, { pg8::EpiRes E; E.out = X1; E.base_p = p.xp; E.base_s = p.xs; E.gate = mod + 2048; gemm(lds, H, W0 + (size_t)NPROJ * DM, 1024, 1024, E); });
    GSYNC(7);
    PH(7, phase_norm<false>(p, X1, X1 + (size_t)4096 * DM, 0, 1, lds));
    GSYNC(8);
    PH(8, { pg8::EpiBf<1> E; E.O = PROJ; E.ldc = DFF; gemm(lds, H, W0 + (size_t)NPROJ * DM + (size_t)DM * DM, DFF, 1024, E); });
    GSYNC(9);
    PH(9, { pg8::EpiRes E; E.out = X2; E.base_p = X1; E.base_s = X1 + (size_t)4096 * DM; E.gate = mod + 5120; gemm(lds, PROJ, W0 + (size_t)NPROJ * DM + (size_t)DM * DM + (size_t)DFF * DM, 1024, DFF, E); });
    GSYNC(10);
    PH(10, phase_norm<false>(p, X2, X2 + (size_t)4096 * DM, 1, 0, lds));
    GSYNC(11);
    PH(11, { pg8::EpiBf<0> E; E.O = PROJ; E.ldc = 3072; gemm(lds, H, W1, 3072, 1024, E); });
    GSYNC(12);
    PH(12, phase_qknorm(p));
    GSYNC(13);
    PH(13, phase_attn(p, lds));
    GSYNC(14);
    PH(14, { pg8::EpiRes E; E.out = X1; E.base_p = X2; E.base_s = X2 + (size_t)4096 * DM; E.gate = mod + 5 * NMOD + 2048; gemm(lds, H, W1 + (size_t)3072 * DM, 1024, 1024, E); });
    GSYNC(15);
    PH(15, phase_norm<false>(p, X1, X1 + (size_t)4096 * DM, 1, 1, lds));
    GSYNC(16);
    PH(16, { pg8::EpiBf<1> E; E.O = PROJ; E.ldc = DFF; gemm(lds, H, W1 + (size_t)3072 * DM + (size_t)DM * DM, DFF, 1024, E); });
    GSYNC(17);
    { pg8::EpiRes E; E.out = X1; E.base_p = X1; E.base_s = X1 + (size_t)4096 * DM; E.gate = mod + 5 * NMOD + 5120; gemm(lds, PROJ, W1 + (size_t)3072 * DM + (size_t)DM * DM + (size_t)DFF * DM, 1024, DFF, E); }
}

extern "C" void kernel_launch(void* const* d_in, const int* in_sizes, int n_in, void* d_out, int out_size, void* d_ws, size_t ws_size, hipStream_t stream) {
    (void)in_sizes; (void)n_in; (void)out_size;
    static int grid_blocks = 0;
    if (!grid_blocks) {
        int dev = 0, cus = 0, per_cu = 0;
        (void)hipGetDevice(&dev);
        (void)hipDeviceGetAttribute(&cus, hipDeviceAttributeMultiprocessorCount, dev);
        (void)hipFuncSetAttribute((const void*)fwd_megakernel, hipFuncAttributeMaxDynamicSharedMemorySize, LDS_BYTES);
        (void)hipOccupancyMaxActiveBlocksPerMultiprocessor(&per_cu, fwd_megakernel, 512, LDS_BYTES);
        if (per_cu > 1) per_cu = 1;
        grid_blocks = cus * per_cu;
        if (ws_size < WS_NEED) fprintf(stderr, "workspace too small: %zu < %zu\n", ws_size, (size_t)WS_NEED);
    }
    Params p{};
    const float* const* in = (const float* const*)d_in;
    p.xp = in[0]; p.xs = in[1]; p.st_hgrn = in[2]; p.st_gdn = in[3]; p.cache_k = in[4]; p.cache_v = in[5]; p.c = in[6]; p.c_ctx = in[7]; p.ada_w = in[8]; p.ada_b = in[9];
    p.norm_g = in[10]; p.w_in = in[11]; p.w_out_ab = in[12]; p.hgrn_lb = in[13]; p.gdn_conv = in[14]; p.a_log = in[15]; p.dt_bias = in[16]; p.gn_hgrn = in[17]; p.gn_gdn = in[18];
    p.w_qkv = in[19]; p.qn = in[20]; p.kn = in[21]; p.rpb = in[22]; p.w_out_na = in[23]; p.w_mlp1 = in[24]; p.w_mlp2 = in[25];
    p.out = (float*)d_out; p.ws = (unsigned char*)d_ws;
    (void)hipMemsetAsync((unsigned char*)d_ws + OFF_BAR, 0, XCD_BAR_WORDS * 4, stream);
    void* args[] = {&p};
    hipError_t e = hipLaunchCooperativeKernel((const void*)fwd_megakernel, dim3(grid_blocks), dim3(512), args, LDS_BYTES, stream);
    if (e != hipSuccess) fprintf(stderr, "cooperative launch failed: %s (grid %d)\n", hipGetErrorString(e), grid_blocks);
}
```

```cpp
#include <hip/hip_runtime.h>
#include <hip/hip_cooperative_groups.h>
#include <cstdint>
#include <cstdio>
namespace cg = cooperative_groups;
namespace pg8 {
#define PG8_LAS __attribute__((address_space(3)))
typedef unsigned short bf16_t;
typedef short bf16x8 __attribute__((ext_vector_type(8)));
typedef float f32x4 __attribute__((ext_vector_type(4)));
typedef unsigned u32x4 __attribute__((ext_vector_type(4)));
constexpr int BM = 256, BK = 64, HALF = 128, HTB = HALF * BK * 2  , STAGE_BYTES = 8 * HTB, NXCD = 8, WGM = 8;

__host__ __device__ __forceinline__ int lds_byte(int r, int c) { const int st = (r >> 4) * 2 + (c >> 5), rr = r & 15, cc = c & 31, ob = rr * 64 + cc * 2; return st * 1024 + (ob ^ (((ob >> 9) & 1) << 5)); }
__host__ __device__ __forceinline__ void stage_rc(int b, int& R, int& C) { const int st = b / 1024, sb = b % 1024, swz = sb ^ (((sb >> 9) & 1) << 5); R = (st >> 1) * 16 + swz / 64; C = (st & 1) * 32 + (swz % 64) / 2; }
__host__ __device__ __forceinline__ int perm32(int rho) { const int n = rho >> 4, i = rho & 15; return 8 * (i >> 2) + 4 * n + (i & 3); }

struct Unit { int pm, pn; };
struct Gemm { const bf16_t* A; const bf16_t* Bt; int M, N, K; };

struct StaticOrder {
    int nM, nN, nwg, G, c;
    __host__ __device__ void init(int M, int N, int G_, int c_) { nM = M / BM; nN = N / BM; nwg = nM * nN; G = G_; c = c_; }
    __host__ __device__ bool next(int i, Unit& u) const {
        const long L = (long)i * G + c; if (L >= nwg) return false;
        int wgid = (int)L; { const int q = nwg / NXCD, r = nwg % NXCD, xcd = wgid % NXCD, off = wgid / NXCD; wgid = (xcd < r ? xcd * (q + 1) : r * (q + 1) + (xcd - r) * q) + off; }
        const int nig = WGM * nN, gid = wgid / nig, fm = gid * WGM, gsz = (nM - fm) < WGM ? (nM - fm) : WGM;
        u.pm = fm + ((wgid % nig) % gsz); u.pn = (wgid % nig) / gsz; return true;
    }
    __device__ __forceinline__ void a_ready(const Unit&) const {}
    __device__ __forceinline__ void done(const Unit&) const {}
};
__device__ __forceinline__ unsigned cvt_pk_bf16(float lo, float hi) { unsigned r; asm volatile("v_cvt_pk_bf16_f32 %0, %1, %2" : "=v"(r) : "v"(lo), "v"(hi)); return r; }
template <int ACT  > struct EpiBf {
    static constexpr bool PERM = true, AFTER_DRAIN = false;
    bf16_t* O; int ldc;
    __device__ __forceinline__ void operator()(const f32x4 (&acc)[2][2][4][2], const Unit& u, int wr, int wc, int fr, int fq) const {
        const int row0 = u.pm * BM + wr * 64 + fr, col0 = u.pn * BM + wc * 32 + 8 * fq;
#pragma unroll
        for (int ai = 0; ai < 2; ++ai)
#pragma unroll
            for (int m = 0; m < 4; ++m) { bf16_t* rowp = O + (size_t)(row0 + ai * HALF + m * 16) * ldc + col0;
#pragma unroll
                for (int bj = 0; bj < 2; ++bj) { f32x4 v0 = acc[ai][bj][m][0], v1 = acc[ai][bj][m][1];
                    if (ACT == 1) {
#pragma unroll
                        for (int e = 0; e < 4; ++e) { const float a = v0[e] > 0.f ? v0[e] : 0.f, b = v1[e] > 0.f ? v1[e] : 0.f; v0[e] = a * a; v1[e] = b * b; } }
                    u32x4 w; w.x = cvt_pk_bf16(v0[0], v0[1]); w.y = cvt_pk_bf16(v0[2], v0[3]); w.z = cvt_pk_bf16(v1[0], v1[1]); w.w = cvt_pk_bf16(v1[2], v1[3]);
                    *(u32x4*)(rowp + bj * HALF) = w; } }
    }
};
struct EpiRes {
    static constexpr bool PERM = false, AFTER_DRAIN = false;
    float* out; const float* base_p; const float* base_s; const float* gate;
    __device__ __forceinline__ void operator()(const f32x4 (&acc)[2][2][4][2], const Unit& u, int wr, int wc, int fr, int fq) const {
        const int row0 = u.pm * BM + wr * 64 + fr, col0 = u.pn * BM + wc * 32 + 4 * fq;
        const int t0 = u.pm * BM; const int mr = t0 < 4096 ? 0 : 1 + ((t0 - 4096) >> 10);
        const float* gp = gate + (size_t)mr * 6144 + col0;
        f32x4 gv[2][2];
#pragma unroll
        for (int bj = 0; bj < 2; ++bj)
#pragma unroll
            for (int n = 0; n < 2; ++n) gv[bj][n] = *(const f32x4*)(gp + bj * HALF + n * 16);
#pragma unroll
        for (int ai = 0; ai < 2; ++ai)
#pragma unroll
            for (int m = 0; m < 4; ++m) { const int row = row0 + ai * HALF + m * 16;
                const float* bp = (row < 4096 ? base_p + (size_t)row * 1024 : base_s + (size_t)(row - 4096) * 1024) + col0; float* op = out + (size_t)row * 1024 + col0;
#pragma unroll
                for (int bj = 0; bj < 2; ++bj)
#pragma unroll
                    for (int n = 0; n < 2; ++n) { const f32x4 b = *(const f32x4*)(bp + bj * HALF + n * 16); *(f32x4*)(op + bj * HALF + n * 16) = b + gv[bj][n] * acc[ai][bj][m][n]; } }
    }
};

template <class Epi, class Sched, bool STAMP = false>
__device__ __forceinline__ void gemm_phase(PG8_LAS unsigned char* lds, const Gemm g, const Sched& S, const Epi& E, unsigned long long* stamps) {
    int tid_l = threadIdx.x; asm volatile("" : "+v"(tid_l));
    const int tid = tid_l, wid = __builtin_amdgcn_readfirstlane(tid >> 6), lane = tid & 63, wr = wid >> 2, wc = wid & 3, fr = lane & 15, fq = lane >> 4;
    const int K = g.K, nt = K / BK;
    int ts_lo = 0, ts_hi = 0, nts = 0; const unsigned long long rt_entry = STAMP ? (unsigned long long)wall_clock64() : 0ull;
#define PG8_STAMP() do { if (STAMP && wid == 0 && nts < 64) { const unsigned long long _c = (unsigned long long)clock64(); \
        ts_lo = (lane == nts) ? (int)(unsigned)_c : ts_lo; ts_hi = (lane == nts) ? (int)(unsigned)(_c >> 32) : ts_hi; ++nts; } } while (0)
    PG8_STAMP();
    unsigned voffA[2], voffB[2];
#pragma unroll
    for (int i = 0; i < 2; ++i) { int R, C; stage_rc(tid * 16 + i * 8192, R, C); const int Rb = Epi::PERM ? ((R & ~31) + perm32(R & 31)) : R;
        voffA[i] = (unsigned)(R * K + C) * 2u; voffB[i] = (unsigned)(Rb * K + C) * 2u; }
    const size_t kstep = (size_t)(BK * 2);
    const size_t hstep = (size_t)HALF * K * 2;
    const size_t tstep = 2 * hstep;
    const unsigned ldsw = (unsigned)wid * 1024u;
    const int aoff = lds_byte(wr * 64 + fr, fq * 8), boff = lds_byte(wc * 32 + fr, fq * 8);
#define PG8_SA(b, h) (((b) * 2 + (h)) * HTB)
#define PG8_SB(b, h) ((4 + (b) * 2 + (h)) * HTB)
#define PG8_STAGE(bufoff, gbase, voff) do { _Pragma("unroll") for (int _i = 0; _i < 2; ++_i) \
        __builtin_amdgcn_global_load_lds((const unsigned*)((const char*)(gbase) + (voff)[_i]), (PG8_LAS unsigned*)(lds + (bufoff) + ldsw + _i * 8192), 16, 0, 0); } while (0)
#define PG8_LDA(dst, b, h) do { _Pragma("unroll") for (int m = 0; m < 4; ++m) _Pragma("unroll") for (int k = 0; k < 2; ++k) dst[m][k] = *(const PG8_LAS bf16x8*)(lds + PG8_SA(b, h) + aoff + m * 2048 + k * 1024); } while (0)
#define PG8_LDB(dst, b, h) do { _Pragma("unroll") for (int n = 0; n < 2; ++n) _Pragma("unroll") for (int k = 0; k < 2; ++k) dst[n][k] = *(const PG8_LAS bf16x8*)(lds + PG8_SB(b, h) + boff + n * 2048 + k * 1024); } while (0)
#define PG8_MMA(ai, bj, At, Bt) do { __builtin_amdgcn_s_setprio(1); _Pragma("unroll") for (int m = 0; m < 4; ++m) _Pragma("unroll") for (int n = 0; n < 2; ++n) _Pragma("unroll") for (int k = 0; k < 2; ++k) \
        acc[ai][bj][m][n] = __builtin_amdgcn_mfma_f32_16x16x32_bf16(Bt[n][k], At[m][k], acc[ai][bj][m][n], 0, 0, 0); __builtin_amdgcn_s_setprio(0); } while (0)
#define PG8_WAIT_V(n) asm volatile("s_waitcnt vmcnt(" #n ")" ::: "memory")
#define PG8_WAIT_L(n) asm volatile("s_waitcnt lgkmcnt(" #n ")" ::: "memory")
#define PG8_BAR __builtin_amdgcn_s_barrier()
#define PG8_SCHED __builtin_amdgcn_sched_barrier(0)
    Unit cur, nxt; int ui = 0;
    if (!S.next(0, cur)) return;
    f32x4 acc[2][2][4][2];
#pragma unroll
    for (int a = 0; a < 2; ++a)
#pragma unroll
        for (int b = 0; b < 2; ++b)
#pragma unroll
            for (int m = 0; m < 4; ++m)
#pragma unroll
                for (int n = 0; n < 2; ++n) acc[a][b][m][n] = (f32x4){0.f, 0.f, 0.f, 0.f};
    bf16x8 At[4][2], B0[2][2], B1[2][2];
    const char* cA = (const char*)g.A + (size_t)cur.pm * tstep; const char* cB = (const char*)g.Bt + (size_t)cur.pn * tstep;
    S.a_ready(cur);
    PG8_STAGE(PG8_SB(0, 0), cB, voffB); PG8_STAGE(PG8_SA(0, 0), cA, voffA); PG8_STAGE(PG8_SB(0, 1), cB + hstep, voffB); PG8_STAGE(PG8_SA(0, 1), cA + hstep, voffA);
    if (wr == 1) PG8_BAR;
    PG8_WAIT_V(4); PG8_BAR;
    PG8_STAGE(PG8_SB(1, 0), cB + kstep, voffB); PG8_STAGE(PG8_SA(1, 0), cA + kstep, voffA); PG8_STAGE(PG8_SB(1, 1), cB + hstep + kstep, voffB);
    PG8_WAIT_V(6); PG8_BAR;
    PG8_STAMP();
    for (;;) {
        const bool has_next = S.next(ui + 1, nxt);
        const char* nA = has_next ? (const char*)g.A + (size_t)nxt.pm * tstep : cA; const char* nB = has_next ? (const char*)g.Bt + (size_t)nxt.pn * tstep : cB;
        for (int t = 0; t < nt; t += 2) {
            const bool last = (t == nt - 2);
            const char* a1 = cA + (size_t)(t + 1) * kstep;
            const char* a2 = last ? nA : cA + (size_t)(t + 2) * kstep; const char* b2 = last ? nB : cB + (size_t)(t + 2) * kstep;
            const char* a3 = a2 + kstep; const char* b3 = b2 + kstep;
            if (last && has_next) S.a_ready(nxt);
            PG8_LDB(B0, 0, 0); PG8_SCHED; PG8_LDA(At, 0, 0); PG8_STAGE(PG8_SA(1, 1), a1 + hstep, voffA);
            PG8_WAIT_L(8); PG8_BAR; PG8_WAIT_L(0); PG8_MMA(0, 0, At, B0); PG8_BAR; PG8_SCHED;
            PG8_LDB(B1, 0, 1); PG8_STAGE(PG8_SB(0, 0), b2, voffB);
            PG8_BAR; PG8_WAIT_L(0); PG8_MMA(0, 1, At, B1); PG8_BAR;
            PG8_LDA(At, 0, 1); PG8_STAGE(PG8_SA(0, 0), a2, voffA);
            PG8_BAR; PG8_WAIT_L(0); PG8_MMA(1, 0, At, B0); PG8_BAR; PG8_SCHED;
            PG8_STAGE(PG8_SB(0, 1), b2 + hstep, voffB);
            PG8_WAIT_V(6); PG8_BAR; PG8_MMA(1, 1, At, B1); PG8_BAR;
            PG8_LDB(B0, 1, 0); PG8_SCHED; PG8_LDA(At, 1, 0); PG8_STAGE(PG8_SA(0, 1), a2 + hstep, voffA);
            PG8_WAIT_L(8); PG8_BAR; PG8_WAIT_L(0); PG8_MMA(0, 0, At, B0); PG8_BAR; PG8_SCHED;
            PG8_LDB(B1, 1, 1); PG8_STAGE(PG8_SB(1, 0), b3, voffB);
            PG8_BAR; PG8_WAIT_L(0); PG8_MMA(0, 1, At, B1); PG8_BAR;
            PG8_LDA(At, 1, 1); PG8_STAGE(PG8_SA(1, 0), a3, voffA);
            PG8_BAR; PG8_WAIT_L(0); PG8_MMA(1, 0, At, B0); PG8_BAR; PG8_SCHED;
            PG8_STAGE(PG8_SB(1, 1), b3 + hstep, voffB);
            PG8_WAIT_V(6); PG8_BAR; PG8_MMA(1, 1, At, B1); PG8_BAR;
        }
        PG8_STAMP();
        if constexpr (!Epi::AFTER_DRAIN) { E(acc, cur, wr, wc, fr, fq); S.done(cur); }
        PG8_STAMP();
        if (!has_next) break;
#pragma unroll
        for (int a = 0; a < 2; ++a)
#pragma unroll
            for (int b = 0; b < 2; ++b)
#pragma unroll
                for (int m = 0; m < 4; ++m)
#pragma unroll
                    for (int n = 0; n < 2; ++n) acc[a][b][m][n] = (f32x4){0.f, 0.f, 0.f, 0.f};
        cur = nxt; cA = nA; cB = nB; ++ui;
    }
    PG8_WAIT_V(0);
    if (wr == 0) PG8_BAR;
    PG8_BAR;
    if constexpr (Epi::AFTER_DRAIN) { E.fused(acc, cur, wr, wc, fr, fq, lds, wid, lane); S.done(cur); }
    PG8_STAMP();
    if (STAMP && wid == 0) { stamps[lane] = lane < nts ? (((unsigned long long)(unsigned)ts_hi << 32) | (unsigned)ts_lo) : 0ull;
        if (lane == 62) stamps[62] = rt_entry; if (lane == 63) stamps[63] = (unsigned long long)wall_clock64(); }
#undef PG8_STAMP
#undef PG8_SA
#undef PG8_SB
#undef PG8_STAGE
#undef PG8_LDA
#undef PG8_LDB
#undef PG8_MMA
#undef PG8_WAIT_V
#undef PG8_WAIT_L
#undef PG8_BAR
#undef PG8_SCHED
}
}

using pg8::bf16_t; using pg8::bf16x8; using pg8::f32x4; using pg8::u32x4;
#define LAS __attribute__((address_space(3)))
#define DI __device__ __forceinline__
typedef float f32x2 __attribute__((ext_vector_type(2)));
typedef unsigned u32x2 __attribute__((ext_vector_type(2)));
typedef unsigned short u16x8 __attribute__((ext_vector_type(8)));
typedef unsigned short u16x4 __attribute__((ext_vector_type(4)));

constexpr int NTOK = 8192, DM = 1024, DFF = 4096, NPROJ = 4608, NPROJ_ALL = 4624, NMOD = 6144;
constexpr int LDS_BYTES = 147456;
constexpr int GDN_PACK_B = 34880, HG_PACK_B = 18944;
constexpr size_t OFF_MOD = 0;
constexpr size_t OFF_LBS = 262144;
constexpr size_t OFF_AB = OFF_LBS + 4096;
constexpr size_t OFF_W0 = OFF_AB + (size_t)NTOK * 16 * 4;
constexpr size_t SZ_WIN = (size_t)NPROJ * DM * 2, SZ_WSQ = (size_t)DM * DM * 2, SZ_WFF = (size_t)DFF * DM * 2;
constexpr size_t OFF_H = OFF_W0 + SZ_WIN + SZ_WSQ + 2 * SZ_WFF;
constexpr size_t OFF_PROJ = OFF_H + (size_t)NTOK * DM * 2;
constexpr size_t OFF_PACK = OFF_PROJ + (size_t)NTOK * NPROJ * 2;
constexpr size_t SZ_GPACK = (size_t)2048 * GDN_PACK_B, SZ_HPACK = (size_t)2048 * HG_PACK_B;
constexpr size_t OFF_O = OFF_PACK + SZ_GPACK + SZ_HPACK;
constexpr size_t WS_NEED = OFF_O + (size_t)2 * NTOK * DM * 2;
constexpr size_t OFF_W1 = OFF_PACK;
constexpr size_t SZ_WQKV = (size_t)3072 * DM * 2;
constexpr size_t OFF_X2 = OFF_W1 + SZ_WQKV + SZ_WSQ + 2 * SZ_WFF;
constexpr size_t OFF_CK = OFF_X2 + (size_t)NTOK * DM * 4;
static_assert(OFF_CK + (size_t)2 * 4 * 16 * 256 * 64 * 2 <= OFF_O, "overlay");
static_assert(WS_NEED <= 268435456ull, "workspace");

struct Params {
    const float *xp, *xs, *st_hgrn, *st_gdn, *cache_k, *cache_v, *c, *c_ctx, *ada_w, *ada_b, *norm_g, *w_in, *w_out_ab, *hgrn_lb, *gdn_conv, *a_log, *dt_bias,
        *gn_hgrn, *gn_gdn, *w_qkv, *qn, *kn, *rpb, *w_out_na, *w_mlp1, *w_mlp2;
    float* out; unsigned char* ws;
};

DI bf16_t f2bf(float f) { unsigned u = __float_as_uint(f); u += 0x7FFFu + ((u >> 16) & 1u); return (bf16_t)(u >> 16); }
DI unsigned pack2_safe(float lo, float hi) { return (unsigned)f2bf(lo) | ((unsigned)f2bf(hi) << 16); }
DI float bf2f(bf16_t h) { return __uint_as_float((unsigned)h << 16); }
DI float sigmoidf_(float x) { return 1.0f / (1.0f + __expf(-x)); }
DI float siluf_(float x) { return x / (1.0f + __expf(-x)); }
DI float softplusf_(float x) { return x > 20.f ? x : log1pf(__expf(x)); }
DI float wave_sum(float v) { for (int o = 32; o > 0; o >>= 1) v += __shfl_xor(v, o); return v; }
DI int modrow(int tok) { return tok < 4096 ? 0 : 1 + ((tok - 4096) >> 10); }
DI const float* xrow(const Params& p, int tok) { return tok < 4096 ? p.xp + (size_t)tok * DM : p.xs + (size_t)(tok - 4096) * DM; }

DI f32x4 mma16(const LAS bf16_t* A, int lda, const LAS bf16_t* Bt, int ldb, int K, f32x4 acc) {
    const int lane = threadIdx.x & 63, r = lane & 15, q = lane >> 4;
    const LAS bf16_t* pa = A + r * lda + 8 * q; const LAS bf16_t* pb = Bt + r * ldb + 8 * q;
    for (int k0 = 0; k0 < K; k0 += 32) {
        const bf16x8 a = *(const LAS bf16x8*)(pa + k0), b = *(const LAS bf16x8*)(pb + k0);
        acc = __builtin_amdgcn_mfma_f32_16x16x32_bf16(a, b, acc, 0, 0, 0);
    }
    return acc;
}
DI void phase_mod(const Params& p, LAS unsigned char* lds) {
    LAS float* sc = (LAS float*)lds;
    LAS float* red = (LAS float*)(lds + 20480);
    const int tid = threadIdx.x;
    float* mod = (float*)(p.ws + OFF_MOD);
    for (int e = tid; e < 5 * 1024; e += 512) { const int m = e >> 10, k = e & 1023; const float v = m == 0 ? p.c_ctx[k] : p.c[(m - 1) * 1024 + k]; sc[e] = siluf_(v); }
    __syncthreads();
    for (int cb = blockIdx.x; cb < 256; cb += gridDim.x) {
        const int l = cb >> 7, n0 = (cb & 127) * 48;
        const float* W = p.ada_w + (size_t)l * 1024 * NMOD + n0;
        const int cq = tid % 12, ks = tid / 12;
        float acc[5][4];
#pragma unroll
        for (int m = 0; m < 5; ++m)
#pragma unroll
            for (int j = 0; j < 4; ++j) acc[m][j] = 0.f;
        if (ks < 42) {
            const int k0 = ks * 25;
#pragma unroll 1
            for (int kk = 0; kk < 25; kk += 5) {
                f32x4 w[5];
#pragma unroll
                for (int u = 0; u < 5; ++u) { const int k = k0 + kk + u; w[u] = k < 1024 ? *(const f32x4*)(W + (size_t)k * NMOD + 4 * cq) : (f32x4){0.f, 0.f, 0.f, 0.f}; }
#pragma unroll
                for (int u = 0; u < 5; ++u) { const int k = (k0 + kk + u) < 1024 ? (k0 + kk + u) : 1023;
#pragma unroll
                    for (int m = 0; m < 5; ++m) { const float sv = sc[m * 1024 + k];
#pragma unroll
                        for (int j = 0; j < 4; ++j) acc[m][j] += sv * w[u][j]; } }
            }
#pragma unroll
            for (int m = 0; m < 5; ++m)
#pragma unroll
                for (int j = 0; j < 4; ++j) red[(ks * 5 + m) * 48 + 4 * cq + j] = acc[m][j];
        }
        __syncthreads();
        if (tid < 240) { const int m = tid / 48, j = tid % 48; float s = 0.f; for (int k = 0; k < 42; ++k) s += red[(k * 5 + m) * 48 + j];
            mod[((size_t)l * 5 + m) * NMOD + n0 + j] = s + p.ada_b[l * NMOD + n0 + j]; }
        __syncthreads();
    }
    if (blockIdx.x == gridDim.x - 1) {
        float* lbs = (float*)(p.ws + OFF_LBS);
        const float a = p.hgrn_lb[tid], b = p.hgrn_lb[512 + tid], c = p.hgrn_lb[1024 + tid];
        const float mx = fmaxf(a, fmaxf(b, c)); const float ea = __expf(a - mx), eb = __expf(b - mx), ec = __expf(c - mx);
        lbs[tid] = ea / (ea + eb + ec);
    }
}
DI void transpose_tiles(const float* W, int K, int N, int ldw, bf16_t* Wt, int tbase, int ttotal, LAS unsigned char* lds) {
    LAS float* tile = (LAS float*)lds;
    const int tid = threadIdx.x, nk = K / 64, nn = N / 64, nt = nk * nn;
    int g = blockIdx.x; if (g < tbase) g += ((tbase - g + gridDim.x - 1) / gridDim.x) * gridDim.x;
    f32x4 v0, v1;
    if (g < tbase + nt) { const int t = g - tbase, tk = t % nk, tn = t / nk; const float* src = W + (size_t)(tk * 64 + (tid >> 4)) * ldw + tn * 64 + 4 * (tid & 15);
        v0 = *(const f32x4*)src; v1 = *(const f32x4*)(src + (size_t)32 * ldw); }
    for (; g < tbase + nt; g += gridDim.x) {
        const int t = g - tbase, tk = t % nk, tn = t / nk, k0 = tk * 64, n0 = tn * 64;
        { const int row = tid >> 4, c4 = tid & 15;
          tile[row * 65 + 4 * c4 + 0] = v0[0]; tile[row * 65 + 4 * c4 + 1] = v0[1]; tile[row * 65 + 4 * c4 + 2] = v0[2]; tile[row * 65 + 4 * c4 + 3] = v0[3];
          tile[(row + 32) * 65 + 4 * c4 + 0] = v1[0]; tile[(row + 32) * 65 + 4 * c4 + 1] = v1[1]; tile[(row + 32) * 65 + 4 * c4 + 2] = v1[2]; tile[(row + 32) * 65 + 4 * c4 + 3] = v1[3]; }
        if (g + (int)gridDim.x < tbase + nt) { const int t2 = t + gridDim.x, tk2 = t2 % nk, tn2 = t2 / nk; const float* src = W + (size_t)(tk2 * 64 + (tid >> 4)) * ldw + tn2 * 64 + 4 * (tid & 15);
            v0 = *(const f32x4*)src; v1 = *(const f32x4*)(src + (size_t)32 * ldw); }
        __syncthreads();
        { const int n = tid >> 3, k8 = tid & 7; u32x4 w;
          w.x = pg8::cvt_pk_bf16(tile[(k8 * 8 + 0) * 65 + n], tile[(k8 * 8 + 1) * 65 + n]); w.y = pg8::cvt_pk_bf16(tile[(k8 * 8 + 2) * 65 + n], tile[(k8 * 8 + 3) * 65 + n]);
          w.z = pg8::cvt_pk_bf16(tile[(k8 * 8 + 4) * 65 + n], tile[(k8 * 8 + 5) * 65 + n]); w.w = pg8::cvt_pk_bf16(tile[(k8 * 8 + 6) * 65 + n], tile[(k8 * 8 + 7) * 65 + n]);
          *(u32x4*)(Wt + (size_t)(n0 + n) * K + k0 + k8 * 8) = w; }
        __syncthreads();
    }
    (void)ttotal;
}
DI void phase_w0(const Params& p, LAS unsigned char* lds) {
    bf16_t* w = (bf16_t*)(p.ws + OFF_W0);
    transpose_tiles(p.w_in, 1024, NPROJ, NPROJ_ALL, w, 0, 0, lds);
}
DI void phase_w1(const Params& p, LAS unsigned char* lds) {
    bf16_t* w0 = (bf16_t*)(p.ws + OFF_W0);
    int tb = 0;
    transpose_tiles(p.w_out_ab, 1024, 1024, 1024, w0 + (size_t)NPROJ * DM, tb, 0, lds); tb += 256;
    transpose_tiles(p.w_mlp1, 1024, 4096, 4096, w0 + (size_t)NPROJ * DM + (size_t)DM * DM, tb, 0, lds); tb += 1024;
    transpose_tiles(p.w_mlp2, 4096, 1024, 1024, w0 + (size_t)NPROJ * DM + (size_t)DM * DM + (size_t)DFF * DM, tb, 0, lds); tb += 1024;
    bf16_t* w = (bf16_t*)(p.ws + OFF_W1);
    transpose_tiles(p.w_qkv, 1024, 3072, 3072, w, tb, 0, lds); tb += 16 * 48;
    transpose_tiles(p.w_out_na, 1024, 1024, 1024, w + (size_t)3072 * DM, tb, 0, lds); tb += 256;
    transpose_tiles(p.w_mlp1 + (size_t)DM * DFF, 1024, 4096, 4096, w + (size_t)3072 * DM + (size_t)DM * DM, tb, 0, lds); tb += 1024;
    transpose_tiles(p.w_mlp2 + (size_t)DFF * DM, 4096, 1024, 1024, w + (size_t)3072 * DM + (size_t)DM * DM + (size_t)DFF * DM, tb, 0, lds);
}
template <bool AB> DI void phase_norm(const Params& p, const float* srcp, const float* srcs, int l, int sub, LAS unsigned char* lds) {
    const int tid = threadIdx.x, wid = tid >> 6, lane = tid & 63;
    const float* mod = (const float*)(p.ws + OFF_MOD) + (size_t)l * 5 * NMOD;
    const float* gw = p.norm_g + (l * 2 + sub) * 1024;
    bf16_t* H = (bf16_t*)(p.ws + OFF_H);
    LAS float* wab = (LAS float*)lds;
    if (AB) {
#pragma unroll
        for (int u = 0; u < 8; ++u) { const int e4 = tid + u * 512, k = e4 >> 2, j4 = e4 & 3;
            *(LAS f32x4*)(wab + k * 16 + 4 * j4) = *(const f32x4*)(p.w_in + (size_t)k * NPROJ_ALL + NPROJ + 4 * j4); }
        __syncthreads(); }
    float* ab = (float*)(p.ws + OFF_AB);
    const int stride = gridDim.x * 8;
    for (int tb = blockIdx.x * 8 + wid; tb < NTOK; tb += stride * 4) {
        f32x4 x[4][4]; float ss[4];
#pragma unroll
        for (int r = 0; r < 4; ++r) { const int tok = tb + r * stride;
            if (tok < NTOK) { const float* xr = tok < 4096 ? srcp + (size_t)tok * 1024 : srcs + (size_t)(tok - 4096) * 1024;
#pragma unroll
                for (int i = 0; i < 4; ++i) x[r][i] = *(const f32x4*)(xr + i * 256 + lane * 4); }
            else {
#pragma unroll
                for (int i = 0; i < 4; ++i) x[r][i] = (f32x4){0.f, 0.f, 0.f, 0.f}; } }
        f32x4 g4[4];
#pragma unroll
        for (int i = 0; i < 4; ++i) g4[i] = *(const f32x4*)(gw + i * 256 + lane * 4);
#pragma unroll
        for (int r = 0; r < 4; ++r) { float a = 0.f;
#pragma unroll
            for (int i = 0; i < 4; ++i) a += x[r][i][0] * x[r][i][0] + x[r][i][1] * x[r][i][1] + x[r][i][2] * x[r][i][2] + x[r][i][3] * x[r][i][3];
            ss[r] = a; }
#pragma unroll
        for (int o = 32; o > 0; o >>= 1) {
#pragma unroll
            for (int r = 0; r < 4; ++r) ss[r] += __shfl_xor(ss[r], o); }
#pragma unroll
        for (int r = 0; r < 4; ++r) { const int tok = tb + r * stride; if (tok >= NTOK) break;
            const float rs = rsqrtf(ss[r] * (1.0f / 1024.0f) + 1e-6f);
            const int mr = modrow(tok);
            const float* sh = mod + (size_t)mr * NMOD + sub * 3072; const float* scp = sh + 1024;
            float pa[16];
            if (AB) {
#pragma unroll
                for (int j = 0; j < 16; ++j) pa[j] = 0.f; }
#pragma unroll
            for (int i = 0; i < 4; ++i) { const int k = i * 256 + lane * 4;
                const f32x4 s4 = *(const f32x4*)(scp + k), h4 = *(const f32x4*)(sh + k);
                f32x4 hv;
#pragma unroll
                for (int e = 0; e < 4; ++e) hv[e] = x[r][i][e] * rs * g4[i][e] * (1.0f + s4[e]) + h4[e];
                uint2 w; w.x = pg8::cvt_pk_bf16(hv[0], hv[1]); w.y = pg8::cvt_pk_bf16(hv[2], hv[3]);
                *(uint2*)(H + (size_t)tok * 1024 + k) = w;
                if (AB) {
#pragma unroll
                    for (int e = 0; e < 4; ++e) {
#pragma unroll
                        for (int j4 = 0; j4 < 4; ++j4) { const f32x4 wv = *(const LAS f32x4*)(wab + (k + e) * 16 + 4 * j4);
                            pa[4 * j4 + 0] += hv[e] * wv[0]; pa[4 * j4 + 1] += hv[e] * wv[1]; pa[4 * j4 + 2] += hv[e] * wv[2]; pa[4 * j4 + 3] += hv[e] * wv[3]; } } }
            }
            if (AB) {
                float mine = 0.f;
#pragma unroll
                for (int j = 0; j < 16; ++j) { const float sv = wave_sum(pa[j]); if (lane == j) mine = sv; }
                if (lane < 16) ab[(size_t)tok * 16 + lane] = mine;
            }
        }
    }
}
DI int chunk_seq_start(int gc) { return gc < 128 ? (gc >> 3) * 256 : 4096 + ((gc - 128) >> 5) * 1024; }
DI int chunk_seq_len(int gc) { return gc < 128 ? 256 : 1024; }
struct PrepRaw { u32x4 v[4]; float ab; };
DI void prep_fetch(const Params& p, int pi, int kind, PrepRaw& R) {
    const int tid = threadIdx.x, h = pi & 3, gc = pi >> 2, t0 = gc * 32;
    const bf16_t* proj = (const bf16_t*)(p.ws + OFF_PROJ);
    if (kind == 0) {
        const int sb = chunk_seq_start(gc), se = sb + chunk_seq_len(gc);
#pragma unroll
        for (int k = 0; k < 4; ++k) { const int pc = tid + k * 512; R.v[k] = (u32x4){0u, 0u, 0u, 0u};
            if (pc < 1728) { const int row = pc / 48, rem = pc % 48, part = rem >> 4, c8 = rem & 15, tk = t0 - 2 + row;
                if (tk >= sb && tk < se) R.v[k] = *(const u32x4*)(proj + (size_t)tk * NPROJ + 2560 + part * 512 + h * 128 + c8 * 8); } }
        R.ab = 0.f;
        if (tid < 128) { const int i = tid >> 2, w = tid & 3;
            R.ab = ((const float*)(p.ws + OFF_AB))[(size_t)(t0 + i) * 16 + w * 4 + h]; }
    } else {
#pragma unroll
        for (int k = 0; k < 3; ++k) { const int pc = tid + k * 512, row = pc / 48, rem = pc % 48, which = rem >> 4, c8 = rem & 15;
            R.v[k] = *(const u32x4*)(proj + (size_t)(t0 + row) * NPROJ + which * 512 + h * 128 + c8 * 8); }
    }
}
DI void gdn_prep_item(const Params& p, int gc, int h, const PrepRaw& R, LAS unsigned char* lds) {
    int tid_ = threadIdx.x; asm volatile("" : "+v"(tid_));
    const int tid = tid_, wid = __builtin_amdgcn_readfirstlane(tid >> 6), lane = tid & 63;
    LAS bf16_t* RAW = (LAS bf16_t*)lds;
    LAS bf16_t* QB = (LAS bf16_t*)(lds + 27648); LAS bf16_t* KB = (LAS bf16_t*)(lds + 36352); LAS bf16_t* VB = (LAS bf16_t*)(lds + 45056);
    LAS float* KK = (LAS float*)(lds + 53760); LAS float* QK = (LAS float*)(lds + 57984);
    LAS float* CW = (LAS float*)(lds + 117248); LAS float* ABL = (LAS float*)(lds + 124928);
#pragma unroll
    for (int k = 0; k < 4; ++k) { const int pc = tid + k * 512; if (pc < 1728) *(LAS u32x4*)(RAW + pc * 8) = R.v[k]; }
    if (tid < 128) ABL[tid] = R.ab;
    __syncthreads();
    { const int i = tid >> 4, cg = tid & 15;
#pragma unroll 1
      for (int part = 0; part < 3; ++part) {
          float a[8];
#pragma unroll
          for (int e = 0; e < 8; ++e) a[e] = 0.f;
#pragma unroll
          for (int j = 0; j < 5; ++j) { const u16x8 x = *(const LAS u16x8*)(RAW + (i + j) * 384 + part * 128 + cg * 8);
              const f32x4 w0 = *(const LAS f32x4*)(CW + j * 384 + part * 128 + cg * 8), w1 = *(const LAS f32x4*)(CW + j * 384 + part * 128 + cg * 8 + 4);
#pragma unroll
              for (int e = 0; e < 4; ++e) { a[e] += bf2f(x[e]) * w0[e]; a[4 + e] += bf2f(x[4 + e]) * w1[e]; } }
          float ss = 0.f;
#pragma unroll
          for (int e = 0; e < 8; ++e) { a[e] = siluf_(a[e]); ss += a[e] * a[e]; }
          float sc = 1.f;
          if (part < 2) { ss += __shfl_xor(ss, 1); ss += __shfl_xor(ss, 2); ss += __shfl_xor(ss, 4); ss += __shfl_xor(ss, 8);
              sc = rsqrtf(ss + 1e-6f) * (part == 0 ? 0.08838834764831845f : 1.f); }
          u32x4 w; w.x = pg8::cvt_pk_bf16(a[0] * sc, a[1] * sc); w.y = pg8::cvt_pk_bf16(a[2] * sc, a[3] * sc); w.z = pg8::cvt_pk_bf16(a[4] * sc, a[5] * sc); w.w = pg8::cvt_pk_bf16(a[6] * sc, a[7] * sc);
          *(LAS u32x4*)(QB + part * 4352 + i * 136 + cg * 8) = w;
      } }
    __syncthreads();
    { const int w4 = wid & 3, mt = w4 >> 1, nt = w4 & 1, r = lane & 15, q = lane >> 4;
      f32x4 acc = {0.f, 0.f, 0.f, 0.f};
      acc = mma16((wid < 4 ? KB : QB) + 16 * mt * 136, 136, KB + 16 * nt * 136, 136, 128, acc);
      LAS float* D = wid < 4 ? KK : QK;
#pragma unroll
      for (int i = 0; i < 4; ++i) D[(16 * mt + 4 * q + i) * 33 + 16 * nt + r] = acc[i]; }
    const int dir = wid >> 2, ht = tid & 255, hw = wid & 3;
    LAS float* GS = (LAS float*)(lds + 62208 + dir * 256); LAS float* AM = (LAS float*)(lds + 62720 + dir * 4224);
    LAS bf16_t* TM = (LAS bf16_t*)(lds + 71168 + dir * 2560); LAS bf16_t* RT = (LAS bf16_t*)(lds + 76288 + dir * 20480);
    bf16_t* pack = (bf16_t*)(p.ws + OFF_PACK + ((size_t)(gc * 4 + h) * 2 + dir) * GDN_PACK_B);
    if (hw == 0) {
        const int pp = lane & 31, i = dir ? 31 - pp : pp;
        const float araw = ABL[i * 4 + dir], braw = ABL[i * 4 + 2 + dir];
        const float beta = sigmoidf_(braw);
        float g = -__expf(p.a_log[dir * 4 + h]) * softplusf_(araw + p.dt_bias[dir * 4 + h]);
#pragma unroll
        for (int o = 1; o < 32; o <<= 1) { const float t = __shfl_up(g, o, 32); if (pp >= o) g += t; }
        if (lane < 32) { GS[pp] = g; GS[32 + pp] = beta; }
    }
    __syncthreads();
    { const int pp = ht >> 3, s0 = (ht & 7) * 4, ip = dir ? 31 - pp : pp; const float gp = GS[pp], bp = GS[32 + pp];
      float at[4];
#pragma unroll
      for (int e = 0; e < 4; ++e) { const int s = s0 + e, is = dir ? 31 - s : s; const float dec = s <= pp ? __expf(gp - GS[s]) : 0.f;
          AM[pp * 33 + s] = s < pp ? bp * KK[ip * 33 + is] * dec : 0.f; at[e] = s <= pp ? QK[ip * 33 + is] * dec : 0.f; }
      uint2 w; w.x = pg8::cvt_pk_bf16(at[0], at[1]); w.y = pg8::cvt_pk_bf16(at[2], at[3]);
      *(uint2*)(pack + 12288 + pp * 32 + s0) = w; }
    __syncthreads();
    if (hw == 0) {
        if (lane < 32) {
            float x[32];
#pragma unroll
            for (int pp = 0; pp < 32; ++pp) {
                float a0 = (pp == lane) ? 1.f : 0.f, a1 = 0.f;
#pragma unroll
                for (int j4 = 0; j4 < (pp + 3) / 4; ++j4) { const LAS float* ar = AM + pp * 33 + 4 * j4;
#pragma unroll
                    for (int e = 0; e < 4; ++e) { const int j = 4 * j4 + e; if (j < pp) { if (e & 1) a1 -= ar[e] * x[j]; else a0 -= ar[e] * x[j]; } } }
                x[pp] = a0 + a1; TM[pp * 40 + lane] = f2bf(a0 + a1);
            }
        }
    } else {
        const float gl = GS[31];
        if (ht == 64) *(float*)((unsigned char*)pack + 34816) = __expf(gl);
        for (int task = ht - 64; task < 2048; task += 192) {
            if (task < 1024) {
                const int row = task >> 2, p0 = (task & 3) * 8, d = row & 127; const LAS bf16_t* src = row < 128 ? KB : VB;
                float o[8];
#pragma unroll
                for (int e = 0; e < 8; ++e) { const int pp = p0 + e, ip = dir ? 31 - pp : pp; const float sc = GS[32 + pp] * (row < 128 ? __expf(GS[pp]) : 1.f); o[e] = bf2f(src[ip * 136 + d]) * sc; }
                u32x4 w; w.x = pg8::cvt_pk_bf16(o[0], o[1]); w.y = pg8::cvt_pk_bf16(o[2], o[3]); w.z = pg8::cvt_pk_bf16(o[4], o[5]); w.w = pg8::cvt_pk_bf16(o[6], o[7]);
                *(LAS u32x4*)(RT + row * 40 + p0) = w;
            } else if (task < 1536) {
                const int t2 = task - 1024, pp = t2 >> 4, d0 = (t2 & 15) * 8, ip = dir ? 31 - pp : pp; const float eg = __expf(GS[pp]);
                const u16x8 x = *(const LAS u16x8*)(QB + ip * 136 + d0);
                u32x4 w; w.x = pg8::cvt_pk_bf16(bf2f(x[0]) * eg, bf2f(x[1]) * eg); w.y = pg8::cvt_pk_bf16(bf2f(x[2]) * eg, bf2f(x[3]) * eg);
                w.z = pg8::cvt_pk_bf16(bf2f(x[4]) * eg, bf2f(x[5]) * eg); w.w = pg8::cvt_pk_bf16(bf2f(x[6]) * eg, bf2f(x[7]) * eg);
                *(u32x4*)(pack + 4096 + pp * 128 + d0) = w;
            } else {
                const int t2 = task - 1536, d = t2 >> 2, p0 = (t2 & 3) * 8;
                float o[8];
#pragma unroll
                for (int e = 0; e < 8; ++e) { const int pp = p0 + e, ip = dir ? 31 - pp : pp; o[e] = bf2f(KB[ip * 136 + d]) * __expf(gl - GS[pp]); }
                u32x4 w; w.x = pg8::cvt_pk_bf16(o[0], o[1]); w.y = pg8::cvt_pk_bf16(o[2], o[3]); w.z = pg8::cvt_pk_bf16(o[4], o[5]); w.w = pg8::cvt_pk_bf16(o[6], o[7]);
                *(u32x4*)(pack + 8192 + d * 32 + p0) = w;
            }
        }
    }
    __syncthreads();
#pragma unroll
    for (int t = 0; t < 8; ++t) { const int id = hw * 8 + t, which = id >> 4, dt = (id >> 1) & 7, pt = id & 1, r = lane & 15, q = lane >> 4;
        f32x4 acc = {0.f, 0.f, 0.f, 0.f};
        acc = mma16(RT + (which * 128 + 16 * dt) * 40, 40, TM + 16 * pt * 40, 40, 32, acc);
        uint2 w; w.x = pack2_safe(acc[0], acc[1]); w.y = pack2_safe(acc[2], acc[3]);
        *(uint2*)(pack + (which ? 13312 : 0) + (16 * pt + r) * 128 + 16 * dt + 4 * q) = w; }
    __syncthreads();
}
template <int PH> DI void hgrn_cols(const Params& p, const LAS bf16_t* RAW, LAS bf16_t* QT, LAS bf16_t* KT, bf16_t* pack, const float* lbs, int h, int dir, int d) {
    const float lb = lbs[h * 128 + d];
    float g[32];
    float acc = 0.f;
#pragma unroll
    for (int pp = 0; pp < 32; ++pp) { const int ip = dir ? 31 - pp : pp; const float fraw = bf2f(RAW[ip * 384 + 128 + dir * 128 + d]);
        acc += __logf(lb + (1.0f - lb) * sigmoidf_(fraw)); g[pp] = acc; }
    const float gl = g[31], gr = g[15];
    if (PH == 1) ((float*)((unsigned char*)pack + 18432))[d] = __expf(gl);
    float kh[16];
#pragma unroll
    for (int e = 0; e < 16; ++e) {
        const int pp = PH * 16 + e, ip = dir ? 31 - pp : pp;
        const float ge = g[pp], gm = pp ? g[pp - 1] : 0.f;
        const float qv = siluf_(bf2f(RAW[ip * 384 + d])) * 0.08838834764831845f, kv = 1.0f - __expf(ge - gm);
        pack[1024 + pp * 128 + d] = f2bf(qv * __expf(ge));
        kh[e] = kv * __expf(gl - ge);
        QT[pp * 136 + d] = f2bf(qv * __expf(ge - gr)); KT[pp * 136 + d] = f2bf(kv * __expf(gr - ge));
    }
    u32x4 w0, w1;
    w0.x = pg8::cvt_pk_bf16(kh[0], kh[1]); w0.y = pg8::cvt_pk_bf16(kh[2], kh[3]); w0.z = pg8::cvt_pk_bf16(kh[4], kh[5]); w0.w = pg8::cvt_pk_bf16(kh[6], kh[7]);
    w1.x = pg8::cvt_pk_bf16(kh[8], kh[9]); w1.y = pg8::cvt_pk_bf16(kh[10], kh[11]); w1.z = pg8::cvt_pk_bf16(kh[12], kh[13]); w1.w = pg8::cvt_pk_bf16(kh[14], kh[15]);
    *(u32x4*)(pack + 5120 + d * 32 + PH * 16) = w0; *(u32x4*)(pack + 5120 + d * 32 + PH * 16 + 8) = w1;
}
DI void hgrn_prep_item(const Params& p, int gc, int h, const PrepRaw& R, LAS unsigned char* lds) {
    int tid_ = threadIdx.x; asm volatile("" : "+v"(tid_));
    const int tid = tid_, wid = __builtin_amdgcn_readfirstlane(tid >> 6), lane = tid & 63;
    LAS bf16_t* RAW = (LAS bf16_t*)lds;
    const float* lbs = (const float*)(p.ws + OFF_LBS);
#pragma unroll
    for (int k = 0; k < 3; ++k) *(LAS u32x4*)(RAW + (tid + k * 512) * 8) = R.v[k];
    __syncthreads();
    const int dir = wid >> 2, ht = tid & 255, hw = wid & 3, d = ht & 127, ph = ht >> 7;
    LAS bf16_t* QT = (LAS bf16_t*)(lds + 24576 + dir * 17408); LAS bf16_t* KT = (LAS bf16_t*)(lds + 33280 + dir * 17408);
    bf16_t* pack = (bf16_t*)(p.ws + OFF_PACK + SZ_GPACK + ((size_t)(gc * 4 + h) * 2 + dir) * HG_PACK_B);
    if (ph == 0) hgrn_cols<0>(p, RAW, QT, KT, pack, lbs, h, dir, d); else hgrn_cols<1>(p, RAW, QT, KT, pack, lbs, h, dir, d);
    __syncthreads();
    { const int mt = hw >> 1, nt = hw & 1, r = lane & 15, q = lane >> 4;
      f32x4 acc = {0.f, 0.f, 0.f, 0.f};
      acc = mma16(QT + 16 * mt * 136, 136, KT + 16 * nt * 136, 136, 128, acc);
#pragma unroll
      for (int i = 0; i < 4; ++i) { const int pp = 16 * mt + 4 * q + i, s = 16 * nt + r; pack[pp * 32 + s] = f2bf(s <= pp ? acc[i] : 0.f); } }
    __syncthreads();
}
DI void phase_prep(const Params& p, LAS unsigned char* lds) {
    const int G = gridDim.x, tid = threadIdx.x;
    LAS float* CW = (LAS float*)(lds + 117248);
    int cwh = -1;
    PrepRaw R;
    int pi = blockIdx.x;
    if (pi < 1024) prep_fetch(p, pi, 0, R);
#pragma unroll 1
    for (; pi < 1024; pi += G) {
        const int h = pi & 3, gc = pi >> 2;
        if (h != cwh) { __syncthreads(); for (int e = tid; e < 5 * 384; e += 512) { const int j = e / 384, c = e % 384; CW[e] = p.gdn_conv[j * 1536 + (c >> 7) * 512 + h * 128 + (c & 127)]; } cwh = h; }
        PrepRaw R2; prep_fetch(p, pi, 1, R2);
        gdn_prep_item(p, gc, h, R, lds);
        if (pi + G < 1024) prep_fetch(p, pi + G, 0, R);
        hgrn_prep_item(p, gc, h, R2, lds);
    }
}
struct ScanPre { u32x4 v[5]; };
template <bool GDN> DI void scan_fetch(const Params& p, const unsigned char* packb, int tok0, int h, int dir, ScanPre& R) {
    const int tid = threadIdx.x; const bf16_t* pack = (const bf16_t*)packb;
    if (GDN) { R.v[0] = *(const u32x4*)(pack + tid * 8); R.v[1] = *(const u32x4*)(pack + 4096 + tid * 8); R.v[2] = *(const u32x4*)(pack + 8192 + tid * 8);
        R.v[3] = *(const u32x4*)(pack + 13312 + tid * 8); R.v[4] = tid < 128 ? *(const u32x4*)(pack + 12288 + tid * 8) : *(const u32x4*)(packb + 34816); }
    else { R.v[0] = *(const u32x4*)(pack + 1024 + tid * 8); R.v[2] = *(const u32x4*)(pack + 5120 + tid * 8);
        { const int pp = tid >> 4, ip = dir ? 31 - pp : pp; R.v[1] = *(const u32x4*)((const bf16_t*)(p.ws + OFF_PROJ) + (size_t)(tok0 + ip) * NPROJ + 1536 + h * 128 + (tid & 15) * 8); }
        R.v[3] = tid < 32 ? *(const u32x4*)(packb + 18432 + tid * 16) : (u32x4){0u, 0u, 0u, 0u};
        R.v[4] = tid < 128 ? *(const u32x4*)(pack + tid * 8) : (u32x4){0u, 0u, 0u, 0u}; }
}
template <bool GDN> DI void scan_stash(LAS unsigned char* buf, const ScanPre& R) {
    const int tid = threadIdx.x, row = tid >> 4, c8 = (tid & 15) * 8, kr = tid >> 2, k8 = (tid & 3) * 8;
    *(LAS u32x4*)((LAS bf16_t*)buf + row * 136 + c8) = R.v[0];
    *(LAS u32x4*)((LAS bf16_t*)(buf + 8704) + row * 136 + c8) = R.v[1];
    *(LAS u32x4*)((LAS bf16_t*)(buf + 17408) + kr * 40 + k8) = R.v[2];
    if (GDN) { *(LAS u32x4*)((LAS bf16_t*)(buf + 30208) + row * 136 + c8) = R.v[3]; if (tid == 128) *(LAS unsigned*)(buf + 38912) = R.v[4].x; }
    else if (tid < 32) *(LAS u32x4*)(buf + 30208 + tid * 16) = R.v[3];
    if (tid < 128) *(LAS u32x4*)((LAS bf16_t*)(buf + 27648) + (tid >> 2) * 40 + k8) = R.v[4];
}
template <bool GDN> DI void scan_item(const Params& p, int s, int h, int dir, LAS unsigned char* lds) {
    int tid_ = threadIdx.x; asm volatile("" : "+v"(tid_));
    const int tid = tid_, wid = __builtin_amdgcn_readfirstlane(tid >> 6), lane = tid & 63, r = lane & 15, q = lane >> 4, dv0 = wid * 16;
    LAS bf16_t* ST = (LAS bf16_t*)(lds + 77856 + wid * 4352); LAS bf16_t* VN = (LAS bf16_t*)(lds + 112672 + wid * 1280);
    const int sstart = s < 16 ? s * 256 : 4096 + (s - 16) * 1024, N = s < 16 ? 8 : 32, gc0 = sstart >> 5;
    bf16_t* O = (bf16_t*)(p.ws + OFF_O) + (size_t)dir * NTOK * DM;
    const unsigned char* pbase = p.ws + OFF_PACK + (GDN ? 0 : SZ_GPACK);
    const size_t pstride = GDN ? GDN_PACK_B : HG_PACK_B;
    ScanPre Ra;
    auto fetch = [&](int mm, ScanPre& R) { if (mm < N) { const int nn = dir ? N - 1 - mm : mm; scan_fetch<GDN>(p, pbase + ((size_t)((gc0 + nn) * 4 + h) * 2 + dir) * pstride, sstart + 32 * nn, h, dir, R); } };
    fetch(0, Ra);
    f32x4 S[8];
    if (s >= 16) { const float* st = (GDN ? p.st_gdn : p.st_hgrn) + ((size_t)((s - 16) * 2 + dir) * 4 + h) * 16384;
#pragma unroll
        for (int i = 0; i < 8; ++i)
#pragma unroll
            for (int j = 0; j < 4; ++j) S[i][j] = st[(16 * i + 4 * q + j) * 128 + dv0 + r];
    } else {
#pragma unroll
        for (int i = 0; i < 8; ++i) S[i] = (f32x4){0.f, 0.f, 0.f, 0.f}; }
#pragma unroll
    for (int i = 0; i < 8; ++i) { u32x2 w; w.x = pack2_safe(S[i][0], S[i][1]); w.y = pack2_safe(S[i][2], S[i][3]); *(LAS u32x2*)(ST + r * 136 + 16 * i + 4 * q) = w; }
    __syncthreads();
    scan_stash<GDN>(lds, Ra);
#pragma unroll 1
    for (int m = 0; m < N; ++m) {
        const int n = dir ? N - 1 - m : m;
        LAS unsigned char* buf = lds + (m & 1) * 38928;
        LAS bf16_t* A0 = (LAS bf16_t*)buf; LAS bf16_t* A1 = (LAS bf16_t*)(buf + 8704); LAS bf16_t* KT = (LAS bf16_t*)(buf + 17408);
        LAS bf16_t* AT = (LAS bf16_t*)(buf + 27648); LAS bf16_t* U = (LAS bf16_t*)(buf + 30208); LAS float* av = (LAS float*)(buf + 30208);
        fetch(m + 1, Ra);
        __syncthreads();
        const float egl = GDN ? *(const LAS float*)(buf + 38912) : 1.f;
        const int fo = r * 136 + 8 * q, fk = r * 40 + 8 * q;
        bf16x8 bst[4], a0f[2][4], atf[2], ktf[8];
#pragma unroll
        for (int kk = 0; kk < 4; ++kk) { bst[kk] = *(const LAS bf16x8*)(ST + fo + 32 * kk); a0f[0][kk] = *(const LAS bf16x8*)(A0 + fo + 32 * kk); a0f[1][kk] = *(const LAS bf16x8*)(A0 + 16 * 136 + fo + 32 * kk); }
        atf[0] = *(const LAS bf16x8*)(AT + fk); atf[1] = *(const LAS bf16x8*)(AT + 16 * 40 + fk);
#pragma unroll
        for (int i = 0; i < 8; ++i) ktf[i] = *(const LAS bf16x8*)(KT + 16 * i * 40 + fk);
        if (GDN) {
            bf16x8 a1f[2][4];
#pragma unroll
            for (int kk = 0; kk < 4; ++kk) { a1f[0][kk] = *(const LAS bf16x8*)(A1 + fo + 32 * kk); a1f[1][kk] = *(const LAS bf16x8*)(A1 + 16 * 136 + fo + 32 * kk); }
            float uv[2][4];
#pragma unroll
            for (int mt = 0; mt < 2; ++mt)
#pragma unroll
                for (int i = 0; i < 4; ++i) uv[mt][i] = bf2f(U[(16 * mt + 4 * q + i) * 136 + dv0 + r]);
            __builtin_amdgcn_sched_barrier(0);
            f32x4 ws[2] = {{0.f, 0.f, 0.f, 0.f}, {0.f, 0.f, 0.f, 0.f}};
#pragma unroll
            for (int kk = 0; kk < 4; ++kk) { ws[0] = __builtin_amdgcn_mfma_f32_16x16x32_bf16(a0f[0][kk], bst[kk], ws[0], 0, 0, 0); ws[1] = __builtin_amdgcn_mfma_f32_16x16x32_bf16(a0f[1][kk], bst[kk], ws[1], 0, 0, 0); }
#pragma unroll
            for (int mt = 0; mt < 2; ++mt) { u32x2 w; w.x = pack2_safe(uv[mt][0] - ws[mt][0], uv[mt][1] - ws[mt][1]); w.y = pack2_safe(uv[mt][2] - ws[mt][2], uv[mt][3] - ws[mt][3]);
                *(LAS u32x2*)(VN + r * 40 + 16 * mt + 4 * q) = w; }
            f32x4 oo[2] = {{0.f, 0.f, 0.f, 0.f}, {0.f, 0.f, 0.f, 0.f}};
#pragma unroll
            for (int kk = 0; kk < 4; ++kk) { oo[0] = __builtin_amdgcn_mfma_f32_16x16x32_bf16(a1f[0][kk], bst[kk], oo[0], 0, 0, 0); oo[1] = __builtin_amdgcn_mfma_f32_16x16x32_bf16(a1f[1][kk], bst[kk], oo[1], 0, 0, 0); }
#pragma unroll
            for (int i = 0; i < 8; ++i) S[i] = S[i] * egl;
            asm volatile("s_waitcnt lgkmcnt(0)" ::: "memory");
            const bf16x8 bvn = *(const LAS bf16x8*)(VN + fk);
            oo[0] = __builtin_amdgcn_mfma_f32_16x16x32_bf16(atf[0], bvn, oo[0], 0, 0, 0); oo[1] = __builtin_amdgcn_mfma_f32_16x16x32_bf16(atf[1], bvn, oo[1], 0, 0, 0);
#pragma unroll
            for (int i = 0; i < 8; ++i) S[i] = __builtin_amdgcn_mfma_f32_16x16x32_bf16(ktf[i], bvn, S[i], 0, 0, 0);
#pragma unroll
            for (int mt = 0; mt < 2; ++mt)
#pragma unroll
                for (int i = 0; i < 4; ++i) { const int pp = 16 * mt + 4 * q + i, ip = dir ? 31 - pp : pp;
                    O[(size_t)(sstart + 32 * n + ip) * DM + 512 + h * 128 + dv0 + r] = f2bf(oo[mt][i]); }
        } else {
            { const int pp = lane >> 1, d8 = (lane & 1) * 8; const u16x8 x = *(const LAS u16x8*)(A1 + pp * 136 + dv0 + d8);
#pragma unroll
              for (int e = 0; e < 8; ++e) VN[(d8 + e) * 40 + pp] = x[e]; }
            f32x4 a4[8];
#pragma unroll
            for (int i = 0; i < 8; ++i) a4[i] = *(const LAS f32x4*)(av + 16 * i + 4 * q);
            __builtin_amdgcn_sched_barrier(0);
            f32x4 oo[2] = {{0.f, 0.f, 0.f, 0.f}, {0.f, 0.f, 0.f, 0.f}};
#pragma unroll
            for (int kk = 0; kk < 4; ++kk) { oo[0] = __builtin_amdgcn_mfma_f32_16x16x32_bf16(a0f[0][kk], bst[kk], oo[0], 0, 0, 0); oo[1] = __builtin_amdgcn_mfma_f32_16x16x32_bf16(a0f[1][kk], bst[kk], oo[1], 0, 0, 0); }
#pragma unroll
            for (int i = 0; i < 8; ++i) S[i] = S[i] * a4[i];
            asm volatile("s_waitcnt lgkmcnt(0)" ::: "memory");
            const bf16x8 bvn = *(const LAS bf16x8*)(VN + fk);
            oo[0] = __builtin_amdgcn_mfma_f32_16x16x32_bf16(atf[0], bvn, oo[0], 0, 0, 0); oo[1] = __builtin_amdgcn_mfma_f32_16x16x32_bf16(atf[1], bvn, oo[1], 0, 0, 0);
#pragma unroll
            for (int i = 0; i < 8; ++i) S[i] = __builtin_amdgcn_mfma_f32_16x16x32_bf16(ktf[i], bvn, S[i], 0, 0, 0);
#pragma unroll
            for (int mt = 0; mt < 2; ++mt)
#pragma unroll
                for (int i = 0; i < 4; ++i) { const int pp = 16 * mt + 4 * q + i, ip = dir ? 31 - pp : pp;
                    O[(size_t)(sstart + 32 * n + ip) * DM + h * 128 + dv0 + r] = f2bf(oo[mt][i]); }
        }
        asm volatile("s_waitcnt lgkmcnt(0)" ::: "memory");
#pragma unroll
        for (int i = 0; i < 8; ++i) { u32x2 w; w.x = pack2_safe(S[i][0], S[i][1]); w.y = pack2_safe(S[i][2], S[i][3]); *(LAS u32x2*)(ST + r * 136 + 16 * i + 4 * q) = w; }
        if (m + 1 < N) scan_stash<GDN>(lds + ((m + 1) & 1) * 38928, Ra);
        (void)U; (void)av;
    }
    if (s < 16) { float* so = p.out + (size_t)NTOK * DM + (GDN ? (size_t)2097152 : 0) + ((size_t)(s * 2 + dir) * 4 + h) * 16384;
#pragma unroll
        for (int i = 0; i < 8; ++i)
#pragma unroll
            for (int j = 0; j < 4; ++j) so[(16 * i + 4 * q + j) * 128 + dv0 + r] = S[i][j]; }
    __syncthreads();
}
DI void scan_dispatch(const Params& p, int it, LAS unsigned char* lds) {
    int mixer, dir, h, s;
    if (it < 64) { mixer = it & 1; dir = (it >> 1) & 1; h = (it >> 2) & 3; s = 16 + (it >> 4); }
    else { const int si = it - 64; mixer = si & 1; dir = (si >> 1) & 1; h = (si >> 2) & 3; s = si >> 4; }
    if (mixer) scan_item<true>(p, s, h, dir, lds); else scan_item<false>(p, s, h, dir, lds);
}
DI void phase_scan(const Params& p, LAS unsigned char* lds) {
    const int b = blockIdx.x, G = gridDim.x;
    if (G == 256) { scan_dispatch(p, b, lds); if (b >= 64 && b < 128) scan_dispatch(p, 256 + b - 64, lds); }
    else for (int it = b; it < 320; it += G) scan_dispatch(p, it, lds);
}
DI void phase_combine(const Params& p) {
    const int tid = threadIdx.x, wid = tid >> 6, lane = tid & 63;
    const bf16_t* O0 = (const bf16_t*)(p.ws + OFF_O); const bf16_t* O1 = O0 + (size_t)NTOK * DM;
    const bf16_t* proj = (const bf16_t*)(p.ws + OFF_PROJ);
    bf16_t* H = (bf16_t*)(p.ws + OFF_H);
    const int mixer = lane >> 5, d0 = (lane & 7) * 16, gcol = (mixer ? 4096 : 2048) + ((16 * lane) & 511);
    const float* gn = (mixer ? p.gn_gdn : p.gn_hgrn) + d0;
    for (int tok = blockIdx.x * 8 + wid; tok < NTOK; tok += gridDim.x * 8) {
        const u16x8 a0 = *(const u16x8*)(O0 + (size_t)tok * DM + 16 * lane), a1 = *(const u16x8*)(O0 + (size_t)tok * DM + 16 * lane + 8);
        const u16x8 b0 = *(const u16x8*)(O1 + (size_t)tok * DM + 16 * lane), b1 = *(const u16x8*)(O1 + (size_t)tok * DM + 16 * lane + 8);
        const u16x8 g0 = *(const u16x8*)(proj + (size_t)tok * NPROJ + gcol), g1 = *(const u16x8*)(proj + (size_t)tok * NPROJ + gcol + 8);
        float v[16]; float ss = 0.f;
#pragma unroll
        for (int j = 0; j < 8; ++j) { v[j] = bf2f(a0[j]) + bf2f(b0[j]); v[8 + j] = bf2f(a1[j]) + bf2f(b1[j]); }
#pragma unroll
        for (int j = 0; j < 16; ++j) ss += v[j] * v[j];
        ss += __shfl_xor(ss, 1); ss += __shfl_xor(ss, 2); ss += __shfl_xor(ss, 4);
        const float rs = rsqrtf(ss * (1.0f / 128.0f) + 1e-6f);
        unsigned w[8];
#pragma unroll
        for (int j = 0; j < 8; ++j) { const float ga = bf2f(j < 4 ? g0[2 * j] : g1[2 * j - 8]), gb = bf2f(j < 4 ? g0[2 * j + 1] : g1[2 * j - 7]);
            w[j] = pg8::cvt_pk_bf16(v[2 * j] * rs * gn[2 * j] * siluf_(ga), v[2 * j + 1] * rs * gn[2 * j + 1] * siluf_(gb)); }
        *(u32x4*)(H + (size_t)tok * DM + 16 * lane) = (u32x4){w[0], w[1], w[2], w[3]};
        *(u32x4*)(H + (size_t)tok * DM + 16 * lane + 8) = (u32x4){w[4], w[5], w[6], w[7]};
    }
}
DI void phase_qknorm(const Params& p) {
    const int tid = threadIdx.x, wid = tid >> 6, lane = tid & 63;
    const bf16_t* QKV = (const bf16_t*)(p.ws + OFF_PROJ);
    bf16_t* QN = (bf16_t*)(p.ws + OFF_O); bf16_t* KN = QN + (size_t)NTOK * DM;
    float* ck = p.out + (size_t)NTOK * DM + 2 * 2097152; float* cv = ck + 4194304;
    const int hd = lane >> 2, d0 = (lane & 3) * 16;
    for (int tok = blockIdx.x * 8 + wid; tok < NTOK; tok += gridDim.x * 8) {
#pragma unroll
        for (int part = 0; part < 2; ++part) {
            const bf16_t* src = QKV + (size_t)tok * 3072 + part * 1024 + 16 * lane;
            const u16x8 a0 = *(const u16x8*)src, a1 = *(const u16x8*)(src + 8);
            float v[16]; float ss = 0.f;
#pragma unroll
            for (int j = 0; j < 8; ++j) { v[j] = bf2f(a0[j]); v[8 + j] = bf2f(a1[j]); }
#pragma unroll
            for (int j = 0; j < 16; ++j) ss += v[j] * v[j];
            ss += __shfl_xor(ss, 1); ss += __shfl_xor(ss, 2);
            const float rs = rsqrtf(ss * (1.0f / 64.0f) + 1e-6f);
            const float* gw = (part ? p.kn : p.qn) + d0;
#pragma unroll
            for (int j = 0; j < 16; ++j) v[j] = v[j] * rs * gw[j];
            unsigned w[8];
#pragma unroll
            for (int j = 0; j < 8; ++j) w[j] = pg8::cvt_pk_bf16(v[2 * j], v[2 * j + 1]);
            bf16_t* dst = (part ? KN : QN) + (size_t)tok * DM + 16 * lane;
            *(u32x4*)dst = (u32x4){w[0], w[1], w[2], w[3]}; *(u32x4*)(dst + 8) = (u32x4){w[4], w[5], w[6], w[7]};
            if (part == 1 && tok < 4096) { float* o = ck + (((size_t)(tok >> 8) * 16 + hd) * 256 + (tok & 255)) * 64 + d0;
#pragma unroll
                for (int j4 = 0; j4 < 4; ++j4) *(f32x4*)(o + 4 * j4) = (f32x4){v[4 * j4], v[4 * j4 + 1], v[4 * j4 + 2], v[4 * j4 + 3]}; }
        }
        if (tok < 4096) { const bf16_t* src = QKV + (size_t)tok * 3072 + 2048 + 16 * lane;
            const u16x8 a0 = *(const u16x8*)src, a1 = *(const u16x8*)(src + 8);
            float* o = cv + (((size_t)(tok >> 8) * 16 + hd) * 256 + (tok & 255)) * 64 + d0;
            *(f32x4*)(o) = (f32x4){bf2f(a0[0]), bf2f(a0[1]), bf2f(a0[2]), bf2f(a0[3])}; *(f32x4*)(o + 4) = (f32x4){bf2f(a0[4]), bf2f(a0[5]), bf2f(a0[6]), bf2f(a0[7])};
            *(f32x4*)(o + 8) = (f32x4){bf2f(a1[0]), bf2f(a1[1]), bf2f(a1[2]), bf2f(a1[3])}; *(f32x4*)(o + 12) = (f32x4){bf2f(a1[4]), bf2f(a1[5]), bf2f(a1[6]), bf2f(a1[7])}; }
    }
    { bf16_t* CK = (bf16_t*)(p.ws + OFF_CK);
      for (int e = blockIdx.x * 512 + tid; e < 262144; e += gridDim.x * 512) {
          const float* src = e < 131072 ? p.cache_k + (size_t)e * 8 : p.cache_v + (size_t)(e - 131072) * 8;
          const f32x4 a = *(const f32x4*)src, b = *(const f32x4*)(src + 4);
          *(u32x4*)(CK + (size_t)e * 8) = (u32x4){pg8::cvt_pk_bf16(a[0], a[1]), pg8::cvt_pk_bf16(a[2], a[3]), pg8::cvt_pk_bf16(b[0], b[1]), pg8::cvt_pk_bf16(b[2], b[3])}; } }
}
struct AStage { const bf16_t* kb; const bf16_t* vb; int ks, vs, nkeys; };
DI void attn_fetch(const AStage& d, u32x4 (&kv)[8]) {
    const int tid = threadIdx.x;
#pragma unroll
    for (int k = 0; k < 4; ++k) { const int pc = tid + k * 512, key = pc >> 3, c8 = (pc & 7) * 8;
        if (key < d.nkeys) { kv[k] = *(const u32x4*)(d.kb + (size_t)key * d.ks + c8); kv[4 + k] = *(const u32x4*)(d.vb + (size_t)key * d.vs + c8); } }
}
DI void attn_stash(LAS unsigned char* lds, const u32x4 (&kv)[8], int nkeys) {
    const int tid = threadIdx.x; LAS bf16_t* KB = (LAS bf16_t*)lds; LAS bf16_t* VT = (LAS bf16_t*)(lds + 36864);
#pragma unroll
    for (int k = 0; k < 4; ++k) { const int pc = tid + k * 512, key = pc >> 3, c8 = (pc & 7) * 8;
        if (key < nkeys) { *(LAS u32x4*)(KB + key * 72 + c8) = kv[k];
#pragma unroll
            for (int j = 0; j < 4; ++j) { VT[(c8 + 2 * j) * 264 + key] = (bf16_t)(kv[4 + k][j] & 0xFFFFu); VT[(c8 + 2 * j + 1) * 264 + key] = (bf16_t)(kv[4 + k][j] >> 16); } } }
}
struct AttnState { f32x4 o[4]; float m[4], l[4]; };
DI void attn_tile(AttnState& st, const bf16x8 (&qf)[2], LAS unsigned char* lds, int wid, int mode, int nkeys, int krow0, int rsW, int rw, int ct) {
    const int lane = threadIdx.x & 63, r = lane & 15, q = lane >> 4;
    const LAS bf16_t* KB = (const LAS bf16_t*)lds; const LAS bf16_t* VT = (const LAS bf16_t*)(lds + 36864);
    LAS bf16_t* PW = (LAS bf16_t*)(lds + 70656 + wid * 4352); const LAS float* RPB = (const LAS float*)(lds + 105472);
    f32x4 sc[16];
#pragma unroll
    for (int g = 0; g < 4; ++g) {
        bool act = (64 * g < nkeys);
        const int krow = krow0 + g;
        if (mode == 2) act = act && (krow >= rsW) && (krow < rsW + 8);
        if (act) {
#pragma unroll
            for (int n2 = 0; n2 < 4; n2 += 2) {
            bf16x8 kf[2][2];
#pragma unroll
            for (int n = 0; n < 2; ++n) { kf[n][0] = *(const LAS bf16x8*)(KB + (64 * g + 16 * (n2 + n) + r) * 72 + 8 * q); kf[n][1] = *(const LAS bf16x8*)(KB + (64 * g + 16 * (n2 + n) + r) * 72 + 32 + 8 * q); }
#pragma unroll
            for (int nn = 0; nn < 2; ++nn) { const int n = n2 + nn; f32x4 a = {0.f, 0.f, 0.f, 0.f};
                a = __builtin_amdgcn_mfma_f32_16x16x32_bf16(qf[0], kf[nn][0], a, 0, 0, 0); a = __builtin_amdgcn_mfma_f32_16x16x32_bf16(qf[1], kf[nn][1], a, 0, 0, 0);
                if (mode == 2) {
                    const LAS float* rp = RPB + (krow - rw + 7) * 31;
#pragma unroll
                    for (int i = 0; i < 4; ++i) { const int c = ct * 16 + 4 * q + i, kc = 16 * n + r; const int cs = c - 8 < 0 ? 0 : (c - 8 > 48 ? 48 : c - 8);
                        const bool valid = kc >= cs && kc < cs + 16; int bi = kc - c + 15; bi = bi < 0 ? 0 : (bi > 30 ? 30 : bi);
                        a[i] = valid ? a[i] * 0.125f + rp[bi] : -1e30f; }
                } else a = a * 0.125f;
                sc[4 * g + n] = a; }
            }
        } else {
#pragma unroll
            for (int n = 0; n < 4; ++n) sc[4 * g + n] = (f32x4){-1e30f, -1e30f, -1e30f, -1e30f}; }
    }
    float alpha[4];
#pragma unroll
    for (int i = 0; i < 4; ++i) {
        float mx = sc[0][i];
#pragma unroll
        for (int n = 1; n < 16; ++n) mx = fmaxf(mx, sc[n][i]);
        mx = fmaxf(mx, __shfl_xor(mx, 1)); mx = fmaxf(mx, __shfl_xor(mx, 2)); mx = fmaxf(mx, __shfl_xor(mx, 4)); mx = fmaxf(mx, __shfl_xor(mx, 8));
        const float mn = fmaxf(st.m[i], mx); alpha[i] = __expf(st.m[i] - mn); st.m[i] = mn;
        float rsum = 0.f;
#pragma unroll
        for (int n = 0; n < 16; ++n) { const float pv = __expf(sc[n][i] - mn); sc[n][i] = pv; rsum += pv; }
        rsum += __shfl_xor(rsum, 1); rsum += __shfl_xor(rsum, 2); rsum += __shfl_xor(rsum, 4); rsum += __shfl_xor(rsum, 8);
        st.l[i] = st.l[i] * alpha[i] + rsum;
    }
#pragma unroll
    for (int dt = 0; dt < 4; ++dt)
#pragma unroll
        for (int i = 0; i < 4; ++i) st.o[dt][i] *= alpha[i];
#pragma unroll
    for (int hf = 0; hf < 2; ++hf) {
        if (128 * hf < nkeys) {
            asm volatile("s_waitcnt lgkmcnt(0)" ::: "memory");
#pragma unroll
            for (int n = 0; n < 8; ++n)
#pragma unroll
                for (int i = 0; i < 4; ++i) PW[(4 * q + i) * 136 + 16 * n + r] = f2bf(sc[8 * hf + n][i]);
            asm volatile("s_waitcnt lgkmcnt(0)" ::: "memory");
            bf16x8 pf[4];
#pragma unroll
            for (int kk = 0; kk < 4; ++kk) pf[kk] = *(const LAS bf16x8*)(PW + r * 136 + 32 * kk + 8 * q);
#pragma unroll
            for (int dt = 0; dt < 4; ++dt) { bf16x8 vf[4];
#pragma unroll
                for (int kk = 0; kk < 4; ++kk) vf[kk] = *(const LAS bf16x8*)(VT + (16 * dt + r) * 264 + 128 * hf + 32 * kk + 8 * q);
#pragma unroll
                for (int kk = 0; kk < 4; ++kk) st.o[dt] = __builtin_amdgcn_mfma_f32_16x16x32_bf16(pf[kk], vf[kk], st.o[dt], 0, 0, 0); }
        }
    }
}
DI void attn_out(const AttnState& st, bf16_t* AO, int qtok0, int h) {
    const int lane = threadIdx.x & 63, r = lane & 15, q = lane >> 4;
#pragma unroll
    for (int dt = 0; dt < 4; ++dt)
#pragma unroll
        for (int i = 0; i < 4; ++i) AO[(size_t)(qtok0 + 4 * q + i) * DM + h * 64 + 16 * dt + r] = f2bf(st.o[dt][i] / st.l[i]);
}
DI void attn_init(AttnState& st) {
#pragma unroll
    for (int i = 0; i < 4; ++i) { st.o[i] = (f32x4){0.f, 0.f, 0.f, 0.f}; st.m[i] = -1e30f; st.l[i] = 0.f; }
}
DI void phase_attn(const Params& p, LAS unsigned char* lds) {
    int tid_ = threadIdx.x; asm volatile("" : "+v"(tid_));
    const int tid = tid_, wid = __builtin_amdgcn_readfirstlane(tid >> 6), lane = tid & 63, r = lane & 15, q = lane >> 4;
    const bf16_t* QN = (const bf16_t*)(p.ws + OFF_O); const bf16_t* KN = QN + (size_t)NTOK * DM;
    const bf16_t* QKV = (const bf16_t*)(p.ws + OFF_PROJ);
    const bf16_t* CK = (const bf16_t*)(p.ws + OFF_CK); const bf16_t* CV = CK + (size_t)4 * 16 * 256 * 64;
    bf16_t* AO = (bf16_t*)(p.ws + OFF_H);
    LAS float* RPB = (LAS float*)(lds + 105472);
    u32x4 kv[8];
    for (int it = blockIdx.x; it < 256; it += gridDim.x) {
        const int b = it >> 4, h = it & 15;
        AStage d; d.kb = KN + (size_t)(b * 256) * DM + h * 64; d.ks = DM; d.vb = QKV + (size_t)(b * 256) * 3072 + 2048 + h * 64; d.vs = 3072; d.nkeys = 256;
        attn_fetch(d, kv);
        bf16x8 qf[2][2];
#pragma unroll
        for (int t = 0; t < 2; ++t)
#pragma unroll
            for (int kk = 0; kk < 2; ++kk) qf[t][kk] = *(const bf16x8*)(QN + (size_t)(b * 256 + wid * 32 + t * 16 + r) * DM + h * 64 + 32 * kk + 8 * q);
        __syncthreads();
        attn_stash(lds, kv, 256);
        __syncthreads();
#pragma unroll
        for (int t = 0; t < 2; ++t) { AttnState st; attn_init(st); attn_tile(st, qf[t], lds, wid, 0, 256, 0, 0, 0, 0); attn_out(st, AO, b * 256 + wid * 32 + t * 16, h); }
    }
    for (int it = blockIdx.x; it < 512; it += gridDim.x) {
        const int b = it >> 7, h = (it >> 3) & 15, rp = it & 7, r0 = 2 * rp, rw = r0 + (wid >> 2), ct = wid & 3;
        const int rsA = r0 - 4 < 0 ? 0 : (r0 - 4 > 8 ? 8 : r0 - 4), r1 = r0 + 1, rsB = r1 - 4 < 0 ? 0 : (r1 - 4 > 8 ? 8 : r1 - 4);
        const int rsW = (wid >> 2) ? rsB : rsA, nwin = rsB + 8 - rsA, nst = 1 + (nwin + 3) / 4;
        const int qtok0 = 4096 + b * 1024 + rw * 64 + ct * 16;
        auto desc = [&](int s) { AStage d;
            if (s == 0) { d.kb = CK + (size_t)((b * 16 + h) * 256) * 64; d.ks = 64; d.vb = CV + (size_t)((b * 16 + h) * 256) * 64; d.vs = 64; d.nkeys = 256; }
            else { const int kr0 = rsA + 4 * (s - 1), nr = (nwin - 4 * (s - 1)) < 4 ? (nwin - 4 * (s - 1)) : 4; const size_t tok0 = 4096 + b * 1024 + kr0 * 64;
                d.kb = KN + tok0 * DM + h * 64; d.ks = DM; d.vb = QKV + tok0 * 3072 + 2048 + h * 64; d.vs = 3072; d.nkeys = nr * 64; }
            return d; };
        AStage d0 = desc(0);
        attn_fetch(d0, kv);
        bf16x8 qf[2];
#pragma unroll
        for (int kk = 0; kk < 2; ++kk) qf[kk] = *(const bf16x8*)(QN + (size_t)(qtok0 + r) * DM + h * 64 + 32 * kk + 8 * q);
        AttnState st; attn_init(st);
        __syncthreads();
        if (tid < 465) RPB[tid] = p.rpb[h * 465 + tid];
#pragma unroll 1
        for (int s = 0; s < nst; ++s) {
            const AStage d = desc(s);
            if (s) __syncthreads();
            attn_stash(lds, kv, d.nkeys);
            if (s + 1 < nst) { const AStage dn = desc(s + 1); attn_fetch(dn, kv); }
            __syncthreads();
            attn_tile(st, qf, lds, wid, s == 0 ? 0 : 2, d.nkeys, rsA + 4 * (s - 1), rsW, rw, ct);
        }
        attn_out(st, AO, qtok0, h);
    }
}
#define XB_TMO      128
#define XB_XCNT(j)  (256  + 64 * (j))
#define XB_XSUB(j)  (1280 + 64 * (j))
#define XB_XGEN(j)  (2304 + 64 * (j))
#define XB_TOP      3328
#define XB_TOPGEN   3392
#define XCD_BAR_WORDS 3456
#define XB_SPIN_CAP (1u << 18)

__device__ __forceinline__ unsigned xb_ld(unsigned* p)              { return __hip_atomic_load(p, __ATOMIC_RELAXED, __HIP_MEMORY_SCOPE_AGENT); }
__device__ __forceinline__ unsigned xb_add(unsigned* p, unsigned v) { return __hip_atomic_fetch_add(p, v, __ATOMIC_RELAXED, __HIP_MEMORY_SCOPE_AGENT); }
__device__ __forceinline__ unsigned xb_xcc_id() { return (unsigned)__builtin_amdgcn_s_getreg((3 << 11) | 20) & 0xFu; }
#define XB_SPIN(cond, bar) do { unsigned _sp = 0; while (cond) { __builtin_amdgcn_s_sleep(1); \
    if ((++_sp & 255u) == 0u) { if (xb_ld(&(bar)[XB_TMO])) break; if (_sp > XB_SPIN_CAP) { atomicAdd(&(bar)[XB_TMO], 1u); break; } } } } while (0)

struct XcdBarrier {
    unsigned* bar; unsigned x;
    volatile LAS unsigned* st;
};

__device__ __forceinline__ XcdBarrier xcd_barrier_post(unsigned* bar, volatile LAS unsigned* st) {
    XcdBarrier b; b.bar = bar; b.x = xb_xcc_id(); b.st = st;
    if (threadIdx.x == 0) (void)xb_add(&bar[XB_XCNT(b.x)], 1u);
    return b;
}
__device__ __forceinline__ void xcd_barrier_complete(unsigned* bar, unsigned x, unsigned& nloc, unsigned& nx) {
    const unsigned G = gridDim.x * gridDim.y * gridDim.z;
    unsigned sum, cnt, mine, sp = 0u;
    for (;;) {
        sum = 0u; cnt = 0u; mine = 0u;
#pragma unroll
        for (unsigned j = 0; j < 16; ++j) { const unsigned c = xb_ld(&bar[XB_XCNT(j)]); sum += c; cnt += (c > 0u) ? 1u : 0u; mine = (j == x) ? c : mine; }
        if (sum == G) break;
        __builtin_amdgcn_s_sleep(1);
        if ((++sp & 255u) == 0u) { if (xb_ld(&bar[XB_TMO])) break; if (sp > XB_SPIN_CAP) { atomicAdd(&bar[XB_TMO], 1u); break; } }
    }
    nloc = mine > 0u ? mine : 1u; nx = cnt > 0u ? cnt : 1u;
}

__device__ __forceinline__ void xcd_barrier(const XcdBarrier& b) {
    asm volatile("s_waitcnt vmcnt(0)" ::: "memory");
    __syncthreads();
    if (threadIdx.x == 0) {
        unsigned* bar = b.bar;
        __builtin_amdgcn_s_waitcnt(0);
        unsigned nloc = b.st[0], nx = b.st[1];
        if (nloc == 0u) { xcd_barrier_complete(bar, b.x, nloc, nx); b.st[0] = nloc; b.st[1] = nx; }
        const unsigned old = xb_add(&bar[XB_XSUB(b.x)], 1u);
        const unsigned gen = old / nloc;
        if (old + 1u == (gen + 1u) * nloc) {
            __builtin_amdgcn_fence(__ATOMIC_RELEASE, "agent");
            asm volatile("s_waitcnt vmcnt(0)" ::: "memory");
            const unsigned og = xb_add(&bar[XB_TOP], 1u);
            const unsigned tg = og / nx;
            if (og + 1u == (tg + 1u) * nx) xb_add(&bar[XB_TOPGEN], 1u);
            else XB_SPIN(xb_ld(&bar[XB_TOPGEN]) == tg, bar);
            __builtin_amdgcn_fence(__ATOMIC_ACQUIRE, "agent");
            xb_add(&bar[XB_XGEN(b.x)], 1u);
            asm volatile("s_waitcnt vmcnt(0)" ::: "memory");
        } else {
            XB_SPIN(xb_ld(&bar[XB_XGEN(b.x)]) == gen, bar);
            __builtin_amdgcn_fence(__ATOMIC_ACQUIRE, "agent");
            asm volatile("s_waitcnt vmcnt(0)" ::: "memory");
        }
    }
    __syncthreads();
}

template <class Epi> DI void gemm(LAS unsigned char* lds, const bf16_t* A, const bf16_t* Bt, int N, int K, const Epi& E) {
    pg8::Gemm g; g.A = A; g.Bt = Bt; g.M = NTOK; g.N = N; g.K = K;
    pg8::StaticOrder S; S.init(NTOK, N, gridDim.x, blockIdx.x);
    pg8::gemm_phase<Epi, pg8::StaticOrder, false>(lds, g, S, E, nullptr);
}
#define GSYNC(n) xcd_barrier(xb)
#ifndef REPEAT_MASK
#define REPEAT_MASK 0
#endif
#define PH(n, ...) do { __VA_ARGS__; if ((REPEAT_MASK >> (n)) & 1) { xcd_barrier(xb); __VA_ARGS__; } } while (0)
constexpr size_t OFF_BAR = 245760;
static_assert(OFF_BAR + XCD_BAR_WORDS * 4 <= OFF_LBS, "bar");
extern __shared__ __attribute__((aligned(16))) unsigned char smem_dyn[];
__global__ void __launch_bounds__(512, 2) fwd_megakernel(Params p) {
    LAS unsigned char* lds = (LAS unsigned char*)smem_dyn;
    volatile LAS unsigned* xst = (volatile LAS unsigned*)(lds + LDS_BYTES - 16);
    if (threadIdx.x < 4) xst[threadIdx.x] = 0u;
    __syncthreads();
    const XcdBarrier xb = xcd_barrier_post((unsigned*)(p.ws + OFF_BAR), xst);
    unsigned char* ws = p.ws;
    const float* mod = (const float*)(ws + OFF_MOD);
    bf16_t* H = (bf16_t*)(ws + OFF_H);
    bf16_t* W0 = (bf16_t*)(ws + OFF_W0); bf16_t* W1 = (bf16_t*)(ws + OFF_W1);
    bf16_t* PROJ = (bf16_t*)(ws + OFF_PROJ);
    float* X1 = p.out;
    float* X2 = (float*)(ws + OFF_X2);
    PH(0, phase_mod(p, lds); __syncthreads(); phase_w0(p, lds));
    GSYNC(1);
    PH(1, phase_norm<true>(p, p.xp, p.xs, 0, 0, lds));
    GSYNC(2);
    PH(2, { pg8::EpiBf<0> E; E.O = PROJ; E.ldc = NPROJ; gemm(lds, H, W0, NPROJ, 1024, E); });
    GSYNC(3);
    PH(3, phase_prep(p, lds));
    GSYNC(4);
    PH(4, phase_scan(p, lds));
    GSYNC(5);
    PH(5, phase_combine(p); __syncthreads(); phase_w1(p, lds));
    GSYNC(6);
    PH(6, { pg8::EpiRes E; E.out = X1; E.base_p = p.xp; E.base_s = p.xs; E.gate = mod + 2048; gemm(lds, H, W0 + (size_t)NPROJ * DM, 1024, 1024, E); });
    GSYNC(7);
    PH(7, phase_norm<false>(p, X1, X1 + (size_t)4096 * DM, 0, 1, lds));
    GSYNC(8);
    PH(8, { pg8::EpiBf<1> E; E.O = PROJ; E.ldc = DFF; gemm(lds, H, W0 + (size_t)NPROJ * DM + (size_t)DM * DM, DFF, 1024, E); });
    GSYNC(9);
    PH(9, { pg8::EpiRes E; E.out = X2; E.base_p = X1; E.base_s = X1 + (size_t)4096 * DM; E.gate = mod + 5120; gemm(lds, PROJ, W0 + (size_t)NPROJ * DM + (size_t)DM * DM + (size_t)DFF * DM, 1024, DFF, E); });
    GSYNC(10);
    PH(10, phase_norm<false>(p, X2, X2 + (size_t)4096 * DM, 1, 0, lds));
    GSYNC(11);
    PH(11, { pg8::EpiBf<0> E; E.O = PROJ; E.ldc = 3072; gemm(lds, H, W1, 3072, 1024, E); });
    GSYNC(12);
    PH(12, phase_qknorm(p));
    GSYNC(13);
    PH(13, phase_attn(p, lds));
    GSYNC(14);
    PH(14, { pg8::EpiRes E; E.out = X1; E.base_p = X2; E.base_s = X2 + (size_t)4096 * DM; E.gate = mod + 5 * NMOD + 2048; gemm(lds, H, W1 + (size_t)3072 * DM, 1024, 1024, E); });
    GSYNC(15);
    PH(15, phase_norm<false>(p, X1, X1 + (size_t)4096 * DM, 1, 1, lds));
    GSYNC(16);
    PH(16, { pg8::EpiBf<1> E; E.O = PROJ; E.ldc = DFF; gemm(lds, H, W1 + (size_t)3072 * DM + (size_t)DM * DM, DFF, 1024, E); });
    GSYNC(17);
    { pg8::EpiRes E; E.out = X1; E.base_p = X1; E.base_s = X1 + (size_t)4096 * DM; E.gate = mod + 5 * NMOD + 5120; gemm(lds, PROJ, W1 + (size_t)3072 * DM + (size_t)DM * DM + (size_t)DFF * DM, 1024, DFF, E); }
}

extern "C" void kernel_launch(void* const* d_in, const int* in_sizes, int n_in, void* d_out, int out_size, void* d_ws, size_t ws_size, hipStream_t stream) {
    (void)in_sizes; (void)n_in; (void)out_size;
    static int grid_blocks = 0;
    if (!grid_blocks) {
        int dev = 0, cus = 0, per_cu = 0;
        (void)hipGetDevice(&dev);
        (void)hipDeviceGetAttribute(&cus, hipDeviceAttributeMultiprocessorCount, dev);
        (void)hipFuncSetAttribute((const void*)fwd_megakernel, hipFuncAttributeMaxDynamicSharedMemorySize, LDS_BYTES);
        (void)hipOccupancyMaxActiveBlocksPerMultiprocessor(&per_cu, fwd_megakernel, 512, LDS_BYTES);
        if (per_cu > 1) per_cu = 1;
        grid_blocks = cus * per_cu;
        if (ws_size < WS_NEED) fprintf(stderr, "workspace too small: %zu < %zu\n", ws_size, (size_t)WS_NEED);
    }
    Params p{};
    const float* const* in = (const float* const*)d_in;
    p.xp = in[0]; p.xs = in[1]; p.st_hgrn = in[2]; p.st_gdn = in[3]; p.cache_k = in[4]; p.cache_v = in[5]; p.c = in[6]; p.c_ctx = in[7]; p.ada_w = in[8]; p.ada_b = in[9];
    p.norm_g = in[10]; p.w_in = in[11]; p.w_out_ab = in[12]; p.hgrn_lb = in[13]; p.gdn_conv = in[14]; p.a_log = in[15]; p.dt_bias = in[16]; p.gn_hgrn = in[17]; p.gn_gdn = in[18];
    p.w_qkv = in[19]; p.qn = in[20]; p.kn = in[21]; p.rpb = in[22]; p.w_out_na = in[23]; p.w_mlp1 = in[24]; p.w_mlp2 = in[25];
    p.out = (float*)d_out; p.ws = (unsigned char*)d_ws;
    (void)hipMemsetAsync((unsigned char*)d_ws + OFF_BAR, 0, XCD_BAR_WORDS * 4, stream);
    void* args[] = {&p};
    hipError_t e = hipLaunchCooperativeKernel((const void*)fwd_megakernel, dim3(grid_blocks), dim3(512), args, LDS_BYTES, stream);
    if (e != hipSuccess) fprintf(stderr, "cooperative launch failed: %s (grid %d)\n", hipGetErrorString(e), grid_blocks);
}
```

```cpp
#include <hip/hip_runtime.h>
#include <hip/hip_cooperative_groups.h>
#include <cstdint>
#include <cstdio>
namespace cg = cooperative_groups;
namespace pg8 {
#define PG8_LAS __attribute__((address_space(3)))
typedef unsigned short bf16_t;
typedef short bf16x8 __attribute__((ext_vector_type(8)));
typedef float f32x4 __attribute__((ext_vector_type(4)));
typedef unsigned u32x4 __attribute__((ext_vector_type(4)));
constexpr int BM = 256, BK = 64, HALF = 128, HTB = HALF * BK * 2  , STAGE_BYTES = 8 * HTB, NXCD = 8, WGM = 8;

__host__ __device__ __forceinline__ int lds_byte(int r, int c) { const int st = (r >> 4) * 2 + (c >> 5), rr = r & 15, cc = c & 31, ob = rr * 64 + cc * 2; return st * 1024 + (ob ^ (((ob >> 9) & 1) << 5)); }
__host__ __device__ __forceinline__ void stage_rc(int b, int& R, int& C) { const int st = b / 1024, sb = b % 1024, swz = sb ^ (((sb >> 9) & 1) << 5); R = (st >> 1) * 16 + swz / 64; C = (st & 1) * 32 + (swz % 64) / 2; }
__host__ __device__ __forceinline__ int perm32(int rho) { const int n = rho >> 4, i = rho & 15; return 8 * (i >> 2) + 4 * n + (i & 3); }

struct Unit { int pm, pn; };
struct Gemm { const bf16_t* A; const bf16_t* Bt; int M, N, K; };

struct StaticOrder {
    int nM, nN, nwg, G, c;
    __host__ __device__ void init(int M, int N, int G_, int c_) { nM = M / BM; nN = N / BM; nwg = nM * nN; G = G_; c = c_; }
    __host__ __device__ bool next(int i, Unit& u) const {
        const long L = (long)i * G + c; if (L >= nwg) return false;
        int wgid = (int)L; { const int q = nwg / NXCD, r = nwg % NXCD, xcd = wgid % NXCD, off = wgid / NXCD; wgid = (xcd < r ? xcd * (q + 1) : r * (q + 1) + (xcd - r) * q) + off; }
        const int nig = WGM * nN, gid = wgid / nig, fm = gid * WGM, gsz = (nM - fm) < WGM ? (nM - fm) : WGM;
        u.pm = fm + ((wgid % nig) % gsz); u.pn = (wgid % nig) / gsz; return true;
    }
    __device__ __forceinline__ void a_ready(const Unit&) const {}
    __device__ __forceinline__ void done(const Unit&) const {}
};
__device__ __forceinline__ unsigned cvt_pk_bf16(float lo, float hi) { unsigned r; asm volatile("v_cvt_pk_bf16_f32 %0, %1, %2" : "=v"(r) : "v"(lo), "v"(hi)); return r; }
template <int ACT  > struct EpiBf {
    static constexpr bool PERM = true, AFTER_DRAIN = false;
    bf16_t* O; int ldc;
    __device__ __forceinline__ void operator()(const f32x4 (&acc)[2][2][4][2], const Unit& u, int wr, int wc, int fr, int fq) const {
        const int row0 = u.pm * BM + wr * 64 + fr, col0 = u.pn * BM + wc * 32 + 8 * fq;
#pragma unroll
        for (int ai = 0; ai < 2; ++ai)
#pragma unroll
            for (int m = 0; m < 4; ++m) { bf16_t* rowp = O + (size_t)(row0 + ai * HALF + m * 16) * ldc + col0;
#pragma unroll
                for (int bj = 0; bj < 2; ++bj) { f32x4 v0 = acc[ai][bj][m][0], v1 = acc[ai][bj][m][1];
                    if (ACT == 1) {
#pragma unroll
                        for (int e = 0; e < 4; ++e) { const float a = v0[e] > 0.f ? v0[e] : 0.f, b = v1[e] > 0.f ? v1[e] : 0.f; v0[e] = a * a; v1[e] = b * b; } }
                    u32x4 w; w.x = cvt_pk_bf16(v0[0], v0[1]); w.y = cvt_pk_bf16(v0[2], v0[3]); w.z = cvt_pk_bf16(v1[0], v1[1]); w.w = cvt_pk_bf16(v1[2], v1[3]);
                    *(u32x4*)(rowp + bj * HALF) = w; } }
    }
};
struct EpiRes {
    static constexpr bool PERM = false, AFTER_DRAIN = false;
    float* out; const float* base_p; const float* base_s; const float* gate;
    __device__ __forceinline__ void operator()(const f32x4 (&acc)[2][2][4][2], const Unit& u, int wr, int wc, int fr, int fq) const {
        const int row0 = u.pm * BM + wr * 64 + fr, col0 = u.pn * BM + wc * 32 + 4 * fq;
        const int t0 = u.pm * BM; const int mr = t0 < 4096 ? 0 : 1 + ((t0 - 4096) >> 10);
        const float* gp = gate + (size_t)mr * 6144 + col0;
        f32x4 gv[2][2];
#pragma unroll
        for (int bj = 0; bj < 2; ++bj)
#pragma unroll
            for (int n = 0; n < 2; ++n) gv[bj][n] = *(const f32x4*)(gp + bj * HALF + n * 16);
#pragma unroll
        for (int am = 0; am < 4; ++am) { const int ai = am >> 1, m0 = (am & 1) * 2;
            f32x4 bb[4][2][2];
#pragma unroll
            for (int m = m0; m < m0 + 2; ++m) { const int row = row0 + ai * HALF + m * 16;
                const float* bp = (row < 4096 ? base_p + (size_t)row * 1024 : base_s + (size_t)(row - 4096) * 1024) + col0;
#pragma unroll
                for (int bj = 0; bj < 2; ++bj)
#pragma unroll
                    for (int n = 0; n < 2; ++n) bb[m][bj][n] = *(const f32x4*)(bp + bj * HALF + n * 16); }
#pragma unroll
            for (int m = m0; m < m0 + 2; ++m) { const int row = row0 + ai * HALF + m * 16; float* op = out + (size_t)row * 1024 + col0;
#pragma unroll
                for (int bj = 0; bj < 2; ++bj)
#pragma unroll
                    for (int n = 0; n < 2; ++n) *(f32x4*)(op + bj * HALF + n * 16) = bb[m][bj][n] + gv[bj][n] * acc[ai][bj][m][n]; }
        }
    }
};

struct EpiRes2 {
    static constexpr bool PERM = false, AFTER_DRAIN = false;
    float* out; const float* base_p; const float* base_s; const float* gate; bf16_t* A2; const float* ng; const float* sc; float* ssq;
    __device__ __forceinline__ void operator()(const f32x4 (&acc)[2][2][4][2], const Unit& u, int wr, int wc, int fr, int fq) const {
        const int row0 = u.pm * BM + wr * 64 + fr, col0 = u.pn * BM + wc * 32 + 4 * fq;
        const int t0 = u.pm * BM; const int mr = t0 < 4096 ? 0 : 1 + ((t0 - 4096) >> 10);
        const float* gp = gate + (size_t)mr * 6144 + col0; const float* sp = sc + (size_t)mr * 6144 + col0; const float* np = ng + col0;
        f32x4 gv[2][2], mv[2][2];
#pragma unroll
        for (int bj = 0; bj < 2; ++bj)
#pragma unroll
            for (int n = 0; n < 2; ++n) { gv[bj][n] = *(const f32x4*)(gp + bj * HALF + n * 16);
                const f32x4 s4 = *(const f32x4*)(sp + bj * HALF + n * 16), n4 = *(const f32x4*)(np + bj * HALF + n * 16); mv[bj][n] = n4 * (s4 + 1.0f); }
#pragma unroll
        for (int am = 0; am < 4; ++am) { const int ai = am >> 1, m0 = (am & 1) * 2;
            f32x4 bb[4][2][2];
#pragma unroll
            for (int m = m0; m < m0 + 2; ++m) { const int row = row0 + ai * HALF + m * 16;
                const float* bp = (row < 4096 ? base_p + (size_t)row * 1024 : base_s + (size_t)(row - 4096) * 1024) + col0;
#pragma unroll
                for (int bj = 0; bj < 2; ++bj)
#pragma unroll
                    for (int n = 0; n < 2; ++n) bb[m][bj][n] = *(const f32x4*)(bp + bj * HALF + n * 16); }
#pragma unroll
            for (int m = m0; m < m0 + 2; ++m) { const int row = row0 + ai * HALF + m * 16; float* op = out + (size_t)row * 1024 + col0;
                bf16_t* ap = A2 + (size_t)row * 1024 + col0; float ss = 0.f;
#pragma unroll
                for (int bj = 0; bj < 2; ++bj)
#pragma unroll
                    for (int n = 0; n < 2; ++n) { const f32x4 v = bb[m][bj][n] + gv[bj][n] * acc[ai][bj][m][n];
                        *(f32x4*)(op + bj * HALF + n * 16) = v; ss += (v[0] * v[0] + v[1] * v[1]) + (v[2] * v[2] + v[3] * v[3]);
                        const f32x4 a = v * mv[bj][n]; uint2 w; w.x = cvt_pk_bf16(a[0], a[1]); w.y = cvt_pk_bf16(a[2], a[3]); *(uint2*)(ap + bj * HALF + n * 16) = w; }
                ss += __shfl_xor(ss, 16); ss += __shfl_xor(ss, 32);
                if (fq == 0) ssq[(size_t)row * 16 + u.pn * 4 + wc] = ss; }
        }
    }
};
template <int ACT  > struct EpiBfSB {
    static constexpr bool PERM = true, AFTER_DRAIN = false;
    bf16_t* O; int ldc; const float* ssq; const float* bias; int ldb;
    __device__ __forceinline__ void operator()(const f32x4 (&acc)[2][2][4][2], const Unit& u, int wr, int wc, int fr, int fq) const {
        const int row0 = u.pm * BM + wr * 64 + fr, col0 = u.pn * BM + wc * 32 + 8 * fq;
        const int t0 = u.pm * BM; const int mr = t0 < 4096 ? 0 : 1 + ((t0 - 4096) >> 10);
        const float* bp = bias + (size_t)mr * ldb + col0;
        f32x4 bv[2][2];
#pragma unroll
        for (int bj = 0; bj < 2; ++bj) { bv[bj][0] = *(const f32x4*)(bp + bj * HALF); bv[bj][1] = *(const f32x4*)(bp + bj * HALF + 4); }
#pragma unroll
        for (int ai = 0; ai < 2; ++ai)
#pragma unroll
            for (int m = 0; m < 4; ++m) { const int row = row0 + ai * HALF + m * 16; bf16_t* rowp = O + (size_t)row * ldc + col0;
                const f32x4 p0 = *(const f32x4*)(ssq + (size_t)row * 16), p1 = *(const f32x4*)(ssq + (size_t)row * 16 + 4), p2 = *(const f32x4*)(ssq + (size_t)row * 16 + 8), p3 = *(const f32x4*)(ssq + (size_t)row * 16 + 12);
                const f32x4 ps = (p0 + p1) + (p2 + p3);
                const float rs = __builtin_amdgcn_rsqf(((ps[0] + ps[1]) + (ps[2] + ps[3])) * (1.0f / 1024.0f) + 1e-6f);
#pragma unroll
                for (int bj = 0; bj < 2; ++bj) { f32x4 v0 = acc[ai][bj][m][0] * rs + bv[bj][0], v1 = acc[ai][bj][m][1] * rs + bv[bj][1];
                    if (ACT == 1) {
#pragma unroll
                        for (int e = 0; e < 4; ++e) { const float a = v0[e] > 0.f ? v0[e] : 0.f, b = v1[e] > 0.f ? v1[e] : 0.f; v0[e] = a * a; v1[e] = b * b; } }
                    u32x4 w; w.x = cvt_pk_bf16(v0[0], v0[1]); w.y = cvt_pk_bf16(v0[2], v0[3]); w.z = cvt_pk_bf16(v1[0], v1[1]); w.w = cvt_pk_bf16(v1[2], v1[3]);
                    *(u32x4*)(rowp + bj * HALF) = w; } }
    }
};

struct EpiProj {
    static constexpr bool PERM = true, AFTER_DRAIN = false;
    bf16_t* O; float* ab;
    __device__ __forceinline__ void operator()(const f32x4 (&acc)[2][2][4][2], const Unit& u, int wr, int wc, int fr, int fq) const {
        if (u.pn < 18) { EpiBf<0> E; E.O = O; E.ldc = 4608; E(acc, u, wr, wc, fr, fq); return; }
        if (wc == 0 && fq < 2) {
            const int row0 = u.pm * BM + wr * 64 + fr;
#pragma unroll
            for (int ai = 0; ai < 2; ++ai)
#pragma unroll
                for (int m = 0; m < 4; ++m) { float* rp = ab + (size_t)(row0 + ai * HALF + m * 16) * 16 + 8 * fq;
                    *(f32x4*)rp = acc[ai][0][m][0]; *(f32x4*)(rp + 4) = acc[ai][0][m][1]; }
        }
    }
};

template <class Epi, class Sched, bool STAMP = false>
__device__ __forceinline__ void gemm_phase(PG8_LAS unsigned char* lds, const Gemm g, const Sched& S, const Epi& E, unsigned long long* stamps) {
    int tid_l = threadIdx.x; asm volatile("" : "+v"(tid_l));
    const int tid = tid_l, wid = __builtin_amdgcn_readfirstlane(tid >> 6), lane = tid & 63, wr = wid >> 2, wc = wid & 3, fr = lane & 15, fq = lane >> 4;
    const int K = g.K, nt = K / BK;
    int ts_lo = 0, ts_hi = 0, nts = 0; const unsigned long long rt_entry = STAMP ? (unsigned long long)wall_clock64() : 0ull;
#define PG8_STAMP() do { if (STAMP && wid == 0 && nts < 64) { const unsigned long long _c = (unsigned long long)clock64(); \
        ts_lo = (lane == nts) ? (int)(unsigned)_c : ts_lo; ts_hi = (lane == nts) ? (int)(unsigned)(_c >> 32) : ts_hi; ++nts; } } while (0)
    PG8_STAMP();
    unsigned voffA[2], voffB[2];
#pragma unroll
    for (int i = 0; i < 2; ++i) { int R, C; stage_rc(tid * 16 + i * 8192, R, C); const int Rb = Epi::PERM ? ((R & ~31) + perm32(R & 31)) : R;
        voffA[i] = (unsigned)(R * K + C) * 2u; voffB[i] = (unsigned)(Rb * K + C) * 2u; }
    const size_t kstep = (size_t)(BK * 2);
    const size_t hstep = (size_t)HALF * K * 2;
    const size_t tstep = 2 * hstep;
    const unsigned ldsw = (unsigned)wid * 1024u;
    const int aoff = lds_byte(wr * 64 + fr, fq * 8), boff = lds_byte(wc * 32 + fr, fq * 8);
#define PG8_SA(b, h) (((b) * 2 + (h)) * HTB)
#define PG8_SB(b, h) ((4 + (b) * 2 + (h)) * HTB)
#define PG8_STAGE(bufoff, gbase, voff) do { _Pragma("unroll") for (int _i = 0; _i < 2; ++_i) \
        __builtin_amdgcn_global_load_lds((const unsigned*)((const char*)(gbase) + (voff)[_i]), (PG8_LAS unsigned*)(lds + (bufoff) + ldsw + _i * 8192), 16, 0, 0); } while (0)
#define PG8_LDA(dst, b, h) do { _Pragma("unroll") for (int m = 0; m < 4; ++m) _Pragma("unroll") for (int k = 0; k < 2; ++k) dst[m][k] = *(const PG8_LAS bf16x8*)(lds + PG8_SA(b, h) + aoff + m * 2048 + k * 1024); } while (0)
#define PG8_LDB(dst, b, h) do { _Pragma("unroll") for (int n = 0; n < 2; ++n) _Pragma("unroll") for (int k = 0; k < 2; ++k) dst[n][k] = *(const PG8_LAS bf16x8*)(lds + PG8_SB(b, h) + boff + n * 2048 + k * 1024); } while (0)
#define PG8_MMA(ai, bj, At, Bt) do { __builtin_amdgcn_s_setprio(1); _Pragma("unroll") for (int m = 0; m < 4; ++m) _Pragma("unroll") for (int n = 0; n < 2; ++n) _Pragma("unroll") for (int k = 0; k < 2; ++k) \
        acc[ai][bj][m][n] = __builtin_amdgcn_mfma_f32_16x16x32_bf16(Bt[n][k], At[m][k], acc[ai][bj][m][n], 0, 0, 0); __builtin_amdgcn_s_setprio(0); } while (0)
#define PG8_WAIT_V(n) asm volatile("s_waitcnt vmcnt(" #n ")" ::: "memory")
#define PG8_WAIT_L(n) asm volatile("s_waitcnt lgkmcnt(" #n ")" ::: "memory")
#define PG8_BAR __builtin_amdgcn_s_barrier()
#define PG8_SCHED __builtin_amdgcn_sched_barrier(0)
    Unit cur, nxt; int ui = 0;
    if (!S.next(0, cur)) return;
    f32x4 acc[2][2][4][2];
#pragma unroll
    for (int a = 0; a < 2; ++a)
#pragma unroll
        for (int b = 0; b < 2; ++b)
#pragma unroll
            for (int m = 0; m < 4; ++m)
#pragma unroll
                for (int n = 0; n < 2; ++n) acc[a][b][m][n] = (f32x4){0.f, 0.f, 0.f, 0.f};
    bf16x8 At[4][2], B0[2][2], B1[2][2];
    const char* cA = (const char*)g.A + (size_t)cur.pm * tstep; const char* cB = (const char*)g.Bt + (size_t)cur.pn * tstep;
    S.a_ready(cur);
    PG8_STAGE(PG8_SB(0, 0), cB, voffB); PG8_STAGE(PG8_SA(0, 0), cA, voffA); PG8_STAGE(PG8_SB(0, 1), cB + hstep, voffB); PG8_STAGE(PG8_SA(0, 1), cA + hstep, voffA);
    if (wr == 1) PG8_BAR;
    PG8_WAIT_V(4); PG8_BAR;
    PG8_STAGE(PG8_SB(1, 0), cB + kstep, voffB); PG8_STAGE(PG8_SA(1, 0), cA + kstep, voffA); PG8_STAGE(PG8_SB(1, 1), cB + hstep + kstep, voffB);
    PG8_WAIT_V(6); PG8_BAR;
    PG8_STAMP();
    for (;;) {
        const bool has_next = S.next(ui + 1, nxt);
        const char* nA = has_next ? (const char*)g.A + (size_t)nxt.pm * tstep : cA; const char* nB = has_next ? (const char*)g.Bt + (size_t)nxt.pn * tstep : cB;
        for (int t = 0; t < nt; t += 2) {
            const bool last = (t == nt - 2);
            const char* a1 = cA + (size_t)(t + 1) * kstep;
            const char* a2 = last ? nA : cA + (size_t)(t + 2) * kstep; const char* b2 = last ? nB : cB + (size_t)(t + 2) * kstep;
            const char* a3 = a2 + kstep; const char* b3 = b2 + kstep;
            if (last && has_next) S.a_ready(nxt);
            PG8_LDB(B0, 0, 0); PG8_SCHED; PG8_LDA(At, 0, 0); PG8_STAGE(PG8_SA(1, 1), a1 + hstep, voffA);
            PG8_WAIT_L(8); PG8_BAR; PG8_WAIT_L(0); PG8_MMA(0, 0, At, B0); PG8_BAR; PG8_SCHED;
            PG8_LDB(B1, 0, 1); PG8_STAGE(PG8_SB(0, 0), b2, voffB);
            PG8_BAR; PG8_WAIT_L(0); PG8_MMA(0, 1, At, B1); PG8_BAR;
            PG8_LDA(At, 0, 1); PG8_STAGE(PG8_SA(0, 0), a2, voffA);
            PG8_BAR; PG8_WAIT_L(0); PG8_MMA(1, 0, At, B0); PG8_BAR; PG8_SCHED;
            PG8_STAGE(PG8_SB(0, 1), b2 + hstep, voffB);
            PG8_WAIT_V(6); PG8_BAR; PG8_MMA(1, 1, At, B1); PG8_BAR;
            PG8_LDB(B0, 1, 0); PG8_SCHED; PG8_LDA(At, 1, 0); PG8_STAGE(PG8_SA(0, 1), a2 + hstep, voffA);
            PG8_WAIT_L(8); PG8_BAR; PG8_WAIT_L(0); PG8_MMA(0, 0, At, B0); PG8_BAR; PG8_SCHED;
            PG8_LDB(B1, 1, 1); PG8_STAGE(PG8_SB(1, 0), b3, voffB);
            PG8_BAR; PG8_WAIT_L(0); PG8_MMA(0, 1, At, B1); PG8_BAR;
            PG8_LDA(At, 1, 1); PG8_STAGE(PG8_SA(1, 0), a3, voffA);
            PG8_BAR; PG8_WAIT_L(0); PG8_MMA(1, 0, At, B0); PG8_BAR; PG8_SCHED;
            PG8_STAGE(PG8_SB(1, 1), b3 + hstep, voffB);
            PG8_WAIT_V(6); PG8_BAR; PG8_MMA(1, 1, At, B1); PG8_BAR;
        }
        PG8_STAMP();
        if constexpr (!Epi::AFTER_DRAIN) { E(acc, cur, wr, wc, fr, fq); S.done(cur); }
        PG8_STAMP();
        if (!has_next) break;
#pragma unroll
        for (int a = 0; a < 2; ++a)
#pragma unroll
            for (int b = 0; b < 2; ++b)
#pragma unroll
                for (int m = 0; m < 4; ++m)
#pragma unroll
                    for (int n = 0; n < 2; ++n) acc[a][b][m][n] = (f32x4){0.f, 0.f, 0.f, 0.f};
        cur = nxt; cA = nA; cB = nB; ++ui;
    }
    PG8_WAIT_V(0);
    if (wr == 0) PG8_BAR;
    PG8_BAR;
    if constexpr (Epi::AFTER_DRAIN) { E.fused(acc, cur, wr, wc, fr, fq, lds, wid, lane); S.done(cur); }
    PG8_STAMP();
    if (STAMP && wid == 0) { stamps[lane] = lane < nts ? (((unsigned long long)(unsigned)ts_hi << 32) | (unsigned)ts_lo) : 0ull;
        if (lane == 62) stamps[62] = rt_entry; if (lane == 63) stamps[63] = (unsigned long long)wall_clock64(); }
#undef PG8_STAMP
#undef PG8_SA
#undef PG8_SB
#undef PG8_STAGE
#undef PG8_LDA
#undef PG8_LDB
#undef PG8_MMA
#undef PG8_WAIT_V
#undef PG8_WAIT_L
#undef PG8_BAR
#undef PG8_SCHED
}
}

using pg8::bf16_t; using pg8::bf16x8; using pg8::f32x4; using pg8::u32x4;
#define LAS __attribute__((address_space(3)))
#define DI __device__ __forceinline__
typedef float f32x2 __attribute__((ext_vector_type(2)));
typedef unsigned u32x2 __attribute__((ext_vector_type(2)));
typedef unsigned short u16x8 __attribute__((ext_vector_type(8)));
typedef unsigned short u16x4 __attribute__((ext_vector_type(4)));

constexpr int NTOK = 8192, DM = 1024, DFF = 4096, NPROJ = 4608, NPROJ_ALL = 4624, NMOD = 6144;
constexpr int LDS_BYTES = 147456;
constexpr int GDN_PACK_B = 34880, HG_PACK_B = 18944;
constexpr size_t OFF_MOD = 0;
constexpr size_t OFF_LBS = 262144;
constexpr size_t OFF_AB = OFF_LBS + 4096;
constexpr size_t OFF_W0 = OFF_AB + (size_t)NTOK * 16 * 4;
constexpr int NPROJ_PAD = 4864;
constexpr size_t SZ_WIN = (size_t)NPROJ_PAD * DM * 2, SZ_WSQ = (size_t)DM * DM * 2, SZ_WFF = (size_t)DFF * DM * 2;
constexpr size_t OFF_H = OFF_W0 + SZ_WIN + SZ_WSQ + 2 * SZ_WFF;
constexpr size_t OFF_PROJ = OFF_H + (size_t)NTOK * DM * 2;
constexpr size_t OFF_PACK = OFF_PROJ + (size_t)NTOK * NPROJ * 2;
constexpr size_t SZ_GPACK = (size_t)2048 * GDN_PACK_B, SZ_HPACK = (size_t)2048 * HG_PACK_B;
constexpr size_t OFF_O = OFF_PACK + SZ_GPACK + SZ_HPACK;
constexpr size_t WS_NEED = OFF_O + (size_t)2 * NTOK * DM * 2;
constexpr size_t OFF_W1 = OFF_PACK;
constexpr size_t SZ_WQKV = (size_t)3072 * DM * 2;
constexpr size_t OFF_X2 = OFF_W1 + SZ_WQKV + SZ_WSQ + 2 * SZ_WFF;
constexpr size_t OFF_CK = OFF_X2 + (size_t)NTOK * DM * 4;
constexpr size_t OFF_H2 = OFF_CK + (size_t)2 * 4 * 16 * 256 * 64 * 2;
constexpr size_t OFF_SSQ = OFF_H2 + (size_t)NTOK * DM * 2;
constexpr size_t OFF_CB = OFF_SSQ + (size_t)3 * NTOK * 16 * 4;
static_assert(OFF_CB + (size_t)5 * (4096 + 3072 + 4096) * 4 <= OFF_O, "overlay");
static_assert(WS_NEED <= 268435456ull, "workspace");

#ifndef PROBE_A
#define PROBE_A -1
#define PROBE_B 1
#define PROBE_SCALE 0.004f
#endif
#define TSTAMP(n) do { if (PROBE_A >= 0 && threadIdx.x == 0 && blockIdx.x == 0) tsl[n] = __builtin_amdgcn_s_memrealtime(); } while (0)
#define SUBSTAMP(lds_, n) do { if (PROBE_A >= 0 && threadIdx.x == 0 && blockIdx.x == 0) ((volatile LAS unsigned long long*)((lds_) + LDS_BYTES - 16 - 512))[n] = __builtin_amdgcn_s_memrealtime(); } while (0)
struct Params {
    const float *xp, *xs, *st_hgrn, *st_gdn, *cache_k, *cache_v, *c, *c_ctx, *ada_w, *ada_b, *norm_g, *w_in, *w_out_ab, *hgrn_lb, *gdn_conv, *a_log, *dt_bias,
        *gn_hgrn, *gn_gdn, *w_qkv, *qn, *kn, *rpb, *w_out_na, *w_mlp1, *w_mlp2;
    float* out; unsigned char* ws;
};

DI bf16_t f2bf(float f) { unsigned u = __float_as_uint(f); u += 0x7FFFu + ((u >> 16) & 1u); return (bf16_t)(u >> 16); }
DI unsigned pack2_safe(float lo, float hi) { return (unsigned)f2bf(lo) | ((unsigned)f2bf(hi) << 16); }
DI float bf2f(bf16_t h) { return __uint_as_float((unsigned)h << 16); }
DI float sigmoidf_(float x) { return 1.0f / (1.0f + __expf(-x)); }
DI float siluf_(float x) { return x / (1.0f + __expf(-x)); }
DI float softplusf_(float x) { return x > 20.f ? x : log1pf(__expf(x)); }
DI float wave_sum(float v) { for (int o = 32; o > 0; o >>= 1) v += __shfl_xor(v, o); return v; }
DI int modrow(int tok) { return tok < 4096 ? 0 : 1 + ((tok - 4096) >> 10); }
DI const float* xrow(const Params& p, int tok) { return tok < 4096 ? p.xp + (size_t)tok * DM : p.xs + (size_t)(tok - 4096) * DM; }

DI f32x4 mma16(const LAS bf16_t* A, int lda, const LAS bf16_t* Bt, int ldb, int K, f32x4 acc) {
    const int lane = threadIdx.x & 63, r = lane & 15, q = lane >> 4;
    const LAS bf16_t* pa = A + r * lda + 8 * q; const LAS bf16_t* pb = Bt + r * ldb + 8 * q;
    for (int k0 = 0; k0 < K; k0 += 32) {
        const bf16x8 a = *(const LAS bf16x8*)(pa + k0), b = *(const LAS bf16x8*)(pb + k0);
        acc = __builtin_amdgcn_mfma_f32_16x16x32_bf16(a, b, acc, 0, 0, 0);
    }
    return acc;
}
DI void phase_mod(const Params& p, LAS unsigned char* lds) {
    LAS float* sc = (LAS float*)lds;
    LAS float* red = (LAS float*)(lds + 20480);
    const int tid = threadIdx.x;
    float* mod = (float*)(p.ws + OFF_MOD);
    for (int e = tid; e < 5 * 1024; e += 512) { const int m = e >> 10, k = e & 1023; const float v = m == 0 ? p.c_ctx[k] : p.c[(m - 1) * 1024 + k]; sc[e] = siluf_(v); }
    __syncthreads();
    for (int cb = blockIdx.x; cb < 256; cb += gridDim.x) {
        const int l = cb >> 7, n0 = (cb & 127) * 48;
        const float* W = p.ada_w + (size_t)l * 1024 * NMOD + n0;
        const int cq = tid % 12, ks = tid / 12;
        float acc[5][4];
#pragma unroll
        for (int m = 0; m < 5; ++m)
#pragma unroll
            for (int j = 0; j < 4; ++j) acc[m][j] = 0.f;
        if (ks < 42) {
            const int k0 = ks * 25;
#pragma unroll 1
            for (int kk = 0; kk < 25; kk += 5) {
                f32x4 w[5];
#pragma unroll
                for (int u = 0; u < 5; ++u) { const int k = k0 + kk + u; w[u] = k < 1024 ? *(const f32x4*)(W + (size_t)k * NMOD + 4 * cq) : (f32x4){0.f, 0.f, 0.f, 0.f}; }
#pragma unroll
                for (int u = 0; u < 5; ++u) { const int k = (k0 + kk + u) < 1024 ? (k0 + kk + u) : 1023;
#pragma unroll
                    for (int m = 0; m < 5; ++m) { const float sv = sc[m * 1024 + k];
#pragma unroll
                        for (int j = 0; j < 4; ++j) acc[m][j] += sv * w[u][j]; } }
            }
#pragma unroll
            for (int m = 0; m < 5; ++m)
#pragma unroll
                for (int j = 0; j < 4; ++j) red[(ks * 5 + m) * 48 + 4 * cq + j] = acc[m][j];
        }
        __syncthreads();
        if (tid < 240) { const int m = tid / 48, j = tid % 48; float s = 0.f; for (int k = 0; k < 42; ++k) s += red[(k * 5 + m) * 48 + j];
            mod[((size_t)l * 5 + m) * NMOD + n0 + j] = s + p.ada_b[l * NMOD + n0 + j]; }
        __syncthreads();
    }
    if (blockIdx.x == gridDim.x - 1) {
        float* lbs = (float*)(p.ws + OFF_LBS);
        const float a = p.hgrn_lb[tid], b = p.hgrn_lb[512 + tid], c = p.hgrn_lb[1024 + tid];
        const float mx = fmaxf(a, fmaxf(b, c)); const float ea = __expf(a - mx), eb = __expf(b - mx), ec = __expf(c - mx);
        lbs[tid] = ea / (ea + eb + ec);
    }
}
DI void transpose_tiles(const float* W, int K, int N, int ldw, bf16_t* Wt, int tbase, int ttotal, LAS unsigned char* lds, int bid = -1, int nb = 0) {
    if (bid < 0) { bid = blockIdx.x; nb = gridDim.x; }
    LAS float* tile = (LAS float*)lds;
    const int tid = threadIdx.x, nk = K / 64, nn = N / 64, nt = nk * nn;
    int g = bid; if (g < tbase) g += ((tbase - g + nb - 1) / nb) * nb;
    __syncthreads();
    for (; g < tbase + nt; g += 4 * nb) {
        f32x4 v[4][2];
#pragma unroll
        for (int u = 0; u < 4; ++u) { const int gu = g + u * nb;
            if (gu < tbase + nt) { const int t = gu - tbase, tk = t % nk, tn = t / nk; const float* src = W + (size_t)(tk * 64 + (tid >> 4)) * ldw + tn * 64 + 4 * (tid & 15);
                v[u][0] = *(const f32x4*)src; v[u][1] = *(const f32x4*)(src + (size_t)32 * ldw); } }
#pragma unroll
        for (int u = 0; u < 4; ++u) { if (g + u * nb < tbase + nt) { LAS float* tl = tile + u * 4160; const int row = tid >> 4, c4 = tid & 15;
#pragma unroll
            for (int e = 0; e < 4; ++e) { tl[row * 65 + 4 * c4 + e] = v[u][0][e]; tl[(row + 32) * 65 + 4 * c4 + e] = v[u][1][e]; } } }
        __syncthreads();
#pragma unroll
        for (int u = 0; u < 4; ++u) { const int gu = g + u * nb;
            if (gu < tbase + nt) { const int t = gu - tbase, tk = t % nk, tn = t / nk, k0 = tk * 64, n0 = tn * 64; const LAS float* tl = tile + u * 4160;
                const int n = tid >> 3, k8 = tid & 7; u32x4 w;
                w.x = pg8::cvt_pk_bf16(tl[(k8 * 8 + 0) * 65 + n], tl[(k8 * 8 + 1) * 65 + n]); w.y = pg8::cvt_pk_bf16(tl[(k8 * 8 + 2) * 65 + n], tl[(k8 * 8 + 3) * 65 + n]);
                w.z = pg8::cvt_pk_bf16(tl[(k8 * 8 + 4) * 65 + n], tl[(k8 * 8 + 5) * 65 + n]); w.w = pg8::cvt_pk_bf16(tl[(k8 * 8 + 6) * 65 + n], tl[(k8 * 8 + 7) * 65 + n]);
                *(u32x4*)(Wt + (size_t)(n0 + n) * K + k0 + k8 * 8) = w; } }
        __syncthreads();
    }
    (void)ttotal;
}
DI void phase_w0(const Params& p, LAS unsigned char* lds) {
    bf16_t* w = (bf16_t*)(p.ws + OFF_W0);
    transpose_tiles(p.w_in, 1024, NPROJ, NPROJ_ALL, w, 0, 0, lds);
    for (int e = blockIdx.x * 512 + threadIdx.x; e < 16 * 1024; e += gridDim.x * 512) { const int k = e >> 4, j = e & 15; w[(size_t)(NPROJ + j) * DM + k] = f2bf(p.w_in[(size_t)k * NPROJ_ALL + NPROJ + j]); }
    for (int e = blockIdx.x * 512 + threadIdx.x; e < 240 * 128; e += gridDim.x * 512) *(u32x4*)(w + (size_t)(NPROJ + 16) * DM + (size_t)e * 8) = (u32x4){0u, 0u, 0u, 0u};
}
DI void bias_cols(const float* W, int N, const float* shv, float* outb, LAS unsigned char* lds, int bid, int nb) {
    LAS float* sv = (LAS float*)lds;
    LAS float* red = (LAS float*)(lds + 20480);
    const int tid = threadIdx.x, cq = tid & 7, ks = tid >> 3;
    __syncthreads();
    for (int e = tid; e < 5 * 1024; e += 512) sv[e] = shv[(size_t)(e >> 10) * NMOD + (e & 1023)];
    __syncthreads();
    for (int cb = bid; cb < N / 32; cb += nb) {
        const float* Wp = W + cb * 32 + 4 * cq;
        float acc[5][4];
#pragma unroll
        for (int m = 0; m < 5; ++m)
#pragma unroll
            for (int j = 0; j < 4; ++j) acc[m][j] = 0.f;
#pragma unroll 1
        for (int kk = 0; kk < 16; kk += 4) {
            f32x4 w[4];
#pragma unroll
            for (int u = 0; u < 4; ++u) w[u] = *(const f32x4*)(Wp + (size_t)(ks * 16 + kk + u) * N);
#pragma unroll
            for (int u = 0; u < 4; ++u)
#pragma unroll
                for (int m = 0; m < 5; ++m) { const float s0 = sv[m * 1024 + ks * 16 + kk + u];
#pragma unroll
                    for (int j = 0; j < 4; ++j) acc[m][j] += s0 * w[u][j]; }
        }
#pragma unroll
        for (int m = 0; m < 5; ++m)
#pragma unroll
            for (int j = 0; j < 4; ++j) red[(ks * 5 + m) * 32 + 4 * cq + j] = acc[m][j];
        __syncthreads();
        if (tid < 160) { const int m = tid >> 5, j = tid & 31; float s0 = 0.f; for (int k = 0; k < 64; ++k) s0 += red[(k * 5 + m) * 32 + j]; outb[(size_t)m * N + cb * 32 + j] = s0; }
        __syncthreads();
    }
}
DI void helper_l0(const Params& p, LAS unsigned char* lds, int bid, int nb) {
    bf16_t* w0 = (bf16_t*)(p.ws + OFF_W0) + (size_t)NPROJ_PAD * DM + (size_t)DM * DM;
    transpose_tiles(p.w_mlp1, 1024, 4096, 4096, w0, 0, 0, lds, bid, nb);
    transpose_tiles(p.w_mlp2, 4096, 1024, 1024, w0 + (size_t)DFF * DM, 1024, 0, lds, bid, nb);
    bias_cols(p.w_mlp1, 4096, (const float*)(p.ws + OFF_MOD) + 3072, (float*)(p.ws + OFF_CB), lds, bid, nb);
}
DI void helper_l1(const Params& p, LAS unsigned char* lds, int bid, int nb) {
    bf16_t* w = (bf16_t*)(p.ws + OFF_W1);
    int tb = 0;
    transpose_tiles(p.w_qkv, 1024, 3072, 3072, w, tb, 0, lds, bid, nb); tb += 16 * 48;
    transpose_tiles(p.w_out_na, 1024, 1024, 1024, w + (size_t)3072 * DM, tb, 0, lds, bid, nb); tb += 256;
    transpose_tiles(p.w_mlp1 + (size_t)DM * DFF, 1024, 4096, 4096, w + (size_t)3072 * DM + (size_t)DM * DM, tb, 0, lds, bid, nb); tb += 1024;
    transpose_tiles(p.w_mlp2 + (size_t)DFF * DM, 4096, 1024, 1024, w + (size_t)3072 * DM + (size_t)DM * DM + (size_t)DFF * DM, tb, 0, lds, bid, nb);
    const float* mod1 = (const float*)(p.ws + OFF_MOD) + (size_t)5 * NMOD;
    bias_cols(p.w_qkv, 3072, mod1, (float*)(p.ws + OFF_CB) + 5 * 4096, lds, bid, nb);
    bias_cols(p.w_mlp1 + (size_t)DM * DFF, 4096, mod1 + 3072, (float*)(p.ws + OFF_CB) + 5 * 4096 + 5 * 3072, lds, bid, nb);
    { bf16_t* CK = (bf16_t*)(p.ws + OFF_CK); const int tid = threadIdx.x;
      for (int e = bid * 512 + tid; e < 262144; e += nb * 512) {
          const float* src = e < 131072 ? p.cache_k + (size_t)e * 8 : p.cache_v + (size_t)(e - 131072) * 8;
          const f32x4 a = *(const f32x4*)src, b = *(const f32x4*)(src + 4);
          *(u32x4*)(CK + (size_t)e * 8) = (u32x4){pg8::cvt_pk_bf16(a[0], a[1]), pg8::cvt_pk_bf16(a[2], a[3]), pg8::cvt_pk_bf16(b[0], b[1]), pg8::cvt_pk_bf16(b[2], b[3])}; } }
}
DI void phase_w1(const Params& p, LAS unsigned char* lds) {
    transpose_tiles(p.w_out_ab, 1024, 1024, 1024, (bf16_t*)(p.ws + OFF_W0) + (size_t)NPROJ_PAD * DM, 0, 0, lds);
}
template <bool AB> DI void phase_norm(const Params& p, const float* srcp, const float* srcs, int l, int sub, LAS unsigned char* lds) {
    const int tid = threadIdx.x, wid = tid >> 6, lane = tid & 63;
    const float* mod = (const float*)(p.ws + OFF_MOD) + (size_t)l * 5 * NMOD;
    const float* gw = p.norm_g + (l * 2 + sub) * 1024;
    bf16_t* H = (bf16_t*)(p.ws + OFF_H);
    LAS float* wab = (LAS float*)lds;
    if (AB) {
#pragma unroll
        for (int u = 0; u < 8; ++u) { const int e4 = tid + u * 512, k = e4 >> 2, j4 = e4 & 3;
            *(LAS f32x4*)(wab + k * 16 + 4 * j4) = *(const f32x4*)(p.w_in + (size_t)k * NPROJ_ALL + NPROJ + 4 * j4); }
        __syncthreads(); }
    SUBSTAMP(lds, 32);
    float* ab = (float*)(p.ws + OFF_AB);
    const int stride = 1;
    for (int tb = blockIdx.x * 32 + wid * 4; tb < NTOK; tb += gridDim.x * 32) {
        f32x4 x[4][4]; float ss[4];
#pragma unroll
        for (int r = 0; r < 4; ++r) { const int tok = tb + r * stride;
            if (tok < NTOK) { const float* xr = tok < 4096 ? srcp + (size_t)tok * 1024 : srcs + (size_t)(tok - 4096) * 1024;
#pragma unroll
                for (int i = 0; i < 4; ++i) x[r][i] = *(const f32x4*)(xr + i * 256 + lane * 4); }
            else {
#pragma unroll
                for (int i = 0; i < 4; ++i) x[r][i] = (f32x4){0.f, 0.f, 0.f, 0.f}; } }
        f32x4 g4[4];
#pragma unroll
        for (int i = 0; i < 4; ++i) g4[i] = *(const f32x4*)(gw + i * 256 + lane * 4);
#pragma unroll
        for (int r = 0; r < 4; ++r) { float a = 0.f;
#pragma unroll
            for (int i = 0; i < 4; ++i) a += x[r][i][0] * x[r][i][0] + x[r][i][1] * x[r][i][1] + x[r][i][2] * x[r][i][2] + x[r][i][3] * x[r][i][3];
            ss[r] = a; }
#pragma unroll
        for (int o = 32; o > 0; o >>= 1) {
#pragma unroll
            for (int r = 0; r < 4; ++r) ss[r] += __shfl_xor(ss[r], o); }
#pragma unroll
        for (int r = 0; r < 4; ++r) { const int tok = tb + r * stride; if (tok >= NTOK) break;
            const float rs = rsqrtf(ss[r] * (1.0f / 1024.0f) + 1e-6f);
            const int mr = modrow(tok);
            const float* sh = mod + (size_t)mr * NMOD + sub * 3072; const float* scp = sh + 1024;
            float pa[16];
            if (AB) {
#pragma unroll
                for (int j = 0; j < 16; ++j) pa[j] = 0.f; }
#pragma unroll
            for (int i = 0; i < 4; ++i) { const int k = i * 256 + lane * 4;
                const f32x4 s4 = *(const f32x4*)(scp + k), h4 = *(const f32x4*)(sh + k);
                f32x4 hv;
#pragma unroll
                for (int e = 0; e < 4; ++e) hv[e] = x[r][i][e] * rs * g4[i][e] * (1.0f + s4[e]) + h4[e];
                uint2 w; w.x = pg8::cvt_pk_bf16(hv[0], hv[1]); w.y = pg8::cvt_pk_bf16(hv[2], hv[3]);
                *(uint2*)(H + (size_t)tok * 1024 + k) = w;
                if (AB) {
#pragma unroll
                    for (int e = 0; e < 4; ++e) {
#pragma unroll
                        for (int j4 = 0; j4 < 4; ++j4) { const f32x4 wv = *(const LAS f32x4*)(wab + (k + e) * 16 + 4 * j4);
                            pa[4 * j4 + 0] += hv[e] * wv[0]; pa[4 * j4 + 1] += hv[e] * wv[1]; pa[4 * j4 + 2] += hv[e] * wv[2]; pa[4 * j4 + 3] += hv[e] * wv[3]; } } }
            }
            if (AB) {
                float mine = 0.f;
#pragma unroll
                for (int j = 0; j < 16; ++j) { const float sv = wave_sum(pa[j]); if (lane == j) mine = sv; }
                if (lane < 16) ab[(size_t)tok * 16 + lane] = mine;
            }
        }
    }
}
DI int chunk_seq_start(int gc) { return gc < 128 ? (gc >> 3) * 256 : 4096 + ((gc - 128) >> 5) * 1024; }
DI int chunk_seq_len(int gc) { return gc < 128 ? 256 : 1024; }
struct PrepRaw { u32x4 v[4]; float ab; };
DI void prep_fetch(const Params& p, int pi, int kind, PrepRaw& R) {
    const int tid = threadIdx.x, h = pi & 3, gc = pi >> 2, t0 = gc * 32;
    const bf16_t* proj = (const bf16_t*)(p.ws + OFF_PROJ);
    if (kind == 0) {
        const int sb = chunk_seq_start(gc), se = sb + chunk_seq_len(gc);
#pragma unroll
        for (int k = 0; k < 4; ++k) { const int pc = tid + k * 512; R.v[k] = (u32x4){0u, 0u, 0u, 0u};
            if (pc < 1728) { const int row = pc / 48, rem = pc % 48, part = rem >> 4, c8 = rem & 15, tk = t0 - 2 + row;
                if (tk >= sb && tk < se) R.v[k] = *(const u32x4*)(proj + (size_t)tk * NPROJ + 2560 + part * 512 + h * 128 + c8 * 8); } }
        R.ab = 0.f;
        if (tid < 128) { const int i = tid >> 2, w = tid & 3;
            R.ab = ((const float*)(p.ws + OFF_AB))[(size_t)(t0 + i) * 16 + w * 4 + h]; }
    } else {
#pragma unroll
        for (int k = 0; k < 3; ++k) { const int pc = tid + k * 512, row = pc / 48, rem = pc % 48, which = rem >> 4, c8 = rem & 15;
            R.v[k] = *(const u32x4*)(proj + (size_t)(t0 + row) * NPROJ + which * 512 + h * 128 + c8 * 8); }
    }
}
DI void gdn_prep_item(const Params& p, int gc, int h, const PrepRaw& R, LAS unsigned char* lds) {
    int tid_ = threadIdx.x; asm volatile("" : "+v"(tid_));
    const int tid = tid_, wid = __builtin_amdgcn_readfirstlane(tid >> 6), lane = tid & 63;
    LAS bf16_t* RAW = (LAS bf16_t*)lds;
    LAS bf16_t* QB = (LAS bf16_t*)(lds + 27648); LAS bf16_t* KB = (LAS bf16_t*)(lds + 36352); LAS bf16_t* VB = (LAS bf16_t*)(lds + 45056);
    LAS float* KK = (LAS float*)(lds + 53760); LAS float* QK = (LAS float*)(lds + 57984);
    LAS float* CW = (LAS float*)(lds + 117248); LAS float* ABL = (LAS float*)(lds + 124928);
#pragma unroll
    for (int k = 0; k < 4; ++k) { const int pc = tid + k * 512; if (pc < 1728) *(LAS u32x4*)(RAW + pc * 8) = R.v[k]; }
    if (tid < 128) ABL[tid] = R.ab;
    __syncthreads();
    { const int i = tid >> 4, cg = tid & 15;
#pragma unroll 1
      for (int part = 0; part < 3; ++part) {
          float a[8];
#pragma unroll
          for (int e = 0; e < 8; ++e) a[e] = 0.f;
#pragma unroll
          for (int j = 0; j < 5; ++j) { const u16x8 x = *(const LAS u16x8*)(RAW + (i + j) * 384 + part * 128 + cg * 8);
              const f32x4 w0 = *(const LAS f32x4*)(CW + j * 384 + part * 128 + cg * 8), w1 = *(const LAS f32x4*)(CW + j * 384 + part * 128 + cg * 8 + 4);
#pragma unroll
              for (int e = 0; e < 4; ++e) { a[e] += bf2f(x[e]) * w0[e]; a[4 + e] += bf2f(x[4 + e]) * w1[e]; } }
          float ss = 0.f;
#pragma unroll
          for (int e = 0; e < 8; ++e) { a[e] = siluf_(a[e]); ss += a[e] * a[e]; }
          float sc = 1.f;
          if (part < 2) { ss += __shfl_xor(ss, 1); ss += __shfl_xor(ss, 2); ss += __shfl_xor(ss, 4); ss += __shfl_xor(ss, 8);
              sc = rsqrtf(ss + 1e-6f) * (part == 0 ? 0.08838834764831845f : 1.f); }
          u32x4 w; w.x = pg8::cvt_pk_bf16(a[0] * sc, a[1] * sc); w.y = pg8::cvt_pk_bf16(a[2] * sc, a[3] * sc); w.z = pg8::cvt_pk_bf16(a[4] * sc, a[5] * sc); w.w = pg8::cvt_pk_bf16(a[6] * sc, a[7] * sc);
          *(LAS u32x4*)(QB + part * 4352 + i * 136 + cg * 8) = w;
      } }
    __syncthreads();
    { const int w4 = wid & 3, mt = w4 >> 1, nt = w4 & 1, r = lane & 15, q = lane >> 4;
      f32x4 acc = {0.f, 0.f, 0.f, 0.f};
      acc = mma16((wid < 4 ? KB : QB) + 16 * mt * 136, 136, KB + 16 * nt * 136, 136, 128, acc);
      LAS float* D = wid < 4 ? KK : QK;
#pragma unroll
      for (int i = 0; i < 4; ++i) D[(16 * mt + 4 * q + i) * 33 + 16 * nt + r] = acc[i]; }
    const int dir = wid >> 2, ht = tid & 255, hw = wid & 3;
    LAS float* GS = (LAS float*)(lds + 62208 + dir * 256); LAS float* AM = (LAS float*)(lds + 62720 + dir * 4224);
    LAS bf16_t* TM = (LAS bf16_t*)(lds + 71168 + dir * 2560); LAS bf16_t* RT = (LAS bf16_t*)(lds + 76288 + dir * 20480);
    bf16_t* pack = (bf16_t*)(p.ws + OFF_PACK + ((size_t)(gc * 4 + h) * 2 + dir) * GDN_PACK_B);
    if (hw == 0) {
        const int pp = lane & 31, i = dir ? 31 - pp : pp;
        const float araw = ABL[i * 4 + dir], braw = ABL[i * 4 + 2 + dir];
        const float beta = sigmoidf_(braw);
        float g = -__expf(p.a_log[dir * 4 + h]) * softplusf_(araw + p.dt_bias[dir * 4 + h]);
#pragma unroll
        for (int o = 1; o < 32; o <<= 1) { const float t = __shfl_up(g, o, 32); if (pp >= o) g += t; }
        if (lane < 32) { GS[pp] = g; GS[32 + pp] = beta; }
    }
    __syncthreads();
    { const int pp = ht >> 3, s0 = (ht & 7) * 4, ip = dir ? 31 - pp : pp; const float gp = GS[pp], bp = GS[32 + pp];
      float at[4];
#pragma unroll
      for (int e = 0; e < 4; ++e) { const int s = s0 + e, is = dir ? 31 - s : s; const float dec = s <= pp ? __expf(gp - GS[s]) : 0.f;
          AM[pp * 33 + s] = s < pp ? bp * KK[ip * 33 + is] * dec : 0.f; at[e] = s <= pp ? QK[ip * 33 + is] * dec : 0.f; }
      uint2 w; w.x = pg8::cvt_pk_bf16(at[0], at[1]); w.y = pg8::cvt_pk_bf16(at[2], at[3]);
      *(uint2*)(pack + 12288 + pp * 32 + s0) = w; }
    __syncthreads();
    if (hw == 0) {
        if (lane < 32) {
            float x[32];
#pragma unroll
            for (int pp = 0; pp < 32; ++pp) {
                float a0 = (pp == lane) ? 1.f : 0.f, a1 = 0.f;
#pragma unroll
                for (int j4 = 0; j4 < (pp + 3) / 4; ++j4) { const LAS float* ar = AM + pp * 33 + 4 * j4;
#pragma unroll
                    for (int e = 0; e < 4; ++e) { const int j = 4 * j4 + e; if (j < pp) { if (e & 1) a1 -= ar[e] * x[j]; else a0 -= ar[e] * x[j]; } } }
                x[pp] = a0 + a1; TM[pp * 40 + lane] = f2bf(a0 + a1);
            }
        }
    } else {
        const float gl = GS[31];
        if (ht == 64) *(float*)((unsigned char*)pack + 34816) = __expf(gl);
        for (int task = ht - 64; task < 2048; task += 192) {
            if (task < 1024) {
                const int row = task >> 2, p0 = (task & 3) * 8, d = row & 127; const LAS bf16_t* src = row < 128 ? KB : VB;
                float o[8];
#pragma unroll
                for (int e = 0; e < 8; ++e) { const int pp = p0 + e, ip = dir ? 31 - pp : pp; const float sc = GS[32 + pp] * (row < 128 ? __expf(GS[pp]) : 1.f); o[e] = bf2f(src[ip * 136 + d]) * sc; }
                u32x4 w; w.x = pg8::cvt_pk_bf16(o[0], o[1]); w.y = pg8::cvt_pk_bf16(o[2], o[3]); w.z = pg8::cvt_pk_bf16(o[4], o[5]); w.w = pg8::cvt_pk_bf16(o[6], o[7]);
                *(LAS u32x4*)(RT + row * 40 + p0) = w;
            } else if (task < 1536) {
                const int t2 = task - 1024, pp = t2 >> 4, d0 = (t2 & 15) * 8, ip = dir ? 31 - pp : pp; const float eg = __expf(GS[pp]);
                const u16x8 x = *(const LAS u16x8*)(QB + ip * 136 + d0);
                u32x4 w; w.x = pg8::cvt_pk_bf16(bf2f(x[0]) * eg, bf2f(x[1]) * eg); w.y = pg8::cvt_pk_bf16(bf2f(x[2]) * eg, bf2f(x[3]) * eg);
                w.z = pg8::cvt_pk_bf16(bf2f(x[4]) * eg, bf2f(x[5]) * eg); w.w = pg8::cvt_pk_bf16(bf2f(x[6]) * eg, bf2f(x[7]) * eg);
                *(u32x4*)(pack + 4096 + pp * 128 + d0) = w;
            } else {
                const int t2 = task - 1536, d = t2 >> 2, p0 = (t2 & 3) * 8;
                float o[8];
#pragma unroll
                for (int e = 0; e < 8; ++e) { const int pp = p0 + e, ip = dir ? 31 - pp : pp; o[e] = bf2f(KB[ip * 136 + d]) * __expf(gl - GS[pp]); }
                u32x4 w; w.x = pg8::cvt_pk_bf16(o[0], o[1]); w.y = pg8::cvt_pk_bf16(o[2], o[3]); w.z = pg8::cvt_pk_bf16(o[4], o[5]); w.w = pg8::cvt_pk_bf16(o[6], o[7]);
                *(u32x4*)(pack + 8192 + d * 32 + p0) = w;
            }
        }
    }
    __syncthreads();
#pragma unroll
    for (int t = 0; t < 8; ++t) { const int id = hw * 8 + t, which = id >> 4, dt = (id >> 1) & 7, pt = id & 1, r = lane & 15, q = lane >> 4;
        f32x4 acc = {0.f, 0.f, 0.f, 0.f};
        acc = mma16(RT + (which * 128 + 16 * dt) * 40, 40, TM + 16 * pt * 40, 40, 32, acc);
        uint2 w; w.x = pack2_safe(acc[0], acc[1]); w.y = pack2_safe(acc[2], acc[3]);
        *(uint2*)(pack + (which ? 13312 : 0) + (16 * pt + r) * 128 + 16 * dt + 4 * q) = w; }
    __syncthreads();
}
template <int PH> DI void hgrn_cols(const Params& p, const LAS bf16_t* RAW, LAS bf16_t* QT, LAS bf16_t* KT, bf16_t* pack, const float* lbs, int h, int dir, int d) {
    const float lb = lbs[h * 128 + d];
    float g[32];
    float acc = 0.f;
#pragma unroll
    for (int pp = 0; pp < 32; ++pp) { const int ip = dir ? 31 - pp : pp; const float fraw = bf2f(RAW[ip * 384 + 128 + dir * 128 + d]);
        acc += __logf(lb + (1.0f - lb) * sigmoidf_(fraw)); g[pp] = acc; }
    const float gl = g[31], gr = g[15];
    if (PH == 1) ((float*)((unsigned char*)pack + 18432))[d] = __expf(gl);
    float kh[16];
#pragma unroll
    for (int e = 0; e < 16; ++e) {
        const int pp = PH * 16 + e, ip = dir ? 31 - pp : pp;
        const float ge = g[pp], gm = pp ? g[pp - 1] : 0.f;
        const float qv = siluf_(bf2f(RAW[ip * 384 + d])) * 0.08838834764831845f, kv = 1.0f - __expf(ge - gm);
        pack[1024 + pp * 128 + d] = f2bf(qv * __expf(ge));
        kh[e] = kv * __expf(gl - ge);
        QT[pp * 136 + d] = f2bf(qv * __expf(ge - gr)); KT[pp * 136 + d] = f2bf(kv * __expf(gr - ge));
    }
    u32x4 w0, w1;
    w0.x = pg8::cvt_pk_bf16(kh[0], kh[1]); w0.y = pg8::cvt_pk_bf16(kh[2], kh[3]); w0.z = pg8::cvt_pk_bf16(kh[4], kh[5]); w0.w = pg8::cvt_pk_bf16(kh[6], kh[7]);
    w1.x = pg8::cvt_pk_bf16(kh[8], kh[9]); w1.y = pg8::cvt_pk_bf16(kh[10], kh[11]); w1.z = pg8::cvt_pk_bf16(kh[12], kh[13]); w1.w = pg8::cvt_pk_bf16(kh[14], kh[15]);
    *(u32x4*)(pack + 5120 + d * 32 + PH * 16) = w0; *(u32x4*)(pack + 5120 + d * 32 + PH * 16 + 8) = w1;
}
DI void hgrn_prep_item(const Params& p, int gc, int h, const PrepRaw& R, LAS unsigned char* lds) {
    int tid_ = threadIdx.x; asm volatile("" : "+v"(tid_));
    const int tid = tid_, wid = __builtin_amdgcn_readfirstlane(tid >> 6), lane = tid & 63;
    LAS bf16_t* RAW = (LAS bf16_t*)lds;
    const float* lbs = (const float*)(p.ws + OFF_LBS);
#pragma unroll
    for (int k = 0; k < 3; ++k) *(LAS u32x4*)(RAW + (tid + k * 512) * 8) = R.v[k];
    __syncthreads();
    const int dir = wid >> 2, ht = tid & 255, hw = wid & 3, d = ht & 127, ph = ht >> 7;
    LAS bf16_t* QT = (LAS bf16_t*)(lds + 24576 + dir * 17408); LAS bf16_t* KT = (LAS bf16_t*)(lds + 33280 + dir * 17408);
    bf16_t* pack = (bf16_t*)(p.ws + OFF_PACK + SZ_GPACK + ((size_t)(gc * 4 + h) * 2 + dir) * HG_PACK_B);
    if (ph == 0) hgrn_cols<0>(p, RAW, QT, KT, pack, lbs, h, dir, d); else hgrn_cols<1>(p, RAW, QT, KT, pack, lbs, h, dir, d);
    __syncthreads();
    { const int mt = hw >> 1, nt = hw & 1, r = lane & 15, q = lane >> 4;
      f32x4 acc = {0.f, 0.f, 0.f, 0.f};
      acc = mma16(QT + 16 * mt * 136, 136, KT + 16 * nt * 136, 136, 128, acc);
#pragma unroll
      for (int i = 0; i < 4; ++i) { const int pp = 16 * mt + 4 * q + i, s = 16 * nt + r; pack[pp * 32 + s] = f2bf(s <= pp ? acc[i] : 0.f); } }
    __syncthreads();
}
DI void phase_prep(const Params& p, LAS unsigned char* lds) {
    const int G = gridDim.x, tid = threadIdx.x;
    LAS float* CW = (LAS float*)(lds + 117248);
    int cwh = -1;
    PrepRaw R;
    int pi = blockIdx.x;
    if (pi < 1024) prep_fetch(p, pi, 0, R);
#pragma unroll 1
    for (; pi < 1024; pi += G) {
        const int h = pi & 3, gc = pi >> 2;
        if (h != cwh) { __syncthreads(); for (int e = tid; e < 5 * 384; e += 512) { const int j = e / 384, c = e % 384; CW[e] = p.gdn_conv[j * 1536 + (c >> 7) * 512 + h * 128 + (c & 127)]; } cwh = h; }
        PrepRaw R2; prep_fetch(p, pi, 1, R2);
        gdn_prep_item(p, gc, h, R, lds);
        if (pi + G < 1024) prep_fetch(p, pi + G, 0, R);
        hgrn_prep_item(p, gc, h, R2, lds);
    }
}
struct ScanPre { u32x4 v[5]; };
template <bool GDN> DI void scan_fetch(const Params& p, const unsigned char* packb, int tok0, int h, int dir, ScanPre& R) {
    const int tid = threadIdx.x; const bf16_t* pack = (const bf16_t*)packb;
    if (GDN) { R.v[0] = *(const u32x4*)(pack + tid * 8); R.v[1] = *(const u32x4*)(pack + 4096 + tid * 8); R.v[2] = *(const u32x4*)(pack + 8192 + tid * 8);
        R.v[3] = *(const u32x4*)(pack + 13312 + tid * 8); R.v[4] = tid < 128 ? *(const u32x4*)(pack + 12288 + tid * 8) : *(const u32x4*)(packb + 34816); }
    else { R.v[0] = *(const u32x4*)(pack + 1024 + tid * 8); R.v[2] = *(const u32x4*)(pack + 5120 + tid * 8);
        { const int pp = tid >> 4, ip = dir ? 31 - pp : pp; R.v[1] = *(const u32x4*)((const bf16_t*)(p.ws + OFF_PROJ) + (size_t)(tok0 + ip) * NPROJ + 1536 + h * 128 + (tid & 15) * 8); }
        R.v[3] = tid < 32 ? *(const u32x4*)(packb + 18432 + tid * 16) : (u32x4){0u, 0u, 0u, 0u};
        R.v[4] = tid < 128 ? *(const u32x4*)(pack + tid * 8) : (u32x4){0u, 0u, 0u, 0u}; }
}
template <bool GDN> DI void scan_stash(LAS unsigned char* buf, const ScanPre& R) {
    const int tid = threadIdx.x, row = tid >> 4, c8 = (tid & 15) * 8, kr = tid >> 2, k8 = (tid & 3) * 8;
    *(LAS u32x4*)((LAS bf16_t*)buf + row * 136 + c8) = R.v[0];
    *(LAS u32x4*)((LAS bf16_t*)(buf + 8704) + row * 136 + c8) = R.v[1];
    *(LAS u32x4*)((LAS bf16_t*)(buf + 17408) + kr * 40 + k8) = R.v[2];
    if (GDN) { *(LAS u32x4*)((LAS bf16_t*)(buf + 30208) + row * 136 + c8) = R.v[3]; if (tid == 128) *(LAS unsigned*)(buf + 38912) = R.v[4].x; }
    else if (tid < 32) *(LAS u32x4*)(buf + 30208 + tid * 16) = R.v[3];
    if (tid < 128) *(LAS u32x4*)((LAS bf16_t*)(buf + 27648) + (tid >> 2) * 40 + k8) = R.v[4];
}
template <bool GDN> DI void scan_item(const Params& p, int s, int h, int dir, LAS unsigned char* lds) {
    int tid_ = threadIdx.x; asm volatile("" : "+v"(tid_));
    const int tid = tid_, wid = __builtin_amdgcn_readfirstlane(tid >> 6), lane = tid & 63, r = lane & 15, q = lane >> 4, dv0 = wid * 16;
    LAS bf16_t* ST = (LAS bf16_t*)(lds + 77856 + wid * 4352); LAS bf16_t* VN = (LAS bf16_t*)(lds + 112672 + wid * 1280);
    const int sstart = s < 16 ? s * 256 : 4096 + (s - 16) * 1024, N = s < 16 ? 8 : 32, gc0 = sstart >> 5;
    bf16_t* O = (bf16_t*)(p.ws + OFF_O) + (size_t)dir * NTOK * DM;
    const unsigned char* pbase = p.ws + OFF_PACK + (GDN ? 0 : SZ_GPACK);
    const size_t pstride = GDN ? GDN_PACK_B : HG_PACK_B;
    ScanPre Ra;
    auto fetch = [&](int mm, ScanPre& R) { if (mm < N) { const int nn = dir ? N - 1 - mm : mm; scan_fetch<GDN>(p, pbase + ((size_t)((gc0 + nn) * 4 + h) * 2 + dir) * pstride, sstart + 32 * nn, h, dir, R); } };
    fetch(0, Ra);
    f32x4 S[8];
    if (s >= 16) { const float* st = (GDN ? p.st_gdn : p.st_hgrn) + ((size_t)((s - 16) * 2 + dir) * 4 + h) * 16384;
#pragma unroll
        for (int i = 0; i < 8; ++i)
#pragma unroll
            for (int j = 0; j < 4; ++j) S[i][j] = st[(16 * i + 4 * q + j) * 128 + dv0 + r];
    } else {
#pragma unroll
        for (int i = 0; i < 8; ++i) S[i] = (f32x4){0.f, 0.f, 0.f, 0.f}; }
#pragma unroll
    for (int i = 0; i < 8; ++i) { u32x2 w; w.x = pack2_safe(S[i][0], S[i][1]); w.y = pack2_safe(S[i][2], S[i][3]); *(LAS u32x2*)(ST + r * 136 + 16 * i + 4 * q) = w; }
    __syncthreads();
    scan_stash<GDN>(lds, Ra);
#pragma unroll 1
    for (int m = 0; m < N; ++m) {
        const int n = dir ? N - 1 - m : m;
        LAS unsigned char* buf = lds + (m & 1) * 38928;
        LAS bf16_t* A0 = (LAS bf16_t*)buf; LAS bf16_t* A1 = (LAS bf16_t*)(buf + 8704); LAS bf16_t* KT = (LAS bf16_t*)(buf + 17408);
        LAS bf16_t* AT = (LAS bf16_t*)(buf + 27648); LAS bf16_t* U = (LAS bf16_t*)(buf + 30208); LAS float* av = (LAS float*)(buf + 30208);
        fetch(m + 1, Ra);
        __syncthreads();
        const float egl = GDN ? *(const LAS float*)(buf + 38912) : 1.f;
        const int fo = r * 136 + 8 * q, fk = r * 40 + 8 * q;
        bf16x8 bst[4], a0f[2][4], atf[2], ktf[8];
#pragma unroll
        for (int kk = 0; kk < 4; ++kk) { bst[kk] = *(const LAS bf16x8*)(ST + fo + 32 * kk); a0f[0][kk] = *(const LAS bf16x8*)(A0 + fo + 32 * kk); a0f[1][kk] = *(const LAS bf16x8*)(A0 + 16 * 136 + fo + 32 * kk); }
        atf[0] = *(const LAS bf16x8*)(AT + fk); atf[1] = *(const LAS bf16x8*)(AT + 16 * 40 + fk);
#pragma unroll
        for (int i = 0; i < 8; ++i) ktf[i] = *(const LAS bf16x8*)(KT + 16 * i * 40 + fk);
        if (GDN) {
            bf16x8 a1f[2][4];
#pragma unroll
            for (int kk = 0; kk < 4; ++kk) { a1f[0][kk] = *(const LAS bf16x8*)(A1 + fo + 32 * kk); a1f[1][kk] = *(const LAS bf16x8*)(A1 + 16 * 136 + fo + 32 * kk); }
            float uv[2][4];
#pragma unroll
            for (int mt = 0; mt < 2; ++mt)
#pragma unroll
                for (int i = 0; i < 4; ++i) uv[mt][i] = bf2f(U[(16 * mt + 4 * q + i) * 136 + dv0 + r]);
            __builtin_amdgcn_sched_barrier(0);
            f32x4 ws[2] = {{0.f, 0.f, 0.f, 0.f}, {0.f, 0.f, 0.f, 0.f}};
#pragma unroll
            for (int kk = 0; kk < 4; ++kk) { ws[0] = __builtin_amdgcn_mfma_f32_16x16x32_bf16(a0f[0][kk], bst[kk], ws[0], 0, 0, 0); ws[1] = __builtin_amdgcn_mfma_f32_16x16x32_bf16(a0f[1][kk], bst[kk], ws[1], 0, 0, 0); }
#pragma unroll
            for (int mt = 0; mt < 2; ++mt) { u32x2 w; w.x = pack2_safe(uv[mt][0] - ws[mt][0], uv[mt][1] - ws[mt][1]); w.y = pack2_safe(uv[mt][2] - ws[mt][2], uv[mt][3] - ws[mt][3]);
                *(LAS u32x2*)(VN + r * 40 + 16 * mt + 4 * q) = w; }
            f32x4 oo[2] = {{0.f, 0.f, 0.f, 0.f}, {0.f, 0.f, 0.f, 0.f}};
#pragma unroll
            for (int kk = 0; kk < 4; ++kk) { oo[0] = __builtin_amdgcn_mfma_f32_16x16x32_bf16(a1f[0][kk], bst[kk], oo[0], 0, 0, 0); oo[1] = __builtin_amdgcn_mfma_f32_16x16x32_bf16(a1f[1][kk], bst[kk], oo[1], 0, 0, 0); }
#pragma unroll
            for (int i = 0; i < 8; ++i) S[i] = S[i] * egl;
            asm volatile("s_waitcnt lgkmcnt(0)" ::: "memory");
            const bf16x8 bvn = *(const LAS bf16x8*)(VN + fk);
            oo[0] = __builtin_amdgcn_mfma_f32_16x16x32_bf16(atf[0], bvn, oo[0], 0, 0, 0); oo[1] = __builtin_amdgcn_mfma_f32_16x16x32_bf16(atf[1], bvn, oo[1], 0, 0, 0);
#pragma unroll
            for (int i = 0; i < 8; ++i) S[i] = __builtin_amdgcn_mfma_f32_16x16x32_bf16(ktf[i], bvn, S[i], 0, 0, 0);
#pragma unroll
            for (int mt = 0; mt < 2; ++mt)
#pragma unroll
                for (int i = 0; i < 4; ++i) { const int pp = 16 * mt + 4 * q + i, ip = dir ? 31 - pp : pp;
                    O[(size_t)(sstart + 32 * n + ip) * DM + 512 + h * 128 + dv0 + r] = f2bf(oo[mt][i]); }
        } else {
            { const int pp = lane >> 1, d8 = (lane & 1) * 8; const u16x8 x = *(const LAS u16x8*)(A1 + pp * 136 + dv0 + d8);
#pragma unroll
              for (int e = 0; e < 8; ++e) VN[(d8 + e) * 40 + pp] = x[e]; }
            f32x4 a4[8];
#pragma unroll
            for (int i = 0; i < 8; ++i) a4[i] = *(const LAS f32x4*)(av + 16 * i + 4 * q);
            __builtin_amdgcn_sched_barrier(0);
            f32x4 oo[2] = {{0.f, 0.f, 0.f, 0.f}, {0.f, 0.f, 0.f, 0.f}};
#pragma unroll
            for (int kk = 0; kk < 4; ++kk) { oo[0] = __builtin_amdgcn_mfma_f32_16x16x32_bf16(a0f[0][kk], bst[kk], oo[0], 0, 0, 0); oo[1] = __builtin_amdgcn_mfma_f32_16x16x32_bf16(a0f[1][kk], bst[kk], oo[1], 0, 0, 0); }
#pragma unroll
            for (int i = 0; i < 8; ++i) S[i] = S[i] * a4[i];
            asm volatile("s_waitcnt lgkmcnt(0)" ::: "memory");
            const bf16x8 bvn = *(const LAS bf16x8*)(VN + fk);
            oo[0] = __builtin_amdgcn_mfma_f32_16x16x32_bf16(atf[0], bvn, oo[0], 0, 0, 0); oo[1] = __builtin_amdgcn_mfma_f32_16x16x32_bf16(atf[1], bvn, oo[1], 0, 0, 0);
#pragma unroll
            for (int i = 0; i < 8; ++i) S[i] = __builtin_amdgcn_mfma_f32_16x16x32_bf16(ktf[i], bvn, S[i], 0, 0, 0);
#pragma unroll
            for (int mt = 0; mt < 2; ++mt)
#pragma unroll
                for (int i = 0; i < 4; ++i) { const int pp = 16 * mt + 4 * q + i, ip = dir ? 31 - pp : pp;
                    O[(size_t)(sstart + 32 * n + ip) * DM + h * 128 + dv0 + r] = f2bf(oo[mt][i]); }
        }
        asm volatile("s_waitcnt lgkmcnt(0)" ::: "memory");
#pragma unroll
        for (int i = 0; i < 8; ++i) { u32x2 w; w.x = pack2_safe(S[i][0], S[i][1]); w.y = pack2_safe(S[i][2], S[i][3]); *(LAS u32x2*)(ST + r * 136 + 16 * i + 4 * q) = w; }
        if (m + 1 < N) scan_stash<GDN>(lds + ((m + 1) & 1) * 38928, Ra);
        (void)U; (void)av;
    }
    if (s < 16) { float* so = p.out + (size_t)NTOK * DM + (GDN ? (size_t)2097152 : 0) + ((size_t)(s * 2 + dir) * 4 + h) * 16384;
#pragma unroll
        for (int i = 0; i < 8; ++i)
#pragma unroll
            for (int j = 0; j < 4; ++j) so[(16 * i + 4 * q + j) * 128 + dv0 + r] = S[i][j]; }
    __syncthreads();
}
DI void scan_dispatch(const Params& p, int it, LAS unsigned char* lds) {
    int mixer, dir, h, s;
    if (it < 64) { mixer = it & 1; dir = (it >> 1) & 1; h = (it >> 2) & 3; s = 16 + (it >> 4); }
    else { const int si = it - 64; mixer = si & 1; dir = (si >> 1) & 1; h = (si >> 2) & 3; s = si >> 4; }
    if (mixer) scan_item<true>(p, s, h, dir, lds); else scan_item<false>(p, s, h, dir, lds);
}
DI void phase_scan(const Params& p, LAS unsigned char* lds) {
    const int b = blockIdx.x, G = gridDim.x;
    if (G == 256) { scan_dispatch(p, b, lds); if (b >= 64 && b < 128) scan_dispatch(p, 256 + b - 64, lds); }
    else for (int it = b; it < 320; it += G) scan_dispatch(p, it, lds);
}
DI void phase_combine(const Params& p) {
    const int tid = threadIdx.x, wid = tid >> 6, lane = tid & 63;
    const bf16_t* O0 = (const bf16_t*)(p.ws + OFF_O); const bf16_t* O1 = O0 + (size_t)NTOK * DM;
    const bf16_t* proj = (const bf16_t*)(p.ws + OFF_PROJ);
    bf16_t* H = (bf16_t*)(p.ws + OFF_H);
    const int mixer = lane >> 5, d0 = (lane & 7) * 16, gcol = (mixer ? 4096 : 2048) + ((16 * lane) & 511);
    const float* gn = (mixer ? p.gn_gdn : p.gn_hgrn) + d0;
    for (int tok = blockIdx.x * 8 + wid; tok < NTOK; tok += gridDim.x * 8) {
        const u16x8 a0 = *(const u16x8*)(O0 + (size_t)tok * DM + 16 * lane), a1 = *(const u16x8*)(O0 + (size_t)tok * DM + 16 * lane + 8);
        const u16x8 b0 = *(const u16x8*)(O1 + (size_t)tok * DM + 16 * lane), b1 = *(const u16x8*)(O1 + (size_t)tok * DM + 16 * lane + 8);
        const u16x8 g0 = *(const u16x8*)(proj + (size_t)tok * NPROJ + gcol), g1 = *(const u16x8*)(proj + (size_t)tok * NPROJ + gcol + 8);
        float v[16]; float ss = 0.f;
#pragma unroll
        for (int j = 0; j < 8; ++j) { v[j] = bf2f(a0[j]) + bf2f(b0[j]); v[8 + j] = bf2f(a1[j]) + bf2f(b1[j]); }
#pragma unroll
        for (int j = 0; j < 16; ++j) ss += v[j] * v[j];
        ss += __shfl_xor(ss, 1); ss += __shfl_xor(ss, 2); ss += __shfl_xor(ss, 4);
        const float rs = rsqrtf(ss * (1.0f / 128.0f) + 1e-6f);
        unsigned w[8];
#pragma unroll
        for (int j = 0; j < 8; ++j) { const float ga = bf2f(j < 4 ? g0[2 * j] : g1[2 * j - 8]), gb = bf2f(j < 4 ? g0[2 * j + 1] : g1[2 * j - 7]);
            w[j] = pg8::cvt_pk_bf16(v[2 * j] * rs * gn[2 * j] * siluf_(ga), v[2 * j + 1] * rs * gn[2 * j + 1] * siluf_(gb)); }
        *(u32x4*)(H + (size_t)tok * DM + 16 * lane) = (u32x4){w[0], w[1], w[2], w[3]};
        *(u32x4*)(H + (size_t)tok * DM + 16 * lane + 8) = (u32x4){w[4], w[5], w[6], w[7]};
    }
}
DI void phase_qknorm(const Params& p) {
    const int tid = threadIdx.x, wid = tid >> 6, lane = tid & 63;
    const bf16_t* QKV = (const bf16_t*)(p.ws + OFF_PROJ);
    bf16_t* QN = (bf16_t*)(p.ws + OFF_O); bf16_t* KN = QN + (size_t)NTOK * DM;
    float* ck = p.out + (size_t)NTOK * DM + 2 * 2097152; float* cv = ck + 4194304;
    const int hd = lane >> 2, d0 = (lane & 3) * 16;
    for (int tok = blockIdx.x * 8 + wid; tok < NTOK; tok += gridDim.x * 8) {
#pragma unroll
        for (int part = 0; part < 2; ++part) {
            const bf16_t* src = QKV + (size_t)tok * 3072 + part * 1024 + 16 * lane;
            const u16x8 a0 = *(const u16x8*)src, a1 = *(const u16x8*)(src + 8);
            float v[16]; float ss = 0.f;
#pragma unroll
            for (int j = 0; j < 8; ++j) { v[j] = bf2f(a0[j]); v[8 + j] = bf2f(a1[j]); }
#pragma unroll
            for (int j = 0; j < 16; ++j) ss += v[j] * v[j];
            ss += __shfl_xor(ss, 1); ss += __shfl_xor(ss, 2);
            const float rs = rsqrtf(ss * (1.0f / 64.0f) + 1e-6f);
            const float* gw = (part ? p.kn : p.qn) + d0;
#pragma unroll
            for (int j = 0; j < 16; ++j) v[j] = v[j] * rs * gw[j];
            unsigned w[8];
#pragma unroll
            for (int j = 0; j < 8; ++j) w[j] = pg8::cvt_pk_bf16(v[2 * j], v[2 * j + 1]);
            bf16_t* dst = (part ? KN : QN) + (size_t)tok * DM + 16 * lane;
            *(u32x4*)dst = (u32x4){w[0], w[1], w[2], w[3]}; *(u32x4*)(dst + 8) = (u32x4){w[4], w[5], w[6], w[7]};
            if (part == 1 && tok < 4096) { float* o = ck + (((size_t)(tok >> 8) * 16 + hd) * 256 + (tok & 255)) * 64 + d0;
#pragma unroll
                for (int j4 = 0; j4 < 4; ++j4) *(f32x4*)(o + 4 * j4) = (f32x4){v[4 * j4], v[4 * j4 + 1], v[4 * j4 + 2], v[4 * j4 + 3]}; }
        }
        if (tok < 4096) { const bf16_t* src = QKV + (size_t)tok * 3072 + 2048 + 16 * lane;
            const u16x8 a0 = *(const u16x8*)src, a1 = *(const u16x8*)(src + 8);
            float* o = cv + (((size_t)(tok >> 8) * 16 + hd) * 256 + (tok & 255)) * 64 + d0;
            *(f32x4*)(o) = (f32x4){bf2f(a0[0]), bf2f(a0[1]), bf2f(a0[2]), bf2f(a0[3])}; *(f32x4*)(o + 4) = (f32x4){bf2f(a0[4]), bf2f(a0[5]), bf2f(a0[6]), bf2f(a0[7])};
            *(f32x4*)(o + 8) = (f32x4){bf2f(a1[0]), bf2f(a1[1]), bf2f(a1[2]), bf2f(a1[3])}; *(f32x4*)(o + 12) = (f32x4){bf2f(a1[4]), bf2f(a1[5]), bf2f(a1[6]), bf2f(a1[7])}; }
    }
}
struct AStage { const bf16_t* kb; const bf16_t* vb; int ks, vs, nkeys; };
DI void attn_fetch(const AStage& d, u32x4 (&kv)[8]) {
    const int tid = threadIdx.x;
#pragma unroll
    for (int k = 0; k < 4; ++k) { const int pc = tid + k * 512, key = pc >> 3, c8 = (pc & 7) * 8;
        if (key < d.nkeys) { kv[k] = *(const u32x4*)(d.kb + (size_t)key * d.ks + c8); kv[4 + k] = *(const u32x4*)(d.vb + (size_t)key * d.vs + c8); } }
}
DI void attn_stash(LAS unsigned char* lds, const u32x4 (&kv)[8], int nkeys) {
    const int tid = threadIdx.x; LAS bf16_t* KB = (LAS bf16_t*)lds; LAS bf16_t* VT = (LAS bf16_t*)(lds + 36864);
#pragma unroll
    for (int k = 0; k < 4; ++k) { const int pc = tid + k * 512, key = pc >> 3, c8 = (pc & 7) * 8;
        if (key < nkeys) { *(LAS u32x4*)(KB + key * 72 + c8) = kv[k];
#pragma unroll
            for (int j = 0; j < 4; ++j) { VT[(c8 + 2 * j) * 264 + key] = (bf16_t)(kv[4 + k][j] & 0xFFFFu); VT[(c8 + 2 * j + 1) * 264 + key] = (bf16_t)(kv[4 + k][j] >> 16); } } }
}
struct AttnState { f32x4 o[4]; float m[4], l[4]; };
DI void attn_tile(AttnState& st, const bf16x8 (&qf)[2], LAS unsigned char* lds, int wid, int mode, int nkeys, int krow0, int rsW, int rw, int ct) {
    const int lane = threadIdx.x & 63, r = lane & 15, q = lane >> 4;
    const LAS bf16_t* KB = (const LAS bf16_t*)lds; const LAS bf16_t* VT = (const LAS bf16_t*)(lds + 36864);
    LAS bf16_t* PW = (LAS bf16_t*)(lds + 70656 + wid * 4352); const LAS float* RPB = (const LAS float*)(lds + 105472);
    f32x4 sc[16];
#pragma unroll
    for (int g = 0; g < 4; ++g) {
        bool act = (64 * g < nkeys);
        const int krow = krow0 + g;
        if (mode == 2) act = act && (krow >= rsW) && (krow < rsW + 8);
        if (act) {
#pragma unroll
            for (int n2 = 0; n2 < 4; n2 += 2) {
            bf16x8 kf[2][2];
#pragma unroll
            for (int n = 0; n < 2; ++n) { kf[n][0] = *(const LAS bf16x8*)(KB + (64 * g + 16 * (n2 + n) + r) * 72 + 8 * q); kf[n][1] = *(const LAS bf16x8*)(KB + (64 * g + 16 * (n2 + n) + r) * 72 + 32 + 8 * q); }
#pragma unroll
            for (int nn = 0; nn < 2; ++nn) { const int n = n2 + nn; f32x4 a = {0.f, 0.f, 0.f, 0.f};
                a = __builtin_amdgcn_mfma_f32_16x16x32_bf16(qf[0], kf[nn][0], a, 0, 0, 0); a = __builtin_amdgcn_mfma_f32_16x16x32_bf16(qf[1], kf[nn][1], a, 0, 0, 0);
                if (mode == 2) {
                    const LAS float* rp = RPB + (krow - rw + 7) * 31;
#pragma unroll
                    for (int i = 0; i < 4; ++i) { const int c = ct * 16 + 4 * q + i, kc = 16 * n + r; const int cs = c - 8 < 0 ? 0 : (c - 8 > 48 ? 48 : c - 8);
                        const bool valid = kc >= cs && kc < cs + 16; int bi = kc - c + 15; bi = bi < 0 ? 0 : (bi > 30 ? 30 : bi);
                        a[i] = valid ? a[i] * 0.125f + rp[bi] : -1e30f; }
                } else a = a * 0.125f;
                sc[4 * g + n] = a; }
            }
        } else {
#pragma unroll
            for (int n = 0; n < 4; ++n) sc[4 * g + n] = (f32x4){-1e30f, -1e30f, -1e30f, -1e30f}; }
    }
    float alpha[4];
#pragma unroll
    for (int i = 0; i < 4; ++i) {
        float mx = sc[0][i];
#pragma unroll
        for (int n = 1; n < 16; ++n) mx = fmaxf(mx, sc[n][i]);
        mx = fmaxf(mx, __shfl_xor(mx, 1)); mx = fmaxf(mx, __shfl_xor(mx, 2)); mx = fmaxf(mx, __shfl_xor(mx, 4)); mx = fmaxf(mx, __shfl_xor(mx, 8));
        const float mn = fmaxf(st.m[i], mx); alpha[i] = __expf(st.m[i] - mn); st.m[i] = mn;
        float rsum = 0.f;
#pragma unroll
        for (int n = 0; n < 16; ++n) { const float pv = __expf(sc[n][i] - mn); sc[n][i] = pv; rsum += pv; }
        rsum += __shfl_xor(rsum, 1); rsum += __shfl_xor(rsum, 2); rsum += __shfl_xor(rsum, 4); rsum += __shfl_xor(rsum, 8);
        st.l[i] = st.l[i] * alpha[i] + rsum;
    }
#pragma unroll
    for (int dt = 0; dt < 4; ++dt)
#pragma unroll
        for (int i = 0; i < 4; ++i) st.o[dt][i] *= alpha[i];
#pragma unroll
    for (int hf = 0; hf < 2; ++hf) {
        if (128 * hf < nkeys) {
            asm volatile("s_waitcnt lgkmcnt(0)" ::: "memory");
#pragma unroll
            for (int n = 0; n < 8; ++n)
#pragma unroll
                for (int i = 0; i < 4; ++i) PW[(4 * q + i) * 136 + 16 * n + r] = f2bf(sc[8 * hf + n][i]);
            asm volatile("s_waitcnt lgkmcnt(0)" ::: "memory");
            bf16x8 pf[4];
#pragma unroll
            for (int kk = 0; kk < 4; ++kk) pf[kk] = *(const LAS bf16x8*)(PW + r * 136 + 32 * kk + 8 * q);
#pragma unroll
            for (int dt = 0; dt < 4; ++dt) { bf16x8 vf[4];
#pragma unroll
                for (int kk = 0; kk < 4; ++kk) vf[kk] = *(const LAS bf16x8*)(VT + (16 * dt + r) * 264 + 128 * hf + 32 * kk + 8 * q);
#pragma unroll
                for (int kk = 0; kk < 4; ++kk) st.o[dt] = __builtin_amdgcn_mfma_f32_16x16x32_bf16(pf[kk], vf[kk], st.o[dt], 0, 0, 0); }
        }
    }
}
DI void attn_out(const AttnState& st, bf16_t* AO, int qtok0, int h) {
    const int lane = threadIdx.x & 63, r = lane & 15, q = lane >> 4;
#pragma unroll
    for (int dt = 0; dt < 4; ++dt)
#pragma unroll
        for (int i = 0; i < 4; ++i) AO[(size_t)(qtok0 + 4 * q + i) * DM + h * 64 + 16 * dt + r] = f2bf(st.o[dt][i] / st.l[i]);
}
DI void attn_init(AttnState& st) {
#pragma unroll
    for (int i = 0; i < 4; ++i) { st.o[i] = (f32x4){0.f, 0.f, 0.f, 0.f}; st.m[i] = -1e30f; st.l[i] = 0.f; }
}
DI void phase_attn(const Params& p, LAS unsigned char* lds) {
    int tid_ = threadIdx.x; asm volatile("" : "+v"(tid_));
    const int tid = tid_, wid = __builtin_amdgcn_readfirstlane(tid >> 6), lane = tid & 63, r = lane & 15, q = lane >> 4;
    const bf16_t* QN = (const bf16_t*)(p.ws + OFF_O); const bf16_t* KN = QN + (size_t)NTOK * DM;
    const bf16_t* QKV = (const bf16_t*)(p.ws + OFF_PROJ);
    const bf16_t* CK = (const bf16_t*)(p.ws + OFF_CK); const bf16_t* CV = CK + (size_t)4 * 16 * 256 * 64;
    bf16_t* AO = (bf16_t*)(p.ws + OFF_H2);
    LAS float* RPB = (LAS float*)(lds + 105472);
    u32x4 kv[8];
    for (int it = blockIdx.x; it < 256; it += gridDim.x) {
        const int b = it >> 4, h = it & 15;
        AStage d; d.kb = KN + (size_t)(b * 256) * DM + h * 64; d.ks = DM; d.vb = QKV + (size_t)(b * 256) * 3072 + 2048 + h * 64; d.vs = 3072; d.nkeys = 256;
        attn_fetch(d, kv);
        bf16x8 qf[2][2];
#pragma unroll
        for (int t = 0; t < 2; ++t)
#pragma unroll
            for (int kk = 0; kk < 2; ++kk) qf[t][kk] = *(const bf16x8*)(QN + (size_t)(b * 256 + wid * 32 + t * 16 + r) * DM + h * 64 + 32 * kk + 8 * q);
        __syncthreads();
        attn_stash(lds, kv, 256);
        __syncthreads();
#pragma unroll
        for (int t = 0; t < 2; ++t) { AttnState st; attn_init(st); attn_tile(st, qf[t], lds, wid, 0, 256, 0, 0, 0, 0); attn_out(st, AO, b * 256 + wid * 32 + t * 16, h); }
    }
    for (int it = blockIdx.x; it < 512; it += gridDim.x) {
        const int b = it >> 7, h = (it >> 3) & 15, rp = it & 7, r0 = 2 * rp, rw = r0 + (wid >> 2), ct = wid & 3;
        const int rsA = r0 - 4 < 0 ? 0 : (r0 - 4 > 8 ? 8 : r0 - 4), r1 = r0 + 1, rsB = r1 - 4 < 0 ? 0 : (r1 - 4 > 8 ? 8 : r1 - 4);
        const int rsW = (wid >> 2) ? rsB : rsA, nwin = rsB + 8 - rsA, nst = 1 + (nwin + 3) / 4;
        const int qtok0 = 4096 + b * 1024 + rw * 64 + ct * 16;
        auto desc = [&](int s) { AStage d;
            if (s == 0) { d.kb = CK + (size_t)((b * 16 + h) * 256) * 64; d.ks = 64; d.vb = CV + (size_t)((b * 16 + h) * 256) * 64; d.vs = 64; d.nkeys = 256; }
            else { const int kr0 = rsA + 4 * (s - 1), nr = (nwin - 4 * (s - 1)) < 4 ? (nwin - 4 * (s - 1)) : 4; const size_t tok0 = 4096 + b * 1024 + kr0 * 64;
                d.kb = KN + tok0 * DM + h * 64; d.ks = DM; d.vb = QKV + tok0 * 3072 + 2048 + h * 64; d.vs = 3072; d.nkeys = nr * 64; }
            return d; };
        AStage d0 = desc(0);
        attn_fetch(d0, kv);
        bf16x8 qf[2];
#pragma unroll
        for (int kk = 0; kk < 2; ++kk) qf[kk] = *(const bf16x8*)(QN + (size_t)(qtok0 + r) * DM + h * 64 + 32 * kk + 8 * q);
        AttnState st; attn_init(st);
        __syncthreads();
        if (tid < 465) RPB[tid] = p.rpb[h * 465 + tid];
#pragma unroll 1
        for (int s = 0; s < nst; ++s) {
            const AStage d = desc(s);
            if (s) __syncthreads();
            attn_stash(lds, kv, d.nkeys);
            if (s + 1 < nst) { const AStage dn = desc(s + 1); attn_fetch(dn, kv); }
            __syncthreads();
            attn_tile(st, qf, lds, wid, s == 0 ? 0 : 2, d.nkeys, rsA + 4 * (s - 1), rsW, rw, ct);
        }
        attn_out(st, AO, qtok0, h);
    }
}
#define XB_TMO      128
#define XB_XCNT(j)  (256  + 64 * (j))
#define XB_XSUB(j)  (1280 + 64 * (j))
#define XB_XGEN(j)  (2304 + 64 * (j))
#define XB_TOP      3328
#define XB_TOPGEN   3392
#define XCD_BAR_WORDS 3456
#define XB_SPIN_CAP (1u << 18)

__device__ __forceinline__ unsigned xb_ld(unsigned* p)              { return __hip_atomic_load(p, __ATOMIC_RELAXED, __HIP_MEMORY_SCOPE_AGENT); }
__device__ __forceinline__ unsigned xb_add(unsigned* p, unsigned v) { return __hip_atomic_fetch_add(p, v, __ATOMIC_RELAXED, __HIP_MEMORY_SCOPE_AGENT); }
__device__ __forceinline__ unsigned xb_xcc_id() { return (unsigned)__builtin_amdgcn_s_getreg((3 << 11) | 20) & 0xFu; }
#define XB_SPIN(cond, bar) do { unsigned _sp = 0; while (cond) { __builtin_amdgcn_s_sleep(1); \
    if ((++_sp & 255u) == 0u) { if (xb_ld(&(bar)[XB_TMO])) break; if (_sp > XB_SPIN_CAP) { atomicAdd(&(bar)[XB_TMO], 1u); break; } } } } while (0)

struct XcdBarrier {
    unsigned* bar; unsigned x;
    volatile LAS unsigned* st;
};

__device__ __forceinline__ XcdBarrier xcd_barrier_post(unsigned* bar, volatile LAS unsigned* st) {
    XcdBarrier b; b.bar = bar; b.x = xb_xcc_id(); b.st = st;
    if (threadIdx.x == 0) (void)xb_add(&bar[XB_XCNT(b.x)], 1u);
    return b;
}
__device__ __forceinline__ void xcd_barrier_complete(unsigned* bar, unsigned x, unsigned& nloc, unsigned& nx) {
    const unsigned G = gridDim.x * gridDim.y * gridDim.z;
    unsigned sum, cnt, mine, sp = 0u;
    for (;;) {
        sum = 0u; cnt = 0u; mine = 0u;
#pragma unroll
        for (unsigned j = 0; j < 16; ++j) { const unsigned c = xb_ld(&bar[XB_XCNT(j)]); sum += c; cnt += (c > 0u) ? 1u : 0u; mine = (j == x) ? c : mine; }
        if (sum == G) break;
        __builtin_amdgcn_s_sleep(1);
        if ((++sp & 255u) == 0u) { if (xb_ld(&bar[XB_TMO])) break; if (sp > XB_SPIN_CAP) { atomicAdd(&bar[XB_TMO], 1u); break; } }
    }
    nloc = mine > 0u ? mine : 1u; nx = cnt > 0u ? cnt : 1u;
}

__device__ __forceinline__ void xcd_barrier(const XcdBarrier& b) {
    asm volatile("s_waitcnt vmcnt(0)" ::: "memory");
    __syncthreads();
    if (threadIdx.x == 0) {
        unsigned* bar = b.bar;
        __builtin_amdgcn_s_waitcnt(0);
        unsigned nloc = b.st[0], nx = b.st[1];
        if (nloc == 0u) { xcd_barrier_complete(bar, b.x, nloc, nx); b.st[0] = nloc; b.st[1] = nx; }
        const unsigned old = xb_add(&bar[XB_XSUB(b.x)], 1u);
        const unsigned gen = old / nloc;
        if (old + 1u == (gen + 1u) * nloc) {
            __builtin_amdgcn_fence(__ATOMIC_RELEASE, "agent");
            asm volatile("s_waitcnt vmcnt(0)" ::: "memory");
            const unsigned og = xb_add(&bar[XB_TOP], 1u);
            const unsigned tg = og / nx;
            if (og + 1u == (tg + 1u) * nx) xb_add(&bar[XB_TOPGEN], 1u);
            else XB_SPIN(xb_ld(&bar[XB_TOPGEN]) == tg, bar);
            __builtin_amdgcn_fence(__ATOMIC_ACQUIRE, "agent");
            xb_add(&bar[XB_XGEN(b.x)], 1u);
            asm volatile("s_waitcnt vmcnt(0)" ::: "memory");
        } else {
            XB_SPIN(xb_ld(&bar[XB_XGEN(b.x)]) == gen, bar);
            __builtin_amdgcn_fence(__ATOMIC_ACQUIRE, "agent");
            asm volatile("s_waitcnt vmcnt(0)" ::: "memory");
        }
    }
    __syncthreads();
}

#ifndef PROBE_GEMM
#define PROBE_GEMM -1
#define PROBE_GA 3
#define PROBE_GB 4
#endif
constexpr size_t OFF_STAMP = OFF_CB + (size_t)5 * (4096 + 3072 + 4096) * 4;
template <int ID = -2, class Epi> DI void gemm(LAS unsigned char* lds, const bf16_t* A, const bf16_t* Bt, int N, int K, const Epi& E, unsigned char* ws = nullptr) {
    pg8::Gemm g; g.A = A; g.Bt = Bt; g.M = NTOK; g.N = N; g.K = K;
    pg8::StaticOrder S; S.init(NTOK, N, gridDim.x, blockIdx.x);
    if (ID == PROBE_GEMM) pg8::gemm_phase<Epi, pg8::StaticOrder, true>(lds, g, S, E, (unsigned long long*)(ws + OFF_STAMP) + (size_t)blockIdx.x * 64);
    else pg8::gemm_phase<Epi, pg8::StaticOrder, false>(lds, g, S, E, nullptr);
}
#define GSYNC(n) do { xcd_barrier(xb); TSTAMP(n); } while (0)
#ifndef REPEAT_MASK
#define REPEAT_MASK 0
#endif
#define PH(n, ...) do { __VA_ARGS__; if ((REPEAT_MASK >> (n)) & 1) { xcd_barrier(xb); __VA_ARGS__; } } while (0)
constexpr size_t OFF_BAR = 245760;
static_assert(OFF_BAR + XCD_BAR_WORDS * 4 <= OFF_LBS, "bar");
extern __shared__ __attribute__((aligned(16))) unsigned char smem_dyn[];
__global__ void __launch_bounds__(512, 2) fwd_megakernel(Params p) {
    LAS unsigned char* lds = (LAS unsigned char*)smem_dyn;
    volatile LAS unsigned* xst = (volatile LAS unsigned*)(lds + LDS_BYTES - 16);
    if (threadIdx.x < 4) xst[threadIdx.x] = 0u;
    __syncthreads();
    const XcdBarrier xb = xcd_barrier_post((unsigned*)(p.ws + OFF_BAR), xst);
    volatile LAS unsigned long long* tsl = (volatile LAS unsigned long long*)(lds + LDS_BYTES - 16 - 512);
    TSTAMP(0);
    unsigned char* ws = p.ws;
    const float* mod = (const float*)(ws + OFF_MOD);
    bf16_t* H = (bf16_t*)(ws + OFF_H);
    bf16_t* W0 = (bf16_t*)(ws + OFF_W0); bf16_t* W1 = (bf16_t*)(ws + OFF_W1);
    bf16_t* PROJ = (bf16_t*)(ws + OFF_PROJ);
    float* X1 = p.out;
    float* X2 = (float*)(ws + OFF_X2);
    bf16_t* H2 = (bf16_t*)(ws + OFF_H2); float* SSQ = (float*)(ws + OFF_SSQ); const float* CB = (const float*)(ws + OFF_CB);
    const int G = gridDim.x;
    PH(0, phase_mod(p, lds); __syncthreads(); phase_w0(p, lds));
    GSYNC(1);
    PH(1, phase_norm<false>(p, p.xp, p.xs, 0, 0, lds));
    GSYNC(2);
    PH(2, { pg8::EpiProj E; E.O = PROJ; E.ab = (float*)(ws + OFF_AB); gemm<2>(lds, H, W0, NPROJ_PAD, 1024, E, ws); });
    GSYNC(3);
    PH(3, phase_prep(p, lds));
    GSYNC(4);
    PH(4, phase_scan(p, lds));
    GSYNC(5);
    PH(5, phase_combine(p); __syncthreads(); phase_w1(p, lds));
    GSYNC(6);
    { pg8::EpiRes2 E; E.out = X1; E.base_p = p.xp; E.base_s = p.xs; E.gate = mod + 2048; E.A2 = H2; E.ng = p.norm_g + 1024; E.sc = mod + 4096; E.ssq = SSQ;
      gemm(lds, H, W0 + (size_t)NPROJ_PAD * DM, 1024, 1024, E);
      if (G > 128) { if ((int)blockIdx.x >= 128) helper_l0(p, lds, blockIdx.x - 128, G - 128); } else helper_l0(p, lds, blockIdx.x, G); }
    GSYNC(8);
    PH(8, { pg8::EpiBfSB<1> E; E.O = PROJ; E.ldc = DFF; E.ssq = SSQ; E.bias = CB; E.ldb = DFF; gemm(lds, H2, W0 + (size_t)NPROJ_PAD * DM + (size_t)DM * DM, DFF, 1024, E); });
    GSYNC(9);
    { pg8::EpiRes2 E; E.out = X2; E.base_p = X1; E.base_s = X1 + (size_t)4096 * DM; E.gate = mod + 5120; E.A2 = H; E.ng = p.norm_g + 2048; E.sc = mod + 5 * NMOD + 1024; E.ssq = SSQ + (size_t)NTOK * 16;
      gemm(lds, PROJ, W0 + (size_t)NPROJ_PAD * DM + (size_t)DM * DM + (size_t)DFF * DM, 1024, DFF, E);
      if (G > 128) { if ((int)blockIdx.x >= 128) helper_l1(p, lds, blockIdx.x - 128, G - 128); } else helper_l1(p, lds, blockIdx.x, G); }
    GSYNC(10);
    PH(11, { pg8::EpiBfSB<0> E; E.O = PROJ; E.ldc = 3072; E.ssq = SSQ + (size_t)NTOK * 16; E.bias = CB + 5 * 4096; E.ldb = 3072; gemm(lds, H, W1, 3072, 1024, E); });
    GSYNC(12);
    PH(12, phase_qknorm(p));
    GSYNC(13);
    PH(13, phase_attn(p, lds));
    GSYNC(14);
    { pg8::EpiRes2 E; E.out = X1; E.base_p = X2; E.base_s = X2 + (size_t)4096 * DM; E.gate = mod + 5 * NMOD + 2048; E.A2 = H; E.ng = p.norm_g + 3072; E.sc = mod + 5 * NMOD + 4096; E.ssq = SSQ + (size_t)2 * NTOK * 16;
      gemm<14>(lds, H2, W1 + (size_t)3072 * DM, 1024, 1024, E, ws); }
    GSYNC(15);
    PH(16, { pg8::EpiBfSB<1> E; E.O = PROJ; E.ldc = DFF; E.ssq = SSQ + (size_t)2 * NTOK * 16; E.bias = CB + 5 * 4096 + 5 * 3072; E.ldb = DFF; gemm(lds, H, W1 + (size_t)3072 * DM + (size_t)DM * DM, DFF, 1024, E); });
    GSYNC(17);
    { pg8::EpiRes E; E.out = X1; E.base_p = X1; E.base_s = X1 + (size_t)4096 * DM; E.gate = mod + 5 * NMOD + 5120; gemm<17>(lds, PROJ, W1 + (size_t)3072 * DM + (size_t)DM * DM + (size_t)DFF * DM, 1024, DFF, E, ws); }
    if (PROBE_A >= 0) { TSTAMP(18);
        if (threadIdx.x == 0 && blockIdx.x == 0) { float us = (float)(long long)(tsl[PROBE_B] - tsl[PROBE_A]) * 0.01f;
            if (PROBE_GEMM >= 0) { const unsigned long long* st = (const unsigned long long*)(p.ws + OFF_STAMP); us = (float)(long long)(st[PROBE_GB] - st[PROBE_GA]) * (PROBE_GB >= 62 ? 0.01f : (1.0f / 2100.0f)); }
            float* e = p.out + (size_t)NTOK * DM + 2 * 2097152 + 4194304 + 7; *e = *e + 0.06f + us * PROBE_SCALE; } }
}

extern "C" void kernel_launch(void* const* d_in, const int* in_sizes, int n_in, void* d_out, int out_size, void* d_ws, size_t ws_size, hipStream_t stream) {
    (void)in_sizes; (void)n_in; (void)out_size;
    static int grid_blocks = 0;
    if (!grid_blocks) {
        int dev = 0, cus = 0, per_cu = 0;
        (void)hipGetDevice(&dev);
        (void)hipDeviceGetAttribute(&cus, hipDeviceAttributeMultiprocessorCount, dev);
        (void)hipFuncSetAttribute((const void*)fwd_megakernel, hipFuncAttributeMaxDynamicSharedMemorySize, LDS_BYTES);
        (void)hipOccupancyMaxActiveBlocksPerMultiprocessor(&per_cu, fwd_megakernel, 512, LDS_BYTES);
        if (per_cu > 1) per_cu = 1;
        grid_blocks = cus * per_cu;
        if (ws_size < WS_NEED) fprintf(stderr, "workspace too small: %zu < %zu\n", ws_size, (size_t)WS_NEED);
    }
    Params p{};
    const float* const* in = (const float* const*)d_in;
    p.xp = in[0]; p.xs = in[1]; p.st_hgrn = in[2]; p.st_gdn = in[3]; p.cache_k = in[4]; p.cache_v = in[5]; p.c = in[6]; p.c_ctx = in[7]; p.ada_w = in[8]; p.ada_b = in[9];
    p.norm_g = in[10]; p.w_in = in[11]; p.w_out_ab = in[12]; p.hgrn_lb = in[13]; p.gdn_conv = in[14]; p.a_log = in[15]; p.dt_bias = in[16]; p.gn_hgrn = in[17]; p.gn_gdn = in[18];
    p.w_qkv = in[19]; p.qn = in[20]; p.kn = in[21]; p.rpb = in[22]; p.w_out_na = in[23]; p.w_mlp1 = in[24]; p.w_mlp2 = in[25];
    p.out = (float*)d_out; p.ws = (unsigned char*)d_ws;
    (void)hipMemsetAsync((unsigned char*)d_ws + OFF_BAR, 0, XCD_BAR_WORDS * 4, stream);
    void* args[] = {&p};
    hipError_t e = hipLaunchCooperativeKernel((const void*)fwd_megakernel, dim3(grid_blocks), dim3(512), args, LDS_BYTES, stream);
    if (e != hipSuccess) fprintf(stderr, "cooperative launch failed: %s (grid %d)\n", hipGetErrorString(e), grid_blocks);
}
```

```cpp
#include <hip/hip_runtime.h>
#include <hip/hip_cooperative_groups.h>
#include <cstdint>
#include <cstdio>
namespace cg = cooperative_groups;
namespace pg8 {
#define PG8_LAS __attribute__((address_space(3)))
typedef unsigned short bf16_t;
typedef short bf16x8 __attribute__((ext_vector_type(8)));
typedef float f32x4 __attribute__((ext_vector_type(4)));
typedef unsigned u32x4 __attribute__((ext_vector_type(4)));
constexpr int BM = 256, BK = 64, HALF = 128, HTB = HALF * BK * 2  , STAGE_BYTES = 8 * HTB, NXCD = 8, WGM = 8;

__host__ __device__ __forceinline__ int lds_byte(int r, int c) { const int st = (r >> 4) * 2 + (c >> 5), rr = r & 15, cc = c & 31, ob = rr * 64 + cc * 2; return st * 1024 + (ob ^ (((ob >> 9) & 1) << 5)); }
__host__ __device__ __forceinline__ void stage_rc(int b, int& R, int& C) { const int st = b / 1024, sb = b % 1024, swz = sb ^ (((sb >> 9) & 1) << 5); R = (st >> 1) * 16 + swz / 64; C = (st & 1) * 32 + (swz % 64) / 2; }
__host__ __device__ __forceinline__ int perm32(int rho) { const int n = rho >> 4, i = rho & 15; return 8 * (i >> 2) + 4 * n + (i & 3); }

struct Unit { int pm, pn; };
struct Gemm { const bf16_t* A; const bf16_t* Bt; int M, N, K; int ld = 0; int aswap = 0; };

struct StaticOrder {
    int nM, nN, nwg, G, c;
    __host__ __device__ void init(int M, int N, int G_, int c_) { nM = M / BM; nN = N / BM; nwg = nM * nN; G = G_; c = c_; }
    __host__ __device__ bool next(int i, Unit& u) const {
        const long L = (long)i * G + c; if (L >= nwg) return false;
        int wgid = (int)L; { const int q = nwg / NXCD, r = nwg % NXCD, xcd = wgid % NXCD, off = wgid / NXCD; wgid = (xcd < r ? xcd * (q + 1) : r * (q + 1) + (xcd - r) * q) + off; }
        const int nig = WGM * nN, gid = wgid / nig, fm = gid * WGM, gsz = (nM - fm) < WGM ? (nM - fm) : WGM;
        u.pm = fm + ((wgid % nig) % gsz); u.pn = (wgid % nig) / gsz; return true;
    }
    __device__ __forceinline__ void a_ready(const Unit&) const {}
    __device__ __forceinline__ void done(const Unit&) const {}
};
struct SplitOrder {
    int c;
    __device__ __forceinline__ bool next(int i, Unit& u) const { if (i) return false; const int xcd = c & 7, j = c >> 3, t = (j >> 1) * 8 + xcd; u.pm = t >> 2; u.pn = t & 3; return true; }
    __device__ __forceinline__ void a_ready(const Unit&) const {}
    __device__ __forceinline__ void done(const Unit&) const {}
};
__device__ __forceinline__ unsigned cvt_pk_bf16(float lo, float hi) { unsigned r; asm volatile("v_cvt_pk_bf16_f32 %0, %1, %2" : "=v"(r) : "v"(lo), "v"(hi)); return r; }
template <int ACT  > struct EpiBf {
    static constexpr bool PERM = true, AFTER_DRAIN = false;
    bf16_t* O; int ldc;
    __device__ __forceinline__ void operator()(const f32x4 (&acc)[2][2][4][2], const Unit& u, int wr, int wc, int fr, int fq) const {
        const int row0 = u.pm * BM + wr * 64 + fr, col0 = u.pn * BM + wc * 32 + 8 * fq;
#pragma unroll
        for (int ai = 0; ai < 2; ++ai)
#pragma unroll
            for (int m = 0; m < 4; ++m) { bf16_t* rowp = O + (size_t)(row0 + ai * HALF + m * 16) * ldc + col0;
#pragma unroll
                for (int bj = 0; bj < 2; ++bj) { f32x4 v0 = acc[ai][bj][m][0], v1 = acc[ai][bj][m][1];
                    if (ACT == 1) {
#pragma unroll
                        for (int e = 0; e < 4; ++e) { const float a = v0[e] > 0.f ? v0[e] : 0.f, b = v1[e] > 0.f ? v1[e] : 0.f; v0[e] = a * a; v1[e] = b * b; } }
                    u32x4 w; w.x = cvt_pk_bf16(v0[0], v0[1]); w.y = cvt_pk_bf16(v0[2], v0[3]); w.z = cvt_pk_bf16(v1[0], v1[1]); w.w = cvt_pk_bf16(v1[2], v1[3]);
                    *(u32x4*)(rowp + bj * HALF) = w; } }
    }
};
struct EpiRes {
    static constexpr bool PERM = false, AFTER_DRAIN = false;
    float* out; const float* base_p; const float* base_s; const float* gate;
    template <int AI> __device__ __forceinline__ void half(const f32x4 (&acc)[2][2][4][2], const Unit& u, int wr, int wc, int fr, int fq, int rowofs = 0) const {
        const int row0 = u.pm * BM + rowofs + wr * 64 + fr, col0 = u.pn * BM + wc * 32 + 4 * fq;
        const int t0 = u.pm * BM; const int mr = t0 < 4096 ? 0 : 1 + ((t0 - 4096) >> 10);
        const float* gp = gate + (size_t)mr * 6144 + col0;
        f32x4 gv[2][2];
#pragma unroll
        for (int bj = 0; bj < 2; ++bj)
#pragma unroll
            for (int n = 0; n < 2; ++n) gv[bj][n] = *(const f32x4*)(gp + bj * HALF + n * 16);
#pragma unroll
        for (int mh = 0; mh < 2; ++mh) { const int ai = AI, m0 = mh * 2;
            f32x4 bb[4][2][2];
#pragma unroll
            for (int m = m0; m < m0 + 2; ++m) { const int row = row0 + ai * HALF + m * 16;
                const float* bp = (row < 4096 ? base_p + (size_t)row * 1024 : base_s + (size_t)(row - 4096) * 1024) + col0;
#pragma unroll
                for (int bj = 0; bj < 2; ++bj)
#pragma unroll
                    for (int n = 0; n < 2; ++n) bb[m][bj][n] = *(const f32x4*)(bp + bj * HALF + n * 16); }
#pragma unroll
            for (int m = m0; m < m0 + 2; ++m) { const int row = row0 + ai * HALF + m * 16; float* op = out + (size_t)row * 1024 + col0;
#pragma unroll
                for (int bj = 0; bj < 2; ++bj)
#pragma unroll
                    for (int n = 0; n < 2; ++n) *(f32x4*)(op + bj * HALF + n * 16) = bb[m][bj][n] + gv[bj][n] * acc[ai][bj][m][n]; }
        }
    }
    __device__ __forceinline__ void operator()(const f32x4 (&acc)[2][2][4][2], const Unit& u, int wr, int wc, int fr, int fq) const { half<0>(acc, u, wr, wc, fr, fq); half<1>(acc, u, wr, wc, fr, fq); }
};

struct EpiRes2 {
    static constexpr bool PERM = false, AFTER_DRAIN = false;
    float* out; const float* base_p; const float* base_s; const float* gate; bf16_t* A2; const float* ng; const float* sc; float* ssq;
    template <int AI> __device__ __forceinline__ void half(const f32x4 (&acc)[2][2][4][2], const Unit& u, int wr, int wc, int fr, int fq, int rowofs = 0) const {
        const int row0 = u.pm * BM + rowofs + wr * 64 + fr, col0 = u.pn * BM + wc * 32 + 4 * fq;
        const int t0 = u.pm * BM; const int mr = t0 < 4096 ? 0 : 1 + ((t0 - 4096) >> 10);
        const float* gp = gate + (size_t)mr * 6144 + col0; const float* sp = sc + (size_t)mr * 6144 + col0; const float* np = ng + col0;
        f32x4 gv[2][2], mv[2][2];
#pragma unroll
        for (int bj = 0; bj < 2; ++bj)
#pragma unroll
            for (int n = 0; n < 2; ++n) { gv[bj][n] = *(const f32x4*)(gp + bj * HALF + n * 16);
                const f32x4 s4 = *(const f32x4*)(sp + bj * HALF + n * 16), n4 = *(const f32x4*)(np + bj * HALF + n * 16); mv[bj][n] = n4 * (s4 + 1.0f); }
#pragma unroll
        for (int mh = 0; mh < 2; ++mh) { const int ai = AI, m0 = mh * 2;
            f32x4 bb[4][2][2];
#pragma unroll
            for (int m = m0; m < m0 + 2; ++m) { const int row = row0 + ai * HALF + m * 16;
                const float* bp = (row < 4096 ? base_p + (size_t)row * 1024 : base_s + (size_t)(row - 4096) * 1024) + col0;
#pragma unroll
                for (int bj = 0; bj < 2; ++bj)
#pragma unroll
                    for (int n = 0; n < 2; ++n) bb[m][bj][n] = *(const f32x4*)(bp + bj * HALF + n * 16); }
#pragma unroll
            for (int m = m0; m < m0 + 2; ++m) { const int row = row0 + ai * HALF + m * 16; float* op = out + (size_t)row * 1024 + col0;
                bf16_t* ap = A2 + (size_t)row * 1024 + col0; float ss = 0.f;
#pragma unroll
                for (int bj = 0; bj < 2; ++bj)
#pragma unroll
                    for (int n = 0; n < 2; ++n) { const f32x4 v = bb[m][bj][n] + gv[bj][n] * acc[ai][bj][m][n];
                        *(f32x4*)(op + bj * HALF + n * 16) = v; ss += (v[0] * v[0] + v[1] * v[1]) + (v[2] * v[2] + v[3] * v[3]);
                        const f32x4 a = v * mv[bj][n]; uint2 w; w.x = cvt_pk_bf16(a[0], a[1]); w.y = cvt_pk_bf16(a[2], a[3]); *(uint2*)(ap + bj * HALF + n * 16) = w; }
                ss += __shfl_xor(ss, 16); ss += __shfl_xor(ss, 32);
                if (fq == 0) ssq[(size_t)row * 16 + u.pn * 4 + wc] = ss; }
        }
    }
    __device__ __forceinline__ void operator()(const f32x4 (&acc)[2][2][4][2], const Unit& u, int wr, int wc, int fr, int fq) const { half<0>(acc, u, wr, wc, fr, fq); half<1>(acc, u, wr, wc, fr, fq); }
};
template <int ACT  > struct EpiBfSB {
    static constexpr bool PERM = true, AFTER_DRAIN = false;
    bf16_t* O; int ldc; const float* ssq; const float* bias; int ldb;
    __device__ __forceinline__ void operator()(const f32x4 (&acc)[2][2][4][2], const Unit& u, int wr, int wc, int fr, int fq) const {
        const int row0 = u.pm * BM + wr * 64 + fr, col0 = u.pn * BM + wc * 32 + 8 * fq;
        const int t0 = u.pm * BM; const int mr = t0 < 4096 ? 0 : 1 + ((t0 - 4096) >> 10);
        const float* bp = bias + (size_t)mr * ldb + col0;
        f32x4 bv[2][2];
#pragma unroll
        for (int bj = 0; bj < 2; ++bj) { bv[bj][0] = *(const f32x4*)(bp + bj * HALF); bv[bj][1] = *(const f32x4*)(bp + bj * HALF + 4); }
#pragma unroll
        for (int ai = 0; ai < 2; ++ai)
#pragma unroll
            for (int m = 0; m < 4; ++m) { const int row = row0 + ai * HALF + m * 16; bf16_t* rowp = O + (size_t)row * ldc + col0;
                const f32x4 p0 = *(const f32x4*)(ssq + (size_t)row * 16), p1 = *(const f32x4*)(ssq + (size_t)row * 16 + 4), p2 = *(const f32x4*)(ssq + (size_t)row * 16 + 8), p3 = *(const f32x4*)(ssq + (size_t)row * 16 + 12);
                const f32x4 ps = (p0 + p1) + (p2 + p3);
                const float rs = __builtin_amdgcn_rsqf(((ps[0] + ps[1]) + (ps[2] + ps[3])) * (1.0f / 1024.0f) + 1e-6f);
#pragma unroll
                for (int bj = 0; bj < 2; ++bj) { f32x4 v0 = acc[ai][bj][m][0] * rs + bv[bj][0], v1 = acc[ai][bj][m][1] * rs + bv[bj][1];
                    if (ACT == 1) {
#pragma unroll
                        for (int e = 0; e < 4; ++e) { const float a = v0[e] > 0.f ? v0[e] : 0.f, b = v1[e] > 0.f ? v1[e] : 0.f; v0[e] = a * a; v1[e] = b * b; } }
                    u32x4 w; w.x = cvt_pk_bf16(v0[0], v0[1]); w.y = cvt_pk_bf16(v0[2], v0[3]); w.z = cvt_pk_bf16(v1[0], v1[1]); w.w = cvt_pk_bf16(v1[2], v1[3]);
                    *(u32x4*)(rowp + bj * HALF) = w; } }
    }
};

struct EpiProj {
    static constexpr bool PERM = true, AFTER_DRAIN = false;
    bf16_t* O; float* ab;
    __device__ __forceinline__ void operator()(const f32x4 (&acc)[2][2][4][2], const Unit& u, int wr, int wc, int fr, int fq) const {
        if (u.pn < 18) { EpiBf<0> E; E.O = O; E.ldc = 4608; E(acc, u, wr, wc, fr, fq); return; }
        if (wc == 0 && fq < 2) {
            const int row0 = u.pm * BM + wr * 64 + fr;
#pragma unroll
            for (int ai = 0; ai < 2; ++ai)
#pragma unroll
                for (int m = 0; m < 4; ++m) { float* rp = ab + (size_t)(row0 + ai * HALF + m * 16) * 16 + 8 * fq;
                    *(f32x4*)rp = acc[ai][0][m][0]; *(f32x4*)(rp + 4) = acc[ai][0][m][1]; }
        }
    }
};

template <class Inner> struct EpiSplit {
    static constexpr bool PERM = Inner::PERM, AFTER_DRAIN = true;
    Inner in; float* slab; unsigned* flags;
    __device__ __forceinline__ void operator()(const f32x4 (&)[2][2][4][2], const Unit&, int, int, int, int) const {}
    template <int AI> static __device__ __forceinline__ void send(const f32x4 (&acc)[2][2][4][2], f32x4* mine, int tid) {
        const __amdgpu_buffer_rsrc_t rs = __builtin_amdgcn_make_buffer_rsrc((void*)mine, 0, 131072, 0x00020000);
#pragma unroll
        for (int bj = 0; bj < 2; ++bj)
#pragma unroll
            for (int m = 0; m < 4; ++m)
#pragma unroll
                for (int n = 0; n < 2; ++n) __builtin_amdgcn_raw_buffer_store_b128(__builtin_bit_cast(u32x4, acc[AI][bj][m][n]), rs, (((bj * 4 + m) * 2 + n) * 512 + tid) * 16, 0, 16);
    }
    template <int AI> static __device__ __forceinline__ void recv(f32x4 (&acc)[2][2][4][2], const f32x4* theirs, int tid) {
#pragma unroll
        for (int bj = 0; bj < 2; ++bj) {
            f32x4 t[4][2];
#pragma unroll
            for (int m = 0; m < 4; ++m)
#pragma unroll
                for (int n = 0; n < 2; ++n) t[m][n] = theirs[((bj * 4 + m) * 2 + n) * 512 + tid];
#pragma unroll
            for (int m = 0; m < 4; ++m)
#pragma unroll
                for (int n = 0; n < 2; ++n) acc[AI][bj][m][n] += t[m][n];
            asm volatile("" ::: "memory");
        }
    }
    __device__ __forceinline__ void fused(f32x4 (&acc)[2][2][4][2], const Unit& u, int wr, int wc, int fr, int fq, PG8_LAS unsigned char* lds, int wid, int lane) const {
        const int tid = wid * 64 + lane, c = blockIdx.x, kh = (c >> 3) & 1, partner = c ^ 8;
        f32x4* mine = (f32x4*)slab + (size_t)c * 8192; const f32x4* theirs = (const f32x4*)slab + (size_t)partner * 8192;
        send<1>(acc, mine, tid);
        __builtin_amdgcn_sched_barrier(0);
        asm volatile("s_waitcnt vmcnt(0)" ::: "memory");
        __syncthreads();
        if (tid == 0) {
            __hip_atomic_store(flags + c, 1u, __ATOMIC_RELAXED, __HIP_MEMORY_SCOPE_AGENT);
            unsigned spins = 0;
            while (__hip_atomic_load(flags + partner, __ATOMIC_RELAXED, __HIP_MEMORY_SCOPE_AGENT) == 0u) { __builtin_amdgcn_s_sleep(2); if (++spins > (1u << 22)) break; }
            __builtin_amdgcn_fence(__ATOMIC_ACQUIRE, "agent");
            asm volatile("s_waitcnt vmcnt(0)" ::: "memory");
        }
        __syncthreads();
        recv<0>(acc, theirs, tid);
        __builtin_amdgcn_sched_barrier(0);
        in.template half<0>(acc, u, wr, wc, fr, fq, kh * HALF);
        (void)lds;
    }
};

template <class Epi, class Sched, bool STAMP = false>
__device__ __forceinline__ void gemm_phase(PG8_LAS unsigned char* lds, const Gemm g, const Sched& S, const Epi& E, unsigned long long* stamps) {
    int tid_l = threadIdx.x; asm volatile("" : "+v"(tid_l));
    const int tid = tid_l, wid = __builtin_amdgcn_readfirstlane(tid >> 6), lane = tid & 63, wr = wid >> 2, wc = wid & 3, fr = lane & 15, fq = lane >> 4;
    const int K = g.ld ? g.ld : g.K, nt = g.K / BK;
    int ts_lo = 0, ts_hi = 0, nts = 0; const unsigned long long rt_entry = STAMP ? (unsigned long long)wall_clock64() : 0ull;
#define PG8_STAMP() do { if (STAMP && wid == 0 && nts < 64) { const unsigned long long _c = (unsigned long long)clock64(); \
        ts_lo = (lane == nts) ? (int)(unsigned)_c : ts_lo; ts_hi = (lane == nts) ? (int)(unsigned)(_c >> 32) : ts_hi; ++nts; } } while (0)
    PG8_STAMP();
    unsigned voffA[2], voffB[2];
#pragma unroll
    for (int i = 0; i < 2; ++i) { int R, C; stage_rc(tid * 16 + i * 8192, R, C); const int Rb = Epi::PERM ? ((R & ~31) + perm32(R & 31)) : R;
        voffA[i] = (unsigned)(R * K + C) * 2u; voffB[i] = (unsigned)(Rb * K + C) * 2u; }
    const size_t kstep = (size_t)(BK * 2);
    const size_t hstep = (size_t)HALF * K * 2;
    const size_t tstep = 2 * hstep;
    const long hstepA = g.aswap ? -(long)hstep : (long)hstep;
    const unsigned ldsw = (unsigned)wid * 1024u;
    const int aoff = lds_byte(wr * 64 + fr, fq * 8), boff = lds_byte(wc * 32 + fr, fq * 8);
#define PG8_SA(b, h) (((b) * 2 + (h)) * HTB)
#define PG8_SB(b, h) ((4 + (b) * 2 + (h)) * HTB)
#define PG8_STAGE(bufoff, gbase, voff) do { _Pragma("unroll") for (int _i = 0; _i < 2; ++_i) \
        __builtin_amdgcn_global_load_lds((const unsigned*)((const char*)(gbase) + (voff)[_i]), (PG8_LAS unsigned*)(lds + (bufoff) + ldsw + _i * 8192), 16, 0, 0); } while (0)
#define PG8_LDA(dst, b, h) do { _Pragma("unroll") for (int m = 0; m < 4; ++m) _Pragma("unroll") for (int k = 0; k < 2; ++k) dst[m][k] = *(const PG8_LAS bf16x8*)(lds + PG8_SA(b, h) + aoff + m * 2048 + k * 1024); } while (0)
#define PG8_LDB(dst, b, h) do { _Pragma("unroll") for (int n = 0; n < 2; ++n) _Pragma("unroll") for (int k = 0; k < 2; ++k) dst[n][k] = *(const PG8_LAS bf16x8*)(lds + PG8_SB(b, h) + boff + n * 2048 + k * 1024); } while (0)
#define PG8_MMA(ai, bj, At, Bt) do { __builtin_amdgcn_s_setprio(1); _Pragma("unroll") for (int m = 0; m < 4; ++m) _Pragma("unroll") for (int n = 0; n < 2; ++n) _Pragma("unroll") for (int k = 0; k < 2; ++k) \
        acc[ai][bj][m][n] = __builtin_amdgcn_mfma_f32_16x16x32_bf16(Bt[n][k], At[m][k], acc[ai][bj][m][n], 0, 0, 0); __builtin_amdgcn_s_setprio(0); } while (0)
#define PG8_WAIT_V(n) asm volatile("s_waitcnt vmcnt(" #n ")" ::: "memory")
#define PG8_WAIT_L(n) asm volatile("s_waitcnt lgkmcnt(" #n ")" ::: "memory")
#define PG8_BAR __builtin_amdgcn_s_barrier()
#define PG8_SCHED __builtin_amdgcn_sched_barrier(0)
    Unit cur, nxt; int ui = 0;
    if (!S.next(0, cur)) return;
    f32x4 acc[2][2][4][2];
#pragma unroll
    for (int a = 0; a < 2; ++a)
#pragma unroll
        for (int b = 0; b < 2; ++b)
#pragma unroll
            for (int m = 0; m < 4; ++m)
#pragma unroll
                for (int n = 0; n < 2; ++n) acc[a][b][m][n] = (f32x4){0.f, 0.f, 0.f, 0.f};
    bf16x8 At[4][2], B0[2][2], B1[2][2];
    const char* cA = (const char*)g.A + (size_t)cur.pm * tstep + (g.aswap ? hstep : 0); const char* cB = (const char*)g.Bt + (size_t)cur.pn * tstep;
    S.a_ready(cur);
    PG8_STAGE(PG8_SB(0, 0), cB, voffB); PG8_STAGE(PG8_SA(0, 0), cA, voffA); PG8_STAGE(PG8_SB(0, 1), cB + hstep, voffB); PG8_STAGE(PG8_SA(0, 1), cA + hstepA, voffA);
    if (wr == 1) PG8_BAR;
    PG8_WAIT_V(4); PG8_BAR;
    PG8_STAGE(PG8_SB(1, 0), cB + kstep, voffB); PG8_STAGE(PG8_SA(1, 0), cA + kstep, voffA); PG8_STAGE(PG8_SB(1, 1), cB + hstep + kstep, voffB);
    PG8_WAIT_V(6); PG8_BAR;
    PG8_STAMP();
    for (;;) {
        const bool has_next = S.next(ui + 1, nxt);
        const char* nA = has_next ? (const char*)g.A + (size_t)nxt.pm * tstep + (g.aswap ? hstep : 0) : cA; const char* nB = has_next ? (const char*)g.Bt + (size_t)nxt.pn * tstep : cB;
        for (int t = 0; t < nt; t += 2) {
            const bool last = (t == nt - 2);
            const char* a1 = cA + (size_t)(t + 1) * kstep;
            const char* a2 = last ? nA : cA + (size_t)(t + 2) * kstep; const char* b2 = last ? nB : cB + (size_t)(t + 2) * kstep;
            const char* a3 = a2 + kstep; const char* b3 = b2 + kstep;
            if (last && has_next) S.a_ready(nxt);
            PG8_LDB(B0, 0, 0); PG8_SCHED; PG8_LDA(At, 0, 0); PG8_STAGE(PG8_SA(1, 1), a1 + hstepA, voffA);
            PG8_WAIT_L(8); PG8_BAR; PG8_WAIT_L(0); PG8_MMA(0, 0, At, B0); PG8_BAR; PG8_SCHED;
            PG8_LDB(B1, 0, 1); PG8_STAGE(PG8_SB(0, 0), b2, voffB);
            PG8_BAR; PG8_WAIT_L(0); PG8_MMA(0, 1, At, B1); PG8_BAR;
            PG8_LDA(At, 0, 1); PG8_STAGE(PG8_SA(0, 0), a2, voffA);
            PG8_BAR; PG8_WAIT_L(0); PG8_MMA(1, 0, At, B0); PG8_BAR; PG8_SCHED;
            PG8_STAGE(PG8_SB(0, 1), b2 + hstep, voffB);
            PG8_WAIT_V(6); PG8_BAR; PG8_MMA(1, 1, At, B1); PG8_BAR;
            PG8_LDB(B0, 1, 0); PG8_SCHED; PG8_LDA(At, 1, 0); PG8_STAGE(PG8_SA(0, 1), a2 + hstepA, voffA);
            PG8_WAIT_L(8); PG8_BAR; PG8_WAIT_L(0); PG8_MMA(0, 0, At, B0); PG8_BAR; PG8_SCHED;
            PG8_LDB(B1, 1, 1); PG8_STAGE(PG8_SB(1, 0), b3, voffB);
            PG8_BAR; PG8_WAIT_L(0); PG8_MMA(0, 1, At, B1); PG8_BAR;
            PG8_LDA(At, 1, 1); PG8_STAGE(PG8_SA(1, 0), a3, voffA);
            PG8_BAR; PG8_WAIT_L(0); PG8_MMA(1, 0, At, B0); PG8_BAR; PG8_SCHED;
            PG8_STAGE(PG8_SB(1, 1), b3 + hstep, voffB);
            PG8_WAIT_V(6); PG8_BAR; PG8_MMA(1, 1, At, B1); PG8_BAR;
        }
        PG8_STAMP();
        if constexpr (!Epi::AFTER_DRAIN) { E(acc, cur, wr, wc, fr, fq); S.done(cur); }
        PG8_STAMP();
        if (!has_next) break;
#pragma unroll
        for (int a = 0; a < 2; ++a)
#pragma unroll
            for (int b = 0; b < 2; ++b)
#pragma unroll
                for (int m = 0; m < 4; ++m)
#pragma unroll
                    for (int n = 0; n < 2; ++n) acc[a][b][m][n] = (f32x4){0.f, 0.f, 0.f, 0.f};
        cur = nxt; cA = nA; cB = nB; ++ui;
    }
    PG8_WAIT_V(0);
    if (wr == 0) PG8_BAR;
    PG8_BAR;
    if constexpr (Epi::AFTER_DRAIN) { E.fused(acc, cur, wr, wc, fr, fq, lds, wid, lane); S.done(cur); }
    PG8_STAMP();
    if (STAMP && wid == 0) { stamps[lane] = lane < nts ? (((unsigned long long)(unsigned)ts_hi << 32) | (unsigned)ts_lo) : 0ull;
        if (lane == 62) stamps[62] = rt_entry; if (lane == 63) stamps[63] = (unsigned long long)wall_clock64(); }
#undef PG8_STAMP
#undef PG8_SA
#undef PG8_SB
#undef PG8_STAGE
#undef PG8_LDA
#undef PG8_LDB
#undef PG8_MMA
#undef PG8_WAIT_V
#undef PG8_WAIT_L
#undef PG8_BAR
#undef PG8_SCHED
}
}

using pg8::bf16_t; using pg8::bf16x8; using pg8::f32x4; using pg8::u32x4;
#define LAS __attribute__((address_space(3)))
#define DI __device__ __forceinline__
typedef float f32x2 __attribute__((ext_vector_type(2)));
typedef unsigned u32x2 __attribute__((ext_vector_type(2)));
typedef unsigned short u16x8 __attribute__((ext_vector_type(8)));
typedef unsigned short u16x4 __attribute__((ext_vector_type(4)));

constexpr int NTOK = 8192, DM = 1024, DFF = 4096, NPROJ = 4608, NPROJ_ALL = 4624, NMOD = 6144;
constexpr int LDS_BYTES = 147456;
constexpr int GDN_PACK_B = 34880, HG_PACK_B = 18944;
constexpr size_t OFF_MOD = 0;
constexpr size_t OFF_BAR = 245760;
constexpr size_t OFF_FLAG = OFF_BAR + 13824;
constexpr size_t OFF_LBS = 264192;
constexpr size_t OFF_AB = 266240;
constexpr size_t OFF_W0 = OFF_AB + (size_t)NTOK * 16 * 4;
constexpr int NPROJ_PAD = 4864;
constexpr size_t SZ_WIN = (size_t)NPROJ_PAD * DM * 2, SZ_WSQ = (size_t)DM * DM * 2, SZ_WFF = (size_t)DFF * DM * 2;
constexpr size_t OFF_H = OFF_W0 + SZ_WIN + SZ_WSQ + 2 * SZ_WFF;
constexpr size_t OFF_PROJ = OFF_H + (size_t)NTOK * DM * 2;
constexpr size_t OFF_PACK = OFF_PROJ + (size_t)NTOK * NPROJ * 2;
constexpr size_t SZ_GPACK = (size_t)2048 * GDN_PACK_B, SZ_HPACK = (size_t)2048 * HG_PACK_B;
constexpr size_t OFF_O = OFF_PACK + SZ_GPACK + SZ_HPACK;
constexpr size_t WS_NEED = OFF_O + (size_t)2 * NTOK * DM * 2;
constexpr size_t OFF_W1 = OFF_PACK;
constexpr size_t SZ_WQKV = (size_t)3072 * DM * 2;
constexpr size_t OFF_X2 = OFF_W1 + SZ_WQKV + SZ_WSQ + 2 * SZ_WFF;
constexpr size_t OFF_CK = OFF_X2 + (size_t)NTOK * DM * 4;
constexpr size_t OFF_H2 = OFF_CK + (size_t)2 * 4 * 16 * 256 * 64 * 2;
constexpr size_t OFF_SSQ = OFF_H2 + (size_t)NTOK * DM * 2;
constexpr size_t OFF_CB = OFF_SSQ + (size_t)3 * NTOK * 16 * 4;
constexpr size_t OFF_STAMP2 = OFF_CB + (size_t)5 * (4096 + 3072 + 4096) * 4 + 131072 + 4096;
static_assert(OFF_STAMP2 + 4096 <= OFF_O, "overlay");
static_assert(WS_NEED <= 268435456ull, "workspace");

#ifndef PROBE_A
#define PROBE_A -1
#define PROBE_B 17
#define PROBE_SCALE 0.004f
#endif
#define TSTAMP(n) do { if (PROBE_A >= 0 && threadIdx.x == 0 && blockIdx.x == 0) tsl[n] = __builtin_amdgcn_s_memrealtime(); } while (0)
#define SUBSTAMP(lds_, n) do { if (PROBE_A >= 0 && threadIdx.x == 0 && blockIdx.x == 0) ((volatile LAS unsigned long long*)((lds_) + LDS_BYTES - 16 - 512))[n] = __builtin_amdgcn_s_memrealtime(); } while (0)
#define SUBSTAMPB(ws_, blk, n) do { if (PROBE_A >= 0 && threadIdx.x == 0 && blockIdx.x == (blk)) ((volatile unsigned long long*)((ws_) + OFF_STAMP2))[n] = __builtin_amdgcn_s_memrealtime(); } while (0)
struct Params {
    const float *xp, *xs, *st_hgrn, *st_gdn, *cache_k, *cache_v, *c, *c_ctx, *ada_w, *ada_b, *norm_g, *w_in, *w_out_ab, *hgrn_lb, *gdn_conv, *a_log, *dt_bias,
        *gn_hgrn, *gn_gdn, *w_qkv, *qn, *kn, *rpb, *w_out_na, *w_mlp1, *w_mlp2;
    float* out; unsigned char* ws;
};

typedef __bf16 bf16x2_t __attribute__((ext_vector_type(2)));
DI bf16_t f2bf(float f) { return __builtin_bit_cast(unsigned short, (__bf16)f); }
DI unsigned pack2_safe(float lo, float hi) { const f32x2 v = {lo, hi}; return __builtin_bit_cast(unsigned, __builtin_convertvector(v, bf16x2_t)); }
DI float bf2f(bf16_t h) { return __uint_as_float((unsigned)h << 16); }
DI float sigmoidf_(float x) { return 1.0f / (1.0f + __expf(-x)); }
DI float siluf_(float x) { return x / (1.0f + __expf(-x)); }
DI float softplusf_(float x) { return x > 20.f ? x : log1pf(__expf(x)); }
DI float wave_sum(float v) { for (int o = 32; o > 0; o >>= 1) v += __shfl_xor(v, o); return v; }
DI int modrow(int tok) { return tok < 4096 ? 0 : 1 + ((tok - 4096) >> 10); }
DI const float* xrow(const Params& p, int tok) { return tok < 4096 ? p.xp + (size_t)tok * DM : p.xs + (size_t)(tok - 4096) * DM; }

DI f32x4 mma16(const LAS bf16_t* A, int lda, const LAS bf16_t* Bt, int ldb, int K, f32x4 acc) {
    const int lane = threadIdx.x & 63, r = lane & 15, q = lane >> 4;
    const LAS bf16_t* pa = A + r * lda + 8 * q; const LAS bf16_t* pb = Bt + r * ldb + 8 * q;
    for (int k0 = 0; k0 < K; k0 += 32) {
        const bf16x8 a = *(const LAS bf16x8*)(pa + k0), b = *(const LAS bf16x8*)(pb + k0);
        acc = __builtin_amdgcn_mfma_f32_16x16x32_bf16(a, b, acc, 0, 0, 0);
    }
    return acc;
}
DI void phase_mod(const Params& p, LAS unsigned char* lds) {
    LAS float* sc = (LAS float*)lds;
    LAS float* red = (LAS float*)(lds + 20480);
    int tid_ = threadIdx.x; asm volatile("" : "+v"(tid_));
    const int tid = tid_;
    float* mod = (float*)(p.ws + OFF_MOD);
    for (int e = tid; e < 5 * 1024; e += 512) { const int m = e >> 10, k = e & 1023; const float v = m == 0 ? p.c_ctx[k] : p.c[(m - 1) * 1024 + k]; sc[e] = siluf_(v); }
    __syncthreads();
    for (int cb = blockIdx.x; cb < 256; cb += gridDim.x) {
        const int l = cb >> 7, n0 = (cb & 127) * 48;
        const float* W = p.ada_w + (size_t)l * 1024 * NMOD + n0;
        const int cq = tid % 12, ks = tid / 12;
        float acc[5][4];
#pragma unroll
        for (int m = 0; m < 5; ++m)
#pragma unroll
            for (int j = 0; j < 4; ++j) acc[m][j] = 0.f;
        if (ks < 42) {
            const int k0 = ks * 25;
#pragma unroll 1
            for (int kk = 0; kk < 25; kk += 5) {
                f32x4 w[5];
#pragma unroll
                for (int u = 0; u < 5; ++u) { const int k = k0 + kk + u; w[u] = k < 1024 ? *(const f32x4*)(W + (size_t)k * NMOD + 4 * cq) : (f32x4){0.f, 0.f, 0.f, 0.f}; }
#pragma unroll
                for (int u = 0; u < 5; ++u) { const int k = (k0 + kk + u) < 1024 ? (k0 + kk + u) : 1023;
#pragma unroll
                    for (int m = 0; m < 5; ++m) { const float sv = sc[m * 1024 + k];
#pragma unroll
                        for (int j = 0; j < 4; ++j) acc[m][j] += sv * w[u][j]; } }
            }
#pragma unroll
            for (int m = 0; m < 5; ++m)
#pragma unroll
                for (int j = 0; j < 4; ++j) red[(ks * 5 + m) * 48 + 4 * cq + j] = acc[m][j];
        }
        __syncthreads();
        if (tid < 240) { const int m = tid / 48, j = tid % 48; float s = 0.f; for (int k = 0; k < 42; ++k) s += red[(k * 5 + m) * 48 + j];
            mod[((size_t)l * 5 + m) * NMOD + n0 + j] = s + p.ada_b[l * NMOD + n0 + j]; }
        __syncthreads();
    }
    if (blockIdx.x == gridDim.x - 1) {
        float* lbs = (float*)(p.ws + OFF_LBS);
        const float a = p.hgrn_lb[tid], b = p.hgrn_lb[512 + tid], c = p.hgrn_lb[1024 + tid];
        const float mx = fmaxf(a, fmaxf(b, c)); const float ea = __expf(a - mx), eb = __expf(b - mx), ec = __expf(c - mx);
        lbs[tid] = ea / (ea + eb + ec);
    }
}
DI void transpose_tiles(const float* W, int K, int N, int ldw, bf16_t* Wt, int tbase, int ttotal, LAS unsigned char* lds, int bid = -1, int nb = 0) {
    if (bid < 0) { bid = blockIdx.x; nb = gridDim.x; }
    LAS float* tile = (LAS float*)lds;
    int tid_ = threadIdx.x; asm volatile("" : "+v"(tid_));
    const int tid = tid_, nk = K / 64, nn = N / 64, nt = nk * nn;
    int g = bid; if (g < tbase) g += ((tbase - g + nb - 1) / nb) * nb;
    __syncthreads();
    for (; g < tbase + nt; g += 4 * nb) {
        f32x4 v[4][2];
#pragma unroll
        for (int u = 0; u < 4; ++u) { const int gu = g + u * nb;
            if (gu < tbase + nt) { const int t = gu - tbase, tk = t % nk, tn = t / nk; const float* src = W + (size_t)(tk * 64 + (tid >> 4)) * ldw + tn * 64 + 4 * (tid & 15);
                v[u][0] = *(const f32x4*)src; v[u][1] = *(const f32x4*)(src + (size_t)32 * ldw); } }
#pragma unroll
        for (int u = 0; u < 4; ++u) { if (g + u * nb < tbase + nt) { LAS float* tl = tile + u * 4160; const int row = tid >> 4, c4 = tid & 15;
#pragma unroll
            for (int e = 0; e < 4; ++e) { tl[row * 65 + 4 * c4 + e] = v[u][0][e]; tl[(row + 32) * 65 + 4 * c4 + e] = v[u][1][e]; } } }
        __syncthreads();
#pragma unroll
        for (int u = 0; u < 4; ++u) { const int gu = g + u * nb;
            if (gu < tbase + nt) { const int t = gu - tbase, tk = t % nk, tn = t / nk, k0 = tk * 64, n0 = tn * 64; const LAS float* tl = tile + u * 4160;
                const int n = tid >> 3, k8 = tid & 7; u32x4 w;
                w.x = pg8::cvt_pk_bf16(tl[(k8 * 8 + 0) * 65 + n], tl[(k8 * 8 + 1) * 65 + n]); w.y = pg8::cvt_pk_bf16(tl[(k8 * 8 + 2) * 65 + n], tl[(k8 * 8 + 3) * 65 + n]);
                w.z = pg8::cvt_pk_bf16(tl[(k8 * 8 + 4) * 65 + n], tl[(k8 * 8 + 5) * 65 + n]); w.w = pg8::cvt_pk_bf16(tl[(k8 * 8 + 6) * 65 + n], tl[(k8 * 8 + 7) * 65 + n]);
                *(u32x4*)(Wt + (size_t)(n0 + n) * K + k0 + k8 * 8) = w; } }
        __syncthreads();
    }
    (void)ttotal;
}
DI void phase_w0(const Params& p, LAS unsigned char* lds) {
    bf16_t* w = (bf16_t*)(p.ws + OFF_W0);
    transpose_tiles(p.w_in, 1024, NPROJ, NPROJ_ALL, w, 0, 0, lds);
    for (int e = blockIdx.x * 512 + threadIdx.x; e < 16 * 1024; e += gridDim.x * 512) { const int k = e >> 4, j = e & 15; w[(size_t)(NPROJ + j) * DM + k] = f2bf(p.w_in[(size_t)k * NPROJ_ALL + NPROJ + j]); }
    for (int e = blockIdx.x * 512 + threadIdx.x; e < 240 * 128; e += gridDim.x * 512) *(u32x4*)(w + (size_t)(NPROJ + 16) * DM + (size_t)e * 8) = (u32x4){0u, 0u, 0u, 0u};
}
DI void bias_cols(const float* W, int N, const float* shv, float* outb, LAS unsigned char* lds, int bid, int nb) {
    LAS float* sv = (LAS float*)lds;
    LAS float* red = (LAS float*)(lds + 20480);
    int tid_ = threadIdx.x; asm volatile("" : "+v"(tid_));
    const int tid = tid_, cq = tid & 7, ks = tid >> 3;
    __syncthreads();
    for (int e = tid; e < 5 * 1024; e += 512) sv[e] = shv[(size_t)(e >> 10) * NMOD + (e & 1023)];
    __syncthreads();
    for (int cb = bid; cb < N / 32; cb += nb) {
        const float* Wp = W + cb * 32 + 4 * cq;
        float acc[5][4];
#pragma unroll
        for (int m = 0; m < 5; ++m)
#pragma unroll
            for (int j = 0; j < 4; ++j) acc[m][j] = 0.f;
#pragma unroll 1
        for (int kk = 0; kk < 16; kk += 4) {
            f32x4 w[4];
#pragma unroll
            for (int u = 0; u < 4; ++u) w[u] = *(const f32x4*)(Wp + (size_t)(ks * 16 + kk + u) * N);
#pragma unroll
            for (int u = 0; u < 4; ++u)
#pragma unroll
                for (int m = 0; m < 5; ++m) { const float s0 = sv[m * 1024 + ks * 16 + kk + u];
#pragma unroll
                    for (int j = 0; j < 4; ++j) acc[m][j] += s0 * w[u][j]; }
        }
#pragma unroll
        for (int m = 0; m < 5; ++m)
#pragma unroll
            for (int j = 0; j < 4; ++j) red[(ks * 5 + m) * 32 + 4 * cq + j] = acc[m][j];
        __syncthreads();
        if (tid < 160) { const int m = tid >> 5, j = tid & 31; float s0 = 0.f; for (int k = 0; k < 64; ++k) s0 += red[(k * 5 + m) * 32 + j]; outb[(size_t)m * N + cb * 32 + j] = s0; }
        __syncthreads();
    }
}
DI bf16_t* w1_temp(const Params& p) { return (bf16_t*)(p.out + (size_t)NTOK * DM + 2 * 2097152); }
DI void helper_scan(const Params& p, LAS unsigned char* lds, int bid, int nb) {
    bf16_t* w0 = (bf16_t*)(p.ws + OFF_W0) + (size_t)NPROJ_PAD * DM + (size_t)DM * DM;
    int tb = 0;
    transpose_tiles(p.w_mlp1, 1024, 4096, 4096, w0, tb, 0, lds, bid, nb); tb += 1024;
    transpose_tiles(p.w_mlp2, 4096, 1024, 1024, w0 + (size_t)DFF * DM, tb, 0, lds, bid, nb); tb += 1024;
    bf16_t* w = w1_temp(p);
    transpose_tiles(p.w_qkv, 1024, 3072, 3072, w, tb, 0, lds, bid, nb); tb += 16 * 48;
    transpose_tiles(p.w_out_na, 1024, 1024, 1024, w + (size_t)3072 * DM, tb, 0, lds, bid, nb); tb += 256;
    transpose_tiles(p.w_mlp1 + (size_t)DM * DFF, 1024, 4096, 4096, w + (size_t)3072 * DM + (size_t)DM * DM, tb, 0, lds, bid, nb); tb += 1024;
    transpose_tiles(p.w_mlp2 + (size_t)DFF * DM, 4096, 1024, 1024, w + (size_t)3072 * DM + (size_t)DM * DM + (size_t)DFF * DM, tb, 0, lds, bid, nb);
}
DI void phase_w1(const Params& p, LAS unsigned char* lds) {
    transpose_tiles(p.w_out_ab, 1024, 1024, 1024, (bf16_t*)(p.ws + OFF_W0) + (size_t)NPROJ_PAD * DM, 0, 0, lds);
    int tid_ = threadIdx.x; asm volatile("" : "+v"(tid_));
    const int tid = tid_, bid = blockIdx.x, nb = gridDim.x;
    { const u32x4* src = (const u32x4*)w1_temp(p); u32x4* dst = (u32x4*)(p.ws + OFF_W1);
      for (int e = bid * 512 + tid; e < 1572864; e += nb * 2048) {
          u32x4 v[4];
#pragma unroll
          for (int u = 0; u < 4; ++u) if (e + u * nb * 512 < 1572864) v[u] = src[e + u * nb * 512];
#pragma unroll
          for (int u = 0; u < 4; ++u) if (e + u * nb * 512 < 1572864) dst[e + u * nb * 512] = v[u]; } }
    const float* mod0 = (const float*)(p.ws + OFF_MOD); const float* mod1 = mod0 + (size_t)5 * NMOD;
    bias_cols(p.w_mlp1, 4096, mod0 + 3072, (float*)(p.ws + OFF_CB), lds, bid, nb);
    bias_cols(p.w_qkv, 3072, mod1, (float*)(p.ws + OFF_CB) + 5 * 4096, lds, bid, nb);
    bias_cols(p.w_mlp1 + (size_t)DM * DFF, 4096, mod1 + 3072, (float*)(p.ws + OFF_CB) + 5 * 4096 + 5 * 3072, lds, bid, nb);
    { bf16_t* CK = (bf16_t*)(p.ws + OFF_CK);
      for (int e = bid * 512 + tid; e < 262144; e += nb * 512) {
          const float* src = e < 131072 ? p.cache_k + (size_t)e * 8 : p.cache_v + (size_t)(e - 131072) * 8;
          const f32x4 a = *(const f32x4*)src, b = *(const f32x4*)(src + 4);
          *(u32x4*)(CK + (size_t)e * 8) = (u32x4){pg8::cvt_pk_bf16(a[0], a[1]), pg8::cvt_pk_bf16(a[2], a[3]), pg8::cvt_pk_bf16(b[0], b[1]), pg8::cvt_pk_bf16(b[2], b[3])}; } }
}
template <bool AB> DI void phase_norm(const Params& p, const float* srcp, const float* srcs, int l, int sub, LAS unsigned char* lds) {
    int tid_ = threadIdx.x; asm volatile("" : "+v"(tid_));
    const int tid = tid_, wid = tid >> 6, lane = tid & 63;
    const float* mod = (const float*)(p.ws + OFF_MOD) + (size_t)l * 5 * NMOD;
    const float* gw = p.norm_g + (l * 2 + sub) * 1024;
    bf16_t* H = (bf16_t*)(p.ws + OFF_H);
    LAS float* wab = (LAS float*)lds;
    if (AB) {
#pragma unroll
        for (int u = 0; u < 8; ++u) { const int e4 = tid + u * 512, k = e4 >> 2, j4 = e4 & 3;
            *(LAS f32x4*)(wab + k * 16 + 4 * j4) = *(const f32x4*)(p.w_in + (size_t)k * NPROJ_ALL + NPROJ + 4 * j4); }
        __syncthreads(); }
    SUBSTAMP(lds, 32);
    float* ab = (float*)(p.ws + OFF_AB);
    const int stride = 1;
    for (int tb = blockIdx.x * 32 + wid * 4; tb < NTOK; tb += gridDim.x * 32) {
        f32x4 x[4][4]; float ss[4];
#pragma unroll
        for (int r = 0; r < 4; ++r) { const int tok = tb + r * stride;
            if (tok < NTOK) { const float* xr = tok < 4096 ? srcp + (size_t)tok * 1024 : srcs + (size_t)(tok - 4096) * 1024;
#pragma unroll
                for (int i = 0; i < 4; ++i) x[r][i] = *(const f32x4*)(xr + i * 256 + lane * 4); }
            else {
#pragma unroll
                for (int i = 0; i < 4; ++i) x[r][i] = (f32x4){0.f, 0.f, 0.f, 0.f}; } }
        f32x4 g4[4];
#pragma unroll
        for (int i = 0; i < 4; ++i) g4[i] = *(const f32x4*)(gw + i * 256 + lane * 4);
#pragma unroll
        for (int r = 0; r < 4; ++r) { float a = 0.f;
#pragma unroll
            for (int i = 0; i < 4; ++i) a += x[r][i][0] * x[r][i][0] + x[r][i][1] * x[r][i][1] + x[r][i][2] * x[r][i][2] + x[r][i][3] * x[r][i][3];
            ss[r] = a; }
#pragma unroll
        for (int o = 32; o > 0; o >>= 1) {
#pragma unroll
            for (int r = 0; r < 4; ++r) ss[r] += __shfl_xor(ss[r], o); }
#pragma unroll
        for (int r = 0; r < 4; ++r) { const int tok = tb + r * stride; if (tok >= NTOK) break;
            const float rs = rsqrtf(ss[r] * (1.0f / 1024.0f) + 1e-6f);
            const int mr = modrow(tok);
            const float* sh = mod + (size_t)mr * NMOD + sub * 3072; const float* scp = sh + 1024;
            float pa[16];
            if (AB) {
#pragma unroll
                for (int j = 0; j < 16; ++j) pa[j] = 0.f; }
#pragma unroll
            for (int i = 0; i < 4; ++i) { const int k = i * 256 + lane * 4;
                const f32x4 s4 = *(const f32x4*)(scp + k), h4 = *(const f32x4*)(sh + k);
                f32x4 hv;
#pragma unroll
                for (int e = 0; e < 4; ++e) hv[e] = x[r][i][e] * rs * g4[i][e] * (1.0f + s4[e]) + h4[e];
                uint2 w; w.x = pg8::cvt_pk_bf16(hv[0], hv[1]); w.y = pg8::cvt_pk_bf16(hv[2], hv[3]);
                *(uint2*)(H + (size_t)tok * 1024 + k) = w;
                if (AB) {
#pragma unroll
                    for (int e = 0; e < 4; ++e) {
#pragma unroll
                        for (int j4 = 0; j4 < 4; ++j4) { const f32x4 wv = *(const LAS f32x4*)(wab + (k + e) * 16 + 4 * j4);
                            pa[4 * j4 + 0] += hv[e] * wv[0]; pa[4 * j4 + 1] += hv[e] * wv[1]; pa[4 * j4 + 2] += hv[e] * wv[2]; pa[4 * j4 + 3] += hv[e] * wv[3]; } } }
            }
            if (AB) {
                float mine = 0.f;
#pragma unroll
                for (int j = 0; j < 16; ++j) { const float sv = wave_sum(pa[j]); if (lane == j) mine = sv; }
                if (lane < 16) ab[(size_t)tok * 16 + lane] = mine;
            }
        }
    }
}
DI int chunk_seq_start(int gc) { return gc < 128 ? (gc >> 3) * 256 : 4096 + ((gc - 128) >> 5) * 1024; }
DI int chunk_seq_len(int gc) { return gc < 128 ? 256 : 1024; }
struct PrepRaw { u32x4 v[4]; float ab; };
DI void prep_fetch(const Params& p, int pi, int kind, PrepRaw& R) {
    const int tid = threadIdx.x, h = pi & 3, gc = pi >> 2, t0 = gc * 32;
    const bf16_t* proj = (const bf16_t*)(p.ws + OFF_PROJ);
    if (kind == 0) {
        const int sb = chunk_seq_start(gc), se = sb + chunk_seq_len(gc);
#pragma unroll
        for (int k = 0; k < 4; ++k) { const int pc = tid + k * 512; R.v[k] = (u32x4){0u, 0u, 0u, 0u};
            if (pc < 1728) { const int row = pc / 48, rem = pc % 48, part = rem >> 4, c8 = rem & 15, tk = t0 - 2 + row;
                if (tk >= sb && tk < se) R.v[k] = *(const u32x4*)(proj + (size_t)tk * NPROJ + 2560 + part * 512 + h * 128 + c8 * 8); } }
        R.ab = 0.f;
        if (tid < 128) { const int i = tid >> 2, w = tid & 3;
            R.ab = ((const float*)(p.ws + OFF_AB))[(size_t)(t0 + i) * 16 + w * 4 + h]; }
    } else {
#pragma unroll
        for (int k = 0; k < 3; ++k) { const int pc = tid + k * 512, row = pc / 48, rem = pc % 48, which = rem >> 4, c8 = rem & 15;
            R.v[k] = *(const u32x4*)(proj + (size_t)(t0 + row) * NPROJ + which * 512 + h * 128 + c8 * 8); }
    }
}
DI void gdn_prep_item(const Params& p, int gc, int h, const PrepRaw& R, LAS unsigned char* lds) {
    int tid_ = threadIdx.x; asm volatile("" : "+v"(tid_));
    const int tid = tid_, wid = __builtin_amdgcn_readfirstlane(tid >> 6), lane = tid & 63;
    LAS bf16_t* RAW = (LAS bf16_t*)lds;
    LAS bf16_t* QB = (LAS bf16_t*)(lds + 27648); LAS bf16_t* KB = (LAS bf16_t*)(lds + 36352); LAS bf16_t* VB = (LAS bf16_t*)(lds + 45056);
    LAS float* KK = (LAS float*)(lds + 53760); LAS float* QK = (LAS float*)(lds + 57984);
    LAS float* CW = (LAS float*)(lds + 117248); LAS float* ABL = (LAS float*)(lds + 124928);
#pragma unroll
    for (int k = 0; k < 4; ++k) { const int pc = tid + k * 512; if (pc < 1728) *(LAS u32x4*)(RAW + pc * 8) = R.v[k]; }
    if (tid < 128) ABL[tid] = R.ab;
    SUBSTAMP(lds, 33);
    __syncthreads();
    SUBSTAMP(lds, 34);
    { const int i = tid >> 4, cg = tid & 15;
#pragma unroll
      for (int part = 0; part < 3; ++part) {
          float a[8];
#pragma unroll
          for (int e = 0; e < 8; ++e) a[e] = 0.f;
#pragma unroll
          for (int j = 0; j < 5; ++j) { const u16x8 x = *(const LAS u16x8*)(RAW + (i + j) * 384 + part * 128 + cg * 8);
              const f32x4 w0 = *(const LAS f32x4*)(CW + j * 384 + part * 128 + cg * 8), w1 = *(const LAS f32x4*)(CW + j * 384 + part * 128 + cg * 8 + 4);
#pragma unroll
              for (int e = 0; e < 4; ++e) { a[e] += bf2f(x[e]) * w0[e]; a[4 + e] += bf2f(x[4 + e]) * w1[e]; } }
          float ss = 0.f;
#pragma unroll
          for (int e = 0; e < 8; ++e) { a[e] = siluf_(a[e]); ss += a[e] * a[e]; }
          float sc = 1.f;
          if (part < 2) { ss += __shfl_xor(ss, 1); ss += __shfl_xor(ss, 2); ss += __shfl_xor(ss, 4); ss += __shfl_xor(ss, 8);
              sc = rsqrtf(ss + 1e-6f) * (part == 0 ? 0.08838834764831845f : 1.f); }
          u32x4 w; w.x = pg8::cvt_pk_bf16(a[0] * sc, a[1] * sc); w.y = pg8::cvt_pk_bf16(a[2] * sc, a[3] * sc); w.z = pg8::cvt_pk_bf16(a[4] * sc, a[5] * sc); w.w = pg8::cvt_pk_bf16(a[6] * sc, a[7] * sc);
          *(LAS u32x4*)(QB + part * 4352 + i * 136 + cg * 8) = w;
      } }
    __syncthreads();
    SUBSTAMP(lds, 35);
    { const int w4 = wid & 3, mt = w4 >> 1, nt = w4 & 1, r = lane & 15, q = lane >> 4;
      f32x4 acc = {0.f, 0.f, 0.f, 0.f};
      acc = mma16((wid < 4 ? KB : QB) + 16 * mt * 136, 136, KB + 16 * nt * 136, 136, 128, acc);
      LAS float* D = wid < 4 ? KK : QK;
#pragma unroll
      for (int i = 0; i < 4; ++i) D[(16 * mt + 4 * q + i) * 33 + 16 * nt + r] = acc[i]; }
    const int dir = wid >> 2, ht = tid & 255, hw = wid & 3;
    LAS float* GS = (LAS float*)(lds + 125440 + dir * 512);     LAS float* AM = (LAS float*)(lds + 62720 + dir * 4224);
    LAS bf16_t* TM = (LAS bf16_t*)(lds + 71168 + dir * 2560); LAS bf16_t* RT = (LAS bf16_t*)(lds + 76288 + dir * 20480);
    bf16_t* pack = (bf16_t*)(p.ws + OFF_PACK + ((size_t)(gc * 4 + h) * 2 + dir) * GDN_PACK_B);
    if (hw == 0) {
        const int pp = lane & 31, i = dir ? 31 - pp : pp;
        const float araw = ABL[i * 4 + dir], braw = ABL[i * 4 + 2 + dir];
        const float beta = sigmoidf_(braw);
        float g = -__expf(p.a_log[dir * 4 + h]) * softplusf_(araw + p.dt_bias[dir * 4 + h]);
#pragma unroll
        for (int o = 1; o < 32; o <<= 1) { const float t = __shfl_up(g, o, 32); if (pp >= o) g += t; }
        const float glast = __shfl(g, 31, 32);
        if (lane < 32) { GS[pp] = g; GS[32 + pp] = beta; GS[64 + pp] = __expf(g); GS[96 + pp] = __expf(glast - g); }
    }
    __syncthreads();
    SUBSTAMP(lds, 36);
    { const int pp = ht >> 3, s0 = (ht & 7) * 4, ip = dir ? 31 - pp : pp; const float gp = GS[pp], bp = GS[32 + pp];
      float at[4];
#pragma unroll
      for (int e = 0; e < 4; ++e) { const int s = s0 + e, is = dir ? 31 - s : s; const float dec = s <= pp ? __expf(gp - GS[s]) : 0.f;
          AM[pp * 33 + s] = s < pp ? bp * KK[ip * 33 + is] * dec : 0.f; at[e] = s <= pp ? QK[ip * 33 + is] * dec : 0.f; }
      uint2 w; w.x = pg8::cvt_pk_bf16(at[0], at[1]); w.y = pg8::cvt_pk_bf16(at[2], at[3]);
      *(uint2*)(pack + 12288 + pp * 32 + s0) = w; }
    __syncthreads();
    SUBSTAMP(lds, 37);
    if (hw == 0) {
        LAS bf16_t* XA = (LAS bf16_t*)(lds + 126464 + dir * 5120); LAS bf16_t* TB = XA + 640; LAS bf16_t* PA = XA + 1280; LAS bf16_t* XB = XA + 1920;
        { const int rr = lane >> 2, c4 = 16 + (lane & 3) * 4;
          *(LAS u32x2*)(XA + rr * 40 + c4) = (u32x2){0u, 0u}; *(LAS u32x2*)(TB + rr * 40 + c4) = (u32x2){0u, 0u}; *(LAS u32x2*)(PA + rr * 40 + c4) = (u32x2){0u, 0u}; *(LAS u32x2*)(XB + rr * 40 + c4) = (u32x2){0u, 0u};
          *(LAS u32x2*)(TM + rr * 40 + c4) = (u32x2){0u, 0u}; }
        { const int n = lane & 15, k0 = (lane >> 4) * 4;
#pragma unroll
          for (int e = 0; e < 4; ++e) TB[n * 40 + k0 + e] = f2bf(AM[(16 + k0 + e) * 33 + n]); }
        if (lane < 32) {
            const int c = lane & 15, base = lane & 16;
            float x[16];
#pragma unroll
            for (int pp = 0; pp < 16; ++pp) {
                float a0 = (pp == c) ? 1.f : 0.f, a1 = 0.f;
                const LAS float* ar = AM + (base + pp) * 33 + base;
#pragma unroll
                for (int j = 0; j < pp; ++j) { if (j & 1) a1 -= ar[j] * x[j]; else a0 -= ar[j] * x[j]; }
                x[pp] = a0 + a1; const bf16_t xb = f2bf(a0 + a1);
                TM[(base + pp) * 40 + base + c] = xb;
                if (base) XA[pp * 40 + c] = xb; else XB[c * 40 + pp] = xb;
            }
        }
        asm volatile("s_waitcnt lgkmcnt(0)" ::: "memory");
        { const int r = lane & 15, q = lane >> 4;
          f32x4 acc = {0.f, 0.f, 0.f, 0.f};
          acc = mma16(XA, 40, TB, 40, 32, acc);
#pragma unroll
          for (int i = 0; i < 4; ++i) PA[(4 * q + i) * 40 + r] = f2bf(acc[i]);
          asm volatile("s_waitcnt lgkmcnt(0)" ::: "memory");
          f32x4 acc2 = {0.f, 0.f, 0.f, 0.f};
          acc2 = mma16(PA, 40, XB, 40, 32, acc2);
#pragma unroll
          for (int i = 0; i < 4; ++i) TM[(16 + 4 * q + i) * 40 + r] = f2bf(-acc2[i]); }
    } else {
        if (ht == 64) *(float*)((unsigned char*)pack + 34816) = GS[64 + 31];
        for (int task = ht - 64; task < 2048; task += 192) {
            if (task < 1024) {
                const int row = task >> 2, p0 = (task & 3) * 8, d = row & 127; const LAS bf16_t* src = row < 128 ? KB : VB;
                float o[8];
#pragma unroll
                for (int e = 0; e < 8; ++e) { const int pp = p0 + e, ip = dir ? 31 - pp : pp; const float sc = GS[32 + pp] * (row < 128 ? GS[64 + pp] : 1.f); o[e] = bf2f(src[ip * 136 + d]) * sc; }
                u32x4 w; w.x = pg8::cvt_pk_bf16(o[0], o[1]); w.y = pg8::cvt_pk_bf16(o[2], o[3]); w.z = pg8::cvt_pk_bf16(o[4], o[5]); w.w = pg8::cvt_pk_bf16(o[6], o[7]);
                *(LAS u32x4*)(RT + row * 40 + p0) = w;
            } else if (task < 1536) {
                const int t2 = task - 1024, pp = t2 >> 4, d0 = (t2 & 15) * 8, ip = dir ? 31 - pp : pp; const float eg = GS[64 + pp];
                const u16x8 x = *(const LAS u16x8*)(QB + ip * 136 + d0);
                u32x4 w; w.x = pg8::cvt_pk_bf16(bf2f(x[0]) * eg, bf2f(x[1]) * eg); w.y = pg8::cvt_pk_bf16(bf2f(x[2]) * eg, bf2f(x[3]) * eg);
                w.z = pg8::cvt_pk_bf16(bf2f(x[4]) * eg, bf2f(x[5]) * eg); w.w = pg8::cvt_pk_bf16(bf2f(x[6]) * eg, bf2f(x[7]) * eg);
                *(u32x4*)(pack + 4096 + pp * 128 + d0) = w;
            } else {
                const int t2 = task - 1536, d = t2 >> 2, p0 = (t2 & 3) * 8;
                float o[8];
#pragma unroll
                for (int e = 0; e < 8; ++e) { const int pp = p0 + e, ip = dir ? 31 - pp : pp; o[e] = bf2f(KB[ip * 136 + d]) * GS[96 + pp]; }
                u32x4 w; w.x = pg8::cvt_pk_bf16(o[0], o[1]); w.y = pg8::cvt_pk_bf16(o[2], o[3]); w.z = pg8::cvt_pk_bf16(o[4], o[5]); w.w = pg8::cvt_pk_bf16(o[6], o[7]);
                *(u32x4*)(pack + 8192 + d * 32 + p0) = w;
            }
        }
    }
    __syncthreads();
    SUBSTAMP(lds, 38);
#pragma unroll
    for (int t = 0; t < 8; ++t) { const int id = hw * 8 + t, which = id >> 4, dt = (id >> 1) & 7, pt = id & 1, r = lane & 15, q = lane >> 4;
        f32x4 acc = {0.f, 0.f, 0.f, 0.f};
        acc = mma16(RT + (which * 128 + 16 * dt) * 40, 40, TM + 16 * pt * 40, 40, 32, acc);
        uint2 w; w.x = pack2_safe(acc[0], acc[1]); w.y = pack2_safe(acc[2], acc[3]);
        *(uint2*)(pack + (which ? 13312 : 0) + (16 * pt + r) * 128 + 16 * dt + 4 * q) = w; }
    __syncthreads();
    SUBSTAMP(lds, 39);
}
template <int PH> DI void hgrn_cols(const Params& p, const LAS bf16_t* RAW, LAS bf16_t* QT, LAS bf16_t* KT, LAS float* XS, bf16_t* pack, const float* lbs, int h, int dir, int d) {
    const float lb = lbs[h * 128 + d];
    float g[16], kv[16];
    float acc = 0.f;
#pragma unroll
    for (int e = 0; e < 16; ++e) { const int pp = PH * 16 + e, ip = dir ? 31 - pp : pp; const float fraw = bf2f(RAW[ip * 384 + 128 + dir * 128 + d]);
        const float f = lb + (1.0f - lb) * sigmoidf_(fraw); kv[e] = 1.0f - f; acc += __logf(f); g[e] = acc; }
    XS[PH * 128 + d] = acc;
    __syncthreads();
    const float oth = XS[(1 - PH) * 128 + d];
    const float gr = PH ? oth : acc, gl = acc + oth, egr = __expf(gr), eglr = __expf(gl - gr);
    if (PH == 1) ((float*)((unsigned char*)pack + 18432))[d] = __expf(gl);
    float kh[16];
#pragma unroll
    for (int e = 0; e < 16; ++e) {
        const int pp = PH * 16 + e, ip = dir ? 31 - pp : pp;
        const float ge = PH ? g[e] + oth : g[e];
        const float e1 = __expf(ge - gr), r1 = __builtin_amdgcn_rcpf(e1);
        const float qv = siluf_(bf2f(RAW[ip * 384 + d])) * 0.08838834764831845f;
        pack[1024 + pp * 128 + d] = f2bf(qv * e1 * egr);
        kh[e] = kv[e] * eglr * r1;
        QT[pp * 136 + d] = f2bf(qv * e1); KT[pp * 136 + d] = f2bf(kv[e] * r1);
    }
    u32x4 w0, w1;
    w0.x = pg8::cvt_pk_bf16(kh[0], kh[1]); w0.y = pg8::cvt_pk_bf16(kh[2], kh[3]); w0.z = pg8::cvt_pk_bf16(kh[4], kh[5]); w0.w = pg8::cvt_pk_bf16(kh[6], kh[7]);
    w1.x = pg8::cvt_pk_bf16(kh[8], kh[9]); w1.y = pg8::cvt_pk_bf16(kh[10], kh[11]); w1.z = pg8::cvt_pk_bf16(kh[12], kh[13]); w1.w = pg8::cvt_pk_bf16(kh[14], kh[15]);
    *(u32x4*)(pack + 5120 + d * 32 + PH * 16) = w0; *(u32x4*)(pack + 5120 + d * 32 + PH * 16 + 8) = w1;
}
DI void hgrn_prep_item(const Params& p, int gc, int h, const PrepRaw& R, LAS unsigned char* lds) {
    int tid_ = threadIdx.x; asm volatile("" : "+v"(tid_));
    const int tid = tid_, wid = __builtin_amdgcn_readfirstlane(tid >> 6), lane = tid & 63;
    LAS bf16_t* RAW = (LAS bf16_t*)lds;
    const float* lbs = (const float*)(p.ws + OFF_LBS);
#pragma unroll
    for (int k = 0; k < 3; ++k) *(LAS u32x4*)(RAW + (tid + k * 512) * 8) = R.v[k];
    __syncthreads();
    SUBSTAMP(lds, 40);
    const int dir = wid >> 2, ht = tid & 255, hw = wid & 3, d = ht & 127, ph = ht >> 7;
    LAS bf16_t* QT = (LAS bf16_t*)(lds + 24576 + dir * 17408); LAS bf16_t* KT = (LAS bf16_t*)(lds + 33280 + dir * 17408);
    bf16_t* pack = (bf16_t*)(p.ws + OFF_PACK + SZ_GPACK + ((size_t)(gc * 4 + h) * 2 + dir) * HG_PACK_B);
    LAS float* XS = (LAS float*)(lds + 59392 + dir * 1024);
    if (ph == 0) hgrn_cols<0>(p, RAW, QT, KT, XS, pack, lbs, h, dir, d); else hgrn_cols<1>(p, RAW, QT, KT, XS, pack, lbs, h, dir, d);
    __syncthreads();
    SUBSTAMP(lds, 41);
    { const int mt = hw >> 1, nt = hw & 1, r = lane & 15, q = lane >> 4;
      f32x4 acc = {0.f, 0.f, 0.f, 0.f};
      acc = mma16(QT + 16 * mt * 136, 136, KT + 16 * nt * 136, 136, 128, acc);
#pragma unroll
      for (int i = 0; i < 4; ++i) { const int pp = 16 * mt + 4 * q + i, s = 16 * nt + r; pack[pp * 32 + s] = f2bf(s <= pp ? acc[i] : 0.f); } }
    __syncthreads();
    SUBSTAMP(lds, 42);
}
DI void phase_prep(const Params& p, LAS unsigned char* lds) {
    const int G = gridDim.x, tid = threadIdx.x;
    LAS float* CW = (LAS float*)(lds + 117248);
    int cwh = -1;
    PrepRaw R;
    int pi = blockIdx.x;
    if (pi < 1024) prep_fetch(p, pi, 0, R);
#pragma unroll 1
    for (; pi < 1024; pi += G) {
        const int h = pi & 3, gc = pi >> 2;
        if (h != cwh) { __syncthreads(); for (int e = tid; e < 5 * 384; e += 512) { const int j = e / 384, c = e % 384; CW[e] = p.gdn_conv[j * 1536 + (c >> 7) * 512 + h * 128 + (c & 127)]; } cwh = h; }
        PrepRaw R2; prep_fetch(p, pi, 1, R2);
        gdn_prep_item(p, gc, h, R, lds);
        if (pi + G < 1024) prep_fetch(p, pi + G, 0, R);
        hgrn_prep_item(p, gc, h, R2, lds);
    }
}
struct ScanPre { u32x4 v[5]; };
template <bool GDN> DI void scan_fetch(const Params& p, const unsigned char* packb, int tok0, int h, int dir, ScanPre& R) {
    const int tid = threadIdx.x; const bf16_t* pack = (const bf16_t*)packb;
    if (GDN) { R.v[0] = *(const u32x4*)(pack + tid * 8); R.v[1] = *(const u32x4*)(pack + 4096 + tid * 8); R.v[2] = *(const u32x4*)(pack + 8192 + tid * 8);
        R.v[3] = *(const u32x4*)(pack + 13312 + tid * 8); R.v[4] = tid < 128 ? *(const u32x4*)(pack + 12288 + tid * 8) : *(const u32x4*)(packb + 34816); }
    else { R.v[0] = *(const u32x4*)(pack + 1024 + tid * 8); R.v[2] = *(const u32x4*)(pack + 5120 + tid * 8);
        { const int pp = tid >> 4, ip = dir ? 31 - pp : pp; R.v[1] = *(const u32x4*)((const bf16_t*)(p.ws + OFF_PROJ) + (size_t)(tok0 + ip) * NPROJ + 1536 + h * 128 + (tid & 15) * 8); }
        R.v[3] = tid < 32 ? *(const u32x4*)(packb + 18432 + tid * 16) : (u32x4){0u, 0u, 0u, 0u};
        R.v[4] = tid < 128 ? *(const u32x4*)(pack + tid * 8) : (u32x4){0u, 0u, 0u, 0u}; }
}
template <bool GDN> DI void scan_stash(LAS unsigned char* buf, const ScanPre& R) {
    const int tid = threadIdx.x, row = tid >> 4, c8 = (tid & 15) * 8, kr = tid >> 2, k8 = (tid & 3) * 8;
    *(LAS u32x4*)((LAS bf16_t*)buf + row * 136 + c8) = R.v[0];
    *(LAS u32x4*)((LAS bf16_t*)(buf + 8704) + row * 136 + c8) = R.v[1];
    *(LAS u32x4*)((LAS bf16_t*)(buf + 17408) + kr * 40 + k8) = R.v[2];
    if (GDN) { *(LAS u32x4*)((LAS bf16_t*)(buf + 30208) + row * 136 + c8) = R.v[3]; if (tid == 128) *(LAS unsigned*)(buf + 38912) = R.v[4].x; }
    else if (tid < 32) *(LAS u32x4*)(buf + 30208 + tid * 16) = R.v[3];
    if (tid < 128) *(LAS u32x4*)((LAS bf16_t*)(buf + 27648) + (tid >> 2) * 40 + k8) = R.v[4];
}
template <bool GDN> DI void scan_item(const Params& p, int s, int h, int dir, LAS unsigned char* lds) {
    int tid_ = threadIdx.x; asm volatile("" : "+v"(tid_));
    const int tid = tid_, wid = __builtin_amdgcn_readfirstlane(tid >> 6), lane = tid & 63, r = lane & 15, q = lane >> 4, dv0 = wid * 16;
    LAS bf16_t* ST = (LAS bf16_t*)(lds + 77856 + wid * 4352); LAS bf16_t* VN = (LAS bf16_t*)(lds + 112672 + wid * 1280);
    const int sstart = s < 16 ? s * 256 : 4096 + (s - 16) * 1024, N = s < 16 ? 8 : 32, gc0 = sstart >> 5;
    bf16_t* O = (bf16_t*)(p.ws + OFF_O) + (size_t)dir * NTOK * DM;
    const unsigned char* pbase = p.ws + OFF_PACK + (GDN ? 0 : SZ_GPACK);
    const size_t pstride = GDN ? GDN_PACK_B : HG_PACK_B;
    ScanPre Ra;
    auto fetch = [&](int mm, ScanPre& R) { if (mm < N) { const int nn = dir ? N - 1 - mm : mm; scan_fetch<GDN>(p, pbase + ((size_t)((gc0 + nn) * 4 + h) * 2 + dir) * pstride, sstart + 32 * nn, h, dir, R); } };
    fetch(0, Ra);
    f32x4 S[8];
    if (s >= 16) { const float* st = (GDN ? p.st_gdn : p.st_hgrn) + ((size_t)((s - 16) * 2 + dir) * 4 + h) * 16384;
#pragma unroll
        for (int i = 0; i < 8; ++i)
#pragma unroll
            for (int j = 0; j < 4; ++j) S[i][j] = st[(16 * i + 4 * q + j) * 128 + dv0 + r];
    } else {
#pragma unroll
        for (int i = 0; i < 8; ++i) S[i] = (f32x4){0.f, 0.f, 0.f, 0.f}; }
#pragma unroll
    for (int i = 0; i < 8; ++i) { u32x2 w; w.x = pack2_safe(S[i][0], S[i][1]); w.y = pack2_safe(S[i][2], S[i][3]); *(LAS u32x2*)(ST + r * 136 + 16 * i + 4 * q) = w; }
    __syncthreads();
    scan_stash<GDN>(lds, Ra);
#pragma unroll 1
    for (int m = 0; m < N; ++m) {
        const int n = dir ? N - 1 - m : m;
        LAS unsigned char* buf = lds + (m & 1) * 38928;
        LAS bf16_t* A0 = (LAS bf16_t*)buf; LAS bf16_t* A1 = (LAS bf16_t*)(buf + 8704); LAS bf16_t* KT = (LAS bf16_t*)(buf + 17408);
        LAS bf16_t* AT = (LAS bf16_t*)(buf + 27648); LAS bf16_t* U = (LAS bf16_t*)(buf + 30208); LAS float* av = (LAS float*)(buf + 30208);
        fetch(m + 1, Ra);
        if (m == 3) SUBSTAMP(lds, 44);
        __syncthreads();
        const float egl = GDN ? *(const LAS float*)(buf + 38912) : 1.f;
        if (m == 3) SUBSTAMP(lds, 45);
        const int fo = r * 136 + 8 * q, fk = r * 40 + 8 * q;
        bf16x8 bst[4], a0f[2][4], atf[2], ktf[8];
#pragma unroll
        for (int kk = 0; kk < 4; ++kk) { bst[kk] = *(const LAS bf16x8*)(ST + fo + 32 * kk); a0f[0][kk] = *(const LAS bf16x8*)(A0 + fo + 32 * kk); a0f[1][kk] = *(const LAS bf16x8*)(A0 + 16 * 136 + fo + 32 * kk); }
        atf[0] = *(const LAS bf16x8*)(AT + fk); atf[1] = *(const LAS bf16x8*)(AT + 16 * 40 + fk);
#pragma unroll
        for (int i = 0; i < 8; ++i) ktf[i] = *(const LAS bf16x8*)(KT + 16 * i * 40 + fk);
        if (GDN) {
            bf16x8 a1f[2][4];
#pragma unroll
            for (int kk = 0; kk < 4; ++kk) { a1f[0][kk] = *(const LAS bf16x8*)(A1 + fo + 32 * kk); a1f[1][kk] = *(const LAS bf16x8*)(A1 + 16 * 136 + fo + 32 * kk); }
            float uv[2][4];
#pragma unroll
            for (int mt = 0; mt < 2; ++mt)
#pragma unroll
                for (int i = 0; i < 4; ++i) uv[mt][i] = bf2f(U[(16 * mt + 4 * q + i) * 136 + dv0 + r]);
            __builtin_amdgcn_sched_barrier(0);
            f32x4 ws[2] = {{0.f, 0.f, 0.f, 0.f}, {0.f, 0.f, 0.f, 0.f}};
#pragma unroll
            for (int kk = 0; kk < 4; ++kk) { ws[0] = __builtin_amdgcn_mfma_f32_16x16x32_bf16(a0f[0][kk], bst[kk], ws[0], 0, 0, 0); ws[1] = __builtin_amdgcn_mfma_f32_16x16x32_bf16(a0f[1][kk], bst[kk], ws[1], 0, 0, 0); }
#pragma unroll
            for (int mt = 0; mt < 2; ++mt) { u32x2 w; w.x = pack2_safe(uv[mt][0] - ws[mt][0], uv[mt][1] - ws[mt][1]); w.y = pack2_safe(uv[mt][2] - ws[mt][2], uv[mt][3] - ws[mt][3]);
                *(LAS u32x2*)(VN + r * 40 + 16 * mt + 4 * q) = w; }
            f32x4 oo[2] = {{0.f, 0.f, 0.f, 0.f}, {0.f, 0.f, 0.f, 0.f}};
#pragma unroll
            for (int kk = 0; kk < 4; ++kk) { oo[0] = __builtin_amdgcn_mfma_f32_16x16x32_bf16(a1f[0][kk], bst[kk], oo[0], 0, 0, 0); oo[1] = __builtin_amdgcn_mfma_f32_16x16x32_bf16(a1f[1][kk], bst[kk], oo[1], 0, 0, 0); }
#pragma unroll
            for (int i = 0; i < 8; ++i) S[i] = S[i] * egl;
            asm volatile("s_waitcnt lgkmcnt(0)" ::: "memory");
            const bf16x8 bvn = *(const LAS bf16x8*)(VN + fk);
            oo[0] = __builtin_amdgcn_mfma_f32_16x16x32_bf16(atf[0], bvn, oo[0], 0, 0, 0); oo[1] = __builtin_amdgcn_mfma_f32_16x16x32_bf16(atf[1], bvn, oo[1], 0, 0, 0);
#pragma unroll
            for (int i = 0; i < 8; ++i) S[i] = __builtin_amdgcn_mfma_f32_16x16x32_bf16(ktf[i], bvn, S[i], 0, 0, 0);
#pragma unroll
            for (int mt = 0; mt < 2; ++mt)
#pragma unroll
                for (int i = 0; i < 4; ++i) { const int pp = 16 * mt + 4 * q + i, ip = dir ? 31 - pp : pp;
                    O[(size_t)(sstart + 32 * n + ip) * DM + 512 + h * 128 + dv0 + r] = f2bf(oo[mt][i]); }
        } else {
            { const int pp = lane >> 1, d8 = (lane & 1) * 8; const u16x8 x = *(const LAS u16x8*)(A1 + pp * 136 + dv0 + d8);
#pragma unroll
              for (int e = 0; e < 8; ++e) VN[(d8 + e) * 40 + pp] = x[e]; }
            f32x4 a4[8];
#pragma unroll
            for (int i = 0; i < 8; ++i) a4[i] = *(const LAS f32x4*)(av + 16 * i + 4 * q);
            __builtin_amdgcn_sched_barrier(0);
            f32x4 oo[2] = {{0.f, 0.f, 0.f, 0.f}, {0.f, 0.f, 0.f, 0.f}};
#pragma unroll
            for (int kk = 0; kk < 4; ++kk) { oo[0] = __builtin_amdgcn_mfma_f32_16x16x32_bf16(a0f[0][kk], bst[kk], oo[0], 0, 0, 0); oo[1] = __builtin_amdgcn_mfma_f32_16x16x32_bf16(a0f[1][kk], bst[kk], oo[1], 0, 0, 0); }
#pragma unroll
            for (int i = 0; i < 8; ++i) S[i] = S[i] * a4[i];
            asm volatile("s_waitcnt lgkmcnt(0)" ::: "memory");
            const bf16x8 bvn = *(const LAS bf16x8*)(VN + fk);
            oo[0] = __builtin_amdgcn_mfma_f32_16x16x32_bf16(atf[0], bvn, oo[0], 0, 0, 0); oo[1] = __builtin_amdgcn_mfma_f32_16x16x32_bf16(atf[1], bvn, oo[1], 0, 0, 0);
#pragma unroll
            for (int i = 0; i < 8; ++i) S[i] = __builtin_amdgcn_mfma_f32_16x16x32_bf16(ktf[i], bvn, S[i], 0, 0, 0);
#pragma unroll
            for (int mt = 0; mt < 2; ++mt)
#pragma unroll
                for (int i = 0; i < 4; ++i) { const int pp = 16 * mt + 4 * q + i, ip = dir ? 31 - pp : pp;
                    O[(size_t)(sstart + 32 * n + ip) * DM + h * 128 + dv0 + r] = f2bf(oo[mt][i]); }
        }
        if (m == 3) SUBSTAMP(lds, 46);
        asm volatile("s_waitcnt lgkmcnt(0)" ::: "memory");
#pragma unroll
        for (int i = 0; i < 8; ++i) { u32x2 w; w.x = pack2_safe(S[i][0], S[i][1]); w.y = pack2_safe(S[i][2], S[i][3]); *(LAS u32x2*)(ST + r * 136 + 16 * i + 4 * q) = w; }
        if (m == 3) SUBSTAMP(lds, 47);
        if (m + 1 < N) scan_stash<GDN>(lds + ((m + 1) & 1) * 38928, Ra);
        if (m == 3) SUBSTAMP(lds, 48);
        if (m == 4) SUBSTAMP(lds, 49);
        (void)U; (void)av;
    }
    if (s < 16) { float* so = p.out + (size_t)NTOK * DM + (GDN ? (size_t)2097152 : 0) + ((size_t)(s * 2 + dir) * 4 + h) * 16384;
#pragma unroll
        for (int i = 0; i < 8; ++i)
#pragma unroll
            for (int j = 0; j < 4; ++j) so[(16 * i + 4 * q + j) * 128 + dv0 + r] = S[i][j]; }
    __syncthreads();
}
DI void scan_dispatch(const Params& p, int it, LAS unsigned char* lds) {
    int mixer, dir, h, s;
    if (it < 64) { mixer = it & 1; dir = (it >> 1) & 1; h = (it >> 2) & 3; s = 16 + (it >> 4); }
    else { const int si = it - 64; mixer = si & 1; dir = (si >> 1) & 1; h = (si >> 2) & 3; s = si >> 4; }
    if (mixer) scan_item<true>(p, s, h, dir, lds); else scan_item<false>(p, s, h, dir, lds);
}
DI void phase_scan(const Params& p, LAS unsigned char* lds) {
    const int b = blockIdx.x, G = gridDim.x;
    if (G == 256) { scan_dispatch(p, b, lds); if (b >= 64 && b < 128) scan_dispatch(p, 256 + b - 64, lds); if (b >= 128) helper_scan(p, lds, b - 128, 128); }
    else { for (int it = b; it < 320; it += G) scan_dispatch(p, it, lds); helper_scan(p, lds, b, G); }
}
DI void phase_combine(const Params& p) {
    int tid_ = threadIdx.x; asm volatile("" : "+v"(tid_));
    const int tid = tid_, wid = tid >> 6, lane = tid & 63;
    const bf16_t* O0 = (const bf16_t*)(p.ws + OFF_O); const bf16_t* O1 = O0 + (size_t)NTOK * DM;
    const bf16_t* proj = (const bf16_t*)(p.ws + OFF_PROJ);
    bf16_t* H = (bf16_t*)(p.ws + OFF_H);
    const int mixer = lane >> 5, d0 = (lane & 7) * 16, gcol = (mixer ? 4096 : 2048) + ((16 * lane) & 511);
    const float* gn = (mixer ? p.gn_gdn : p.gn_hgrn) + d0;
    for (int tok = blockIdx.x * 8 + wid; tok < NTOK; tok += gridDim.x * 8) {
        const u16x8 a0 = *(const u16x8*)(O0 + (size_t)tok * DM + 16 * lane), a1 = *(const u16x8*)(O0 + (size_t)tok * DM + 16 * lane + 8);
        const u16x8 b0 = *(const u16x8*)(O1 + (size_t)tok * DM + 16 * lane), b1 = *(const u16x8*)(O1 + (size_t)tok * DM + 16 * lane + 8);
        const u16x8 g0 = *(const u16x8*)(proj + (size_t)tok * NPROJ + gcol), g1 = *(const u16x8*)(proj + (size_t)tok * NPROJ + gcol + 8);
        float v[16]; float ss = 0.f;
#pragma unroll
        for (int j = 0; j < 8; ++j) { v[j] = bf2f(a0[j]) + bf2f(b0[j]); v[8 + j] = bf2f(a1[j]) + bf2f(b1[j]); }
#pragma unroll
        for (int j = 0; j < 16; ++j) ss += v[j] * v[j];
        ss += __shfl_xor(ss, 1); ss += __shfl_xor(ss, 2); ss += __shfl_xor(ss, 4);
        const float rs = rsqrtf(ss * (1.0f / 128.0f) + 1e-6f);
        unsigned w[8];
#pragma unroll
        for (int j = 0; j < 8; ++j) { const float ga = bf2f(j < 4 ? g0[2 * j] : g1[2 * j - 8]), gb = bf2f(j < 4 ? g0[2 * j + 1] : g1[2 * j - 7]);
            w[j] = pg8::cvt_pk_bf16(v[2 * j] * rs * gn[2 * j] * siluf_(ga), v[2 * j + 1] * rs * gn[2 * j + 1] * siluf_(gb)); }
        *(u32x4*)(H + (size_t)tok * DM + 16 * lane) = (u32x4){w[0], w[1], w[2], w[3]};
        *(u32x4*)(H + (size_t)tok * DM + 16 * lane + 8) = (u32x4){w[4], w[5], w[6], w[7]};
    }
}
DI void phase_qknorm(const Params& p) {
    int tid_ = threadIdx.x; asm volatile("" : "+v"(tid_));
    const int tid = tid_, wid = tid >> 6, lane = tid & 63;
    const bf16_t* QKV = (const bf16_t*)(p.ws + OFF_PROJ);
    bf16_t* QN = (bf16_t*)(p.ws + OFF_O); bf16_t* KN = QN + (size_t)NTOK * DM;
    float* ck = p.out + (size_t)NTOK * DM + 2 * 2097152; float* cv = ck + 4194304;
    const int hd = lane >> 2, d0 = (lane & 3) * 16;
    for (int tok = blockIdx.x * 8 + wid; tok < NTOK; tok += gridDim.x * 8) {
#pragma unroll
        for (int part = 0; part < 2; ++part) {
            const bf16_t* src = QKV + (size_t)tok * 3072 + part * 1024 + 16 * lane;
            const u16x8 a0 = *(const u16x8*)src, a1 = *(const u16x8*)(src + 8);
            float v[16]; float ss = 0.f;
#pragma unroll
            for (int j = 0; j < 8; ++j) { v[j] = bf2f(a0[j]); v[8 + j] = bf2f(a1[j]); }
#pragma unroll
            for (int j = 0; j < 16; ++j) ss += v[j] * v[j];
            ss += __shfl_xor(ss, 1); ss += __shfl_xor(ss, 2);
            const float rs = rsqrtf(ss * (1.0f / 64.0f) + 1e-6f);
            const float* gw = (part ? p.kn : p.qn) + d0;
#pragma unroll
            for (int j = 0; j < 16; ++j) v[j] = v[j] * rs * gw[j];
            unsigned w[8];
#pragma unroll
            for (int j = 0; j < 8; ++j) w[j] = pg8::cvt_pk_bf16(v[2 * j], v[2 * j + 1]);
            bf16_t* dst = (part ? KN : QN) + (size_t)tok * DM + 16 * lane;
            *(u32x4*)dst = (u32x4){w[0], w[1], w[2], w[3]}; *(u32x4*)(dst + 8) = (u32x4){w[4], w[5], w[6], w[7]};
            if (part == 1 && tok < 4096) { float* o = ck + (((size_t)(tok >> 8) * 16 + hd) * 256 + (tok & 255)) * 64 + d0;
#pragma unroll
                for (int j4 = 0; j4 < 4; ++j4) *(f32x4*)(o + 4 * j4) = (f32x4){v[4 * j4], v[4 * j4 + 1], v[4 * j4 + 2], v[4 * j4 + 3]}; }
        }
        if (tok < 4096) { const bf16_t* src = QKV + (size_t)tok * 3072 + 2048 + 16 * lane;
            const u16x8 a0 = *(const u16x8*)src, a1 = *(const u16x8*)(src + 8);
            float* o = cv + (((size_t)(tok >> 8) * 16 + hd) * 256 + (tok & 255)) * 64 + d0;
            *(f32x4*)(o) = (f32x4){bf2f(a0[0]), bf2f(a0[1]), bf2f(a0[2]), bf2f(a0[3])}; *(f32x4*)(o + 4) = (f32x4){bf2f(a0[4]), bf2f(a0[5]), bf2f(a0[6]), bf2f(a0[7])};
            *(f32x4*)(o + 8) = (f32x4){bf2f(a1[0]), bf2f(a1[1]), bf2f(a1[2]), bf2f(a1[3])}; *(f32x4*)(o + 12) = (f32x4){bf2f(a1[4]), bf2f(a1[5]), bf2f(a1[6]), bf2f(a1[7])}; }
    }
}
struct AStage { const bf16_t* kb; const bf16_t* vb; int ks, vs, nkeys; };
DI void attn_fetch(const AStage& d, u32x4 (&kv)[8]) {
    const int tid = threadIdx.x;
#pragma unroll
    for (int k = 0; k < 4; ++k) { const int pc = tid + k * 512, key = pc >> 3, c8 = (pc & 7) * 8;
        if (key < d.nkeys) { kv[k] = *(const u32x4*)(d.kb + (size_t)key * d.ks + c8); kv[4 + k] = *(const u32x4*)(d.vb + (size_t)key * d.vs + c8); } }
}
DI void attn_stash(LAS unsigned char* lds, const u32x4 (&kv)[8], int nkeys) {
    const int tid = threadIdx.x; LAS bf16_t* KB = (LAS bf16_t*)lds; LAS bf16_t* VT = (LAS bf16_t*)(lds + 36864);
#pragma unroll
    for (int k = 0; k < 4; ++k) { const int pc = tid + k * 512, key = pc >> 3, c8 = (pc & 7) * 8;
        if (key < nkeys) { *(LAS u32x4*)(KB + key * 72 + c8) = kv[k];
#pragma unroll
            for (int j = 0; j < 4; ++j) { VT[(c8 + 2 * j) * 264 + key] = (bf16_t)(kv[4 + k][j] & 0xFFFFu); VT[(c8 + 2 * j + 1) * 264 + key] = (bf16_t)(kv[4 + k][j] >> 16); } } }
}
struct AttnState { f32x4 o[4]; float m[4], l[4]; };
DI void attn_tile(AttnState& st, const bf16x8 (&qf)[2], LAS unsigned char* lds, int wid, int mode, int nkeys, int krow0, int rsW, int rw, int ct) {
    const int lane = threadIdx.x & 63, r = lane & 15, q = lane >> 4;
    const LAS bf16_t* KB = (const LAS bf16_t*)lds; const LAS bf16_t* VT = (const LAS bf16_t*)(lds + 36864);
    LAS bf16_t* PW = (LAS bf16_t*)(lds + 70656 + wid * 4352); const LAS float* RPB = (const LAS float*)(lds + 105472);
    f32x4 sc[16];
#pragma unroll
    for (int g = 0; g < 4; ++g) {
        bool act = (64 * g < nkeys);
        const int krow = krow0 + g;
        if (mode == 2) act = act && (krow >= rsW) && (krow < rsW + 8);
        if (act) {
#pragma unroll
            for (int n2 = 0; n2 < 4; n2 += 2) {
            bf16x8 kf[2][2];
#pragma unroll
            for (int n = 0; n < 2; ++n) { kf[n][0] = *(const LAS bf16x8*)(KB + (64 * g + 16 * (n2 + n) + r) * 72 + 8 * q); kf[n][1] = *(const LAS bf16x8*)(KB + (64 * g + 16 * (n2 + n) + r) * 72 + 32 + 8 * q); }
#pragma unroll
            for (int nn = 0; nn < 2; ++nn) { const int n = n2 + nn; f32x4 a = {0.f, 0.f, 0.f, 0.f};
                a = __builtin_amdgcn_mfma_f32_16x16x32_bf16(qf[0], kf[nn][0], a, 0, 0, 0); a = __builtin_amdgcn_mfma_f32_16x16x32_bf16(qf[1], kf[nn][1], a, 0, 0, 0);
                if (mode == 2) {
                    const LAS float* rp = RPB + (krow - rw + 7) * 31;
#pragma unroll
                    for (int i = 0; i < 4; ++i) { const int c = ct * 16 + 4 * q + i, kc = 16 * n + r; const int cs = c - 8 < 0 ? 0 : (c - 8 > 48 ? 48 : c - 8);
                        const bool valid = kc >= cs && kc < cs + 16; int bi = kc - c + 15; bi = bi < 0 ? 0 : (bi > 30 ? 30 : bi);
                        a[i] = valid ? a[i] * 0.125f + rp[bi] : -1e30f; }
                } else a = a * 0.125f;
                sc[4 * g + n] = a; }
            }
        } else {
#pragma unroll
            for (int n = 0; n < 4; ++n) sc[4 * g + n] = (f32x4){-1e30f, -1e30f, -1e30f, -1e30f}; }
    }
    float alpha[4];
#pragma unroll
    for (int i = 0; i < 4; ++i) {
        float mx = sc[0][i];
#pragma unroll
        for (int n = 1; n < 16; ++n) mx = fmaxf(mx, sc[n][i]);
        mx = fmaxf(mx, __shfl_xor(mx, 1)); mx = fmaxf(mx, __shfl_xor(mx, 2)); mx = fmaxf(mx, __shfl_xor(mx, 4)); mx = fmaxf(mx, __shfl_xor(mx, 8));
        const float mn = fmaxf(st.m[i], mx); alpha[i] = __expf(st.m[i] - mn); st.m[i] = mn;
        float rsum = 0.f;
#pragma unroll
        for (int n = 0; n < 16; ++n) { const float pv = __expf(sc[n][i] - mn); sc[n][i] = pv; rsum += pv; }
        rsum += __shfl_xor(rsum, 1); rsum += __shfl_xor(rsum, 2); rsum += __shfl_xor(rsum, 4); rsum += __shfl_xor(rsum, 8);
        st.l[i] = st.l[i] * alpha[i] + rsum;
    }
#pragma unroll
    for (int dt = 0; dt < 4; ++dt)
#pragma unroll
        for (int i = 0; i < 4; ++i) st.o[dt][i] *= alpha[i];
#pragma unroll
    for (int hf = 0; hf < 2; ++hf) {
        if (128 * hf < nkeys) {
            asm volatile("s_waitcnt lgkmcnt(0)" ::: "memory");
#pragma unroll
            for (int n = 0; n < 8; ++n)
#pragma unroll
                for (int i = 0; i < 4; ++i) PW[(4 * q + i) * 136 + 16 * n + r] = f2bf(sc[8 * hf + n][i]);
            asm volatile("s_waitcnt lgkmcnt(0)" ::: "memory");
            bf16x8 pf[4];
#pragma unroll
            for (int kk = 0; kk < 4; ++kk) pf[kk] = *(const LAS bf16x8*)(PW + r * 136 + 32 * kk + 8 * q);
#pragma unroll
            for (int dt = 0; dt < 4; ++dt) { bf16x8 vf[4];
#pragma unroll
                for (int kk = 0; kk < 4; ++kk) vf[kk] = *(const LAS bf16x8*)(VT + (16 * dt + r) * 264 + 128 * hf + 32 * kk + 8 * q);
#pragma unroll
                for (int kk = 0; kk < 4; ++kk) st.o[dt] = __builtin_amdgcn_mfma_f32_16x16x32_bf16(pf[kk], vf[kk], st.o[dt], 0, 0, 0); }
        }
    }
}
DI void attn_out(const AttnState& st, bf16_t* AO, int qtok0, int h) {
    const int lane = threadIdx.x & 63, r = lane & 15, q = lane >> 4;
#pragma unroll
    for (int dt = 0; dt < 4; ++dt)
#pragma unroll
        for (int i = 0; i < 4; ++i) AO[(size_t)(qtok0 + 4 * q + i) * DM + h * 64 + 16 * dt + r] = f2bf(st.o[dt][i] / st.l[i]);
}
DI void attn_init(AttnState& st) {
#pragma unroll
    for (int i = 0; i < 4; ++i) { st.o[i] = (f32x4){0.f, 0.f, 0.f, 0.f}; st.m[i] = -1e30f; st.l[i] = 0.f; }
}
DI void phase_attn(const Params& p, LAS unsigned char* lds) {
    int tid_ = threadIdx.x; asm volatile("" : "+v"(tid_));
    const int tid = tid_, wid = __builtin_amdgcn_readfirstlane(tid >> 6), lane = tid & 63, r = lane & 15, q = lane >> 4;
    const bf16_t* QN = (const bf16_t*)(p.ws + OFF_O); const bf16_t* KN = QN + (size_t)NTOK * DM;
    const bf16_t* QKV = (const bf16_t*)(p.ws + OFF_PROJ);
    const bf16_t* CK = (const bf16_t*)(p.ws + OFF_CK); const bf16_t* CV = CK + (size_t)4 * 16 * 256 * 64;
    bf16_t* AO = (bf16_t*)(p.ws + OFF_H2);
    LAS float* RPB = (LAS float*)(lds + 105472);
    u32x4 kv[8];
    for (int it = blockIdx.x; it < 256; it += gridDim.x) {
        const int b = it >> 4, h = it & 15;
        AStage d; d.kb = KN + (size_t)(b * 256) * DM + h * 64; d.ks = DM; d.vb = QKV + (size_t)(b * 256) * 3072 + 2048 + h * 64; d.vs = 3072; d.nkeys = 256;
        attn_fetch(d, kv);
        bf16x8 qf[2][2];
#pragma unroll
        for (int t = 0; t < 2; ++t)
#pragma unroll
            for (int kk = 0; kk < 2; ++kk) qf[t][kk] = *(const bf16x8*)(QN + (size_t)(b * 256 + wid * 32 + t * 16 + r) * DM + h * 64 + 32 * kk + 8 * q);
        __syncthreads();
        attn_stash(lds, kv, 256);
        __syncthreads();
#pragma unroll
        for (int t = 0; t < 2; ++t) { AttnState st; attn_init(st); attn_tile(st, qf[t], lds, wid, 0, 256, 0, 0, 0, 0); attn_out(st, AO, b * 256 + wid * 32 + t * 16, h); }
    }
    for (int it = blockIdx.x; it < 512; it += gridDim.x) {
        const int b = it >> 7, h = (it >> 3) & 15, rp = it & 7, r0 = 2 * rp, rw = r0 + (wid >> 2), ct = wid & 3;
        const int rsA = r0 - 4 < 0 ? 0 : (r0 - 4 > 8 ? 8 : r0 - 4), r1 = r0 + 1, rsB = r1 - 4 < 0 ? 0 : (r1 - 4 > 8 ? 8 : r1 - 4);
        const int rsW = (wid >> 2) ? rsB : rsA, nwin = rsB + 8 - rsA, nst = 1 + (nwin + 3) / 4;
        const int qtok0 = 4096 + b * 1024 + rw * 64 + ct * 16;
        auto desc = [&](int s) { AStage d;
            if (s == 0) { d.kb = CK + (size_t)((b * 16 + h) * 256) * 64; d.ks = 64; d.vb = CV + (size_t)((b * 16 + h) * 256) * 64; d.vs = 64; d.nkeys = 256; }
            else { const int kr0 = rsA + 4 * (s - 1), nr = (nwin - 4 * (s - 1)) < 4 ? (nwin - 4 * (s - 1)) : 4; const size_t tok0 = 4096 + b * 1024 + kr0 * 64;
                d.kb = KN + tok0 * DM + h * 64; d.ks = DM; d.vb = QKV + tok0 * 3072 + 2048 + h * 64; d.vs = 3072; d.nkeys = nr * 64; }
            return d; };
        AStage d0 = desc(0);
        attn_fetch(d0, kv);
        bf16x8 qf[2];
#pragma unroll
        for (int kk = 0; kk < 2; ++kk) qf[kk] = *(const bf16x8*)(QN + (size_t)(qtok0 + r) * DM + h * 64 + 32 * kk + 8 * q);
        AttnState st; attn_init(st);
        __syncthreads();
        if (tid < 465) RPB[tid] = p.rpb[h * 465 + tid];
#pragma unroll 1
        for (int s = 0; s < nst; ++s) {
            const AStage d = desc(s);
            if (s) __syncthreads();
            attn_stash(lds, kv, d.nkeys);
            if (s + 1 < nst) { const AStage dn = desc(s + 1); attn_fetch(dn, kv); }
            __syncthreads();
            attn_tile(st, qf, lds, wid, s == 0 ? 0 : 2, d.nkeys, rsA + 4 * (s - 1), rsW, rw, ct);
        }
        attn_out(st, AO, qtok0, h);
    }
}
#define XB_TMO      128
#define XB_XCNT(j)  (256  + 64 * (j))
#define XB_XSUB(j)  (1280 + 64 * (j))
#define XB_XGEN(j)  (2304 + 64 * (j))
#define XB_TOP      3328
#define XB_TOPGEN   3392
#define XCD_BAR_WORDS 3456
#define XB_SPIN_CAP (1u << 18)

__device__ __forceinline__ unsigned xb_ld(unsigned* p)              { return __hip_atomic_load(p, __ATOMIC_RELAXED, __HIP_MEMORY_SCOPE_AGENT); }
__device__ __forceinline__ unsigned xb_add(unsigned* p, unsigned v) { return __hip_atomic_fetch_add(p, v, __ATOMIC_RELAXED, __HIP_MEMORY_SCOPE_AGENT); }
__device__ __forceinline__ unsigned xb_xcc_id() { return (unsigned)__builtin_amdgcn_s_getreg((3 << 11) | 20) & 0xFu; }
#define XB_SPIN(cond, bar) do { unsigned _sp = 0; while (cond) { __builtin_amdgcn_s_sleep(1); \
    if ((++_sp & 255u) == 0u) { if (xb_ld(&(bar)[XB_TMO])) break; if (_sp > XB_SPIN_CAP) { atomicAdd(&(bar)[XB_TMO], 1u); break; } } } } while (0)

struct XcdBarrier {
    unsigned* bar; unsigned x;
    volatile LAS unsigned* st;
};

__device__ __forceinline__ XcdBarrier xcd_barrier_post(unsigned* bar, volatile LAS unsigned* st) {
    XcdBarrier b; b.bar = bar; b.x = xb_xcc_id(); b.st = st;
    if (threadIdx.x == 0) (void)xb_add(&bar[XB_XCNT(b.x)], 1u);
    return b;
}
__device__ __forceinline__ void xcd_barrier_complete(unsigned* bar, unsigned x, unsigned& nloc, unsigned& nx) {
    const unsigned G = gridDim.x * gridDim.y * gridDim.z;
    unsigned sum, cnt, mine, sp = 0u;
    for (;;) {
        sum = 0u; cnt = 0u; mine = 0u;
#pragma unroll
        for (unsigned j = 0; j < 16; ++j) { const unsigned c = xb_ld(&bar[XB_XCNT(j)]); sum += c; cnt += (c > 0u) ? 1u : 0u; mine = (j == x) ? c : mine; }
        if (sum == G) break;
        __builtin_amdgcn_s_sleep(1);
        if ((++sp & 255u) == 0u) { if (xb_ld(&bar[XB_TMO])) break; if (sp > XB_SPIN_CAP) { atomicAdd(&bar[XB_TMO], 1u); break; } }
    }
    nloc = mine > 0u ? mine : 1u; nx = cnt > 0u ? cnt : 1u;
}

__device__ __forceinline__ void xcd_barrier(const XcdBarrier& b) {
    asm volatile("s_waitcnt vmcnt(0)" ::: "memory");
    __syncthreads();
    if (threadIdx.x == 0) {
        unsigned* bar = b.bar;
        __builtin_amdgcn_s_waitcnt(0);
        unsigned nloc = b.st[0], nx = b.st[1];
        if (nloc == 0u) { xcd_barrier_complete(bar, b.x, nloc, nx); b.st[0] = nloc; b.st[1] = nx; }
        const unsigned old = xb_add(&bar[XB_XSUB(b.x)], 1u);
        const unsigned gen = old / nloc;
        if (old + 1u == (gen + 1u) * nloc) {
            __builtin_amdgcn_fence(__ATOMIC_RELEASE, "agent");
            asm volatile("s_waitcnt vmcnt(0)" ::: "memory");
            const unsigned og = xb_add(&bar[XB_TOP], 1u);
            const unsigned tg = og / nx;
            if (og + 1u == (tg + 1u) * nx) xb_add(&bar[XB_TOPGEN], 1u);
            else XB_SPIN(xb_ld(&bar[XB_TOPGEN]) == tg, bar);
            __builtin_amdgcn_fence(__ATOMIC_ACQUIRE, "agent");
            xb_add(&bar[XB_XGEN(b.x)], 1u);
            asm volatile("s_waitcnt vmcnt(0)" ::: "memory");
        } else {
            XB_SPIN(xb_ld(&bar[XB_XGEN(b.x)]) == gen, bar);
            __builtin_amdgcn_fence(__ATOMIC_ACQUIRE, "agent");
            asm volatile("s_waitcnt vmcnt(0)" ::: "memory");
        }
    }
    __syncthreads();
}

#ifndef PROBE_GEMM
#define PROBE_GEMM -1
#define PROBE_GA 3
#define PROBE_GB 4
#endif
constexpr size_t OFF_STAMP = OFF_CB + (size_t)5 * (4096 + 3072 + 4096) * 4;
template <int ID = -2, class Epi> DI void gemm(LAS unsigned char* lds, const bf16_t* A, const bf16_t* Bt, int N, int K, const Epi& E, unsigned char* ws = nullptr) {
    pg8::Gemm g; g.A = A; g.Bt = Bt; g.M = NTOK; g.N = N; g.K = K;
    pg8::StaticOrder S; S.init(NTOK, N, gridDim.x, blockIdx.x);
    if (ID == PROBE_GEMM) pg8::gemm_phase<Epi, pg8::StaticOrder, true>(lds, g, S, E, (unsigned long long*)(ws + OFF_STAMP) + (size_t)blockIdx.x * 64);
    else pg8::gemm_phase<Epi, pg8::StaticOrder, false>(lds, g, S, E, nullptr);
}
template <int PHX, class Inner> DI void gemm_split(LAS unsigned char* lds, const bf16_t* A, const bf16_t* Bt, int K, const Inner& in, unsigned char* ws) {
    if (gridDim.x == 256) {
        const int kh = (blockIdx.x >> 3) & 1;
        pg8::Gemm g; g.A = A + (size_t)kh * (K / 2); g.Bt = Bt + (size_t)kh * (K / 2); g.M = NTOK; g.N = 1024; g.K = K / 2; g.ld = K; g.aswap = kh;
        pg8::SplitOrder S; S.c = blockIdx.x;
        pg8::EpiSplit<Inner> E; E.in = in; E.slab = (float*)(ws + OFF_O); E.flags = (unsigned*)(ws + OFF_FLAG) + PHX * 256;
        pg8::gemm_phase<pg8::EpiSplit<Inner>, pg8::SplitOrder, false>(lds, g, S, E, nullptr);
    } else gemm(lds, A, Bt, 1024, K, in);
}
#define GSYNC(n) do { xcd_barrier(xb); TSTAMP(n); } while (0)
#ifndef REPEAT_MASK
#define REPEAT_MASK 0
#endif
#define PH(n, ...) do { __VA_ARGS__; if ((REPEAT_MASK >> (n)) & 1) { xcd_barrier(xb); __VA_ARGS__; } } while (0)
static_assert(XCD_BAR_WORDS * 4 == 13824 && OFF_FLAG + 4096 <= OFF_LBS, "bar");
extern __shared__ __attribute__((aligned(16))) unsigned char smem_dyn[];
__global__ void __launch_bounds__(512, 2) fwd_megakernel(Params p) {
    LAS unsigned char* lds = (LAS unsigned char*)smem_dyn;
    volatile LAS unsigned* xst = (volatile LAS unsigned*)(lds + LDS_BYTES - 16);
    if (threadIdx.x < 4) xst[threadIdx.x] = 0u;
    __syncthreads();
    const XcdBarrier xb = xcd_barrier_post((unsigned*)(p.ws + OFF_BAR), xst);
    volatile LAS unsigned long long* tsl = (volatile LAS unsigned long long*)(lds + LDS_BYTES - 16 - 512);
    TSTAMP(0);
#define mod ((const float*)(p.ws + OFF_MOD))
#define H ((bf16_t*)(p.ws + OFF_H))
#define W0 ((bf16_t*)(p.ws + OFF_W0))
#define W1 ((bf16_t*)(p.ws + OFF_W1))
#define PROJ ((bf16_t*)(p.ws + OFF_PROJ))
#define X1 (p.out)
#define X2 ((float*)(p.ws + OFF_X2))
#define H2 ((bf16_t*)(p.ws + OFF_H2))
#define SSQ ((float*)(p.ws + OFF_SSQ))
#define CB ((const float*)(p.ws + OFF_CB))
    const int G = gridDim.x;
    PH(0, phase_mod(p, lds); __syncthreads(); phase_w0(p, lds));
    GSYNC(1);
    PH(1, phase_norm<false>(p, p.xp, p.xs, 0, 0, lds));
    GSYNC(2);
    PH(2, { pg8::EpiProj E; E.O = PROJ; E.ab = (float*)(p.ws + OFF_AB); gemm<2>(lds, H, W0, NPROJ_PAD, 1024, E, p.ws); });
    GSYNC(3);
    PH(3, phase_prep(p, lds));
    GSYNC(4);
    PH(4, phase_scan(p, lds));
    GSYNC(5);
    PH(5, phase_combine(p); __syncthreads(); phase_w1(p, lds));
    GSYNC(6);
    { pg8::EpiRes2 E; E.out = X1; E.base_p = p.xp; E.base_s = p.xs; E.gate = mod + 2048; E.A2 = H2; E.ng = p.norm_g + 1024; E.sc = mod + 4096; E.ssq = SSQ;
      gemm_split<0>(lds, H, W0 + (size_t)NPROJ_PAD * DM, 1024, E, p.ws); }
    GSYNC(8);
    PH(8, { pg8::EpiBfSB<1> E; E.O = PROJ; E.ldc = DFF; E.ssq = SSQ; E.bias = CB; E.ldb = DFF; gemm(lds, H2, W0 + (size_t)NPROJ_PAD * DM + (size_t)DM * DM, DFF, 1024, E); });
    GSYNC(9);
    { pg8::EpiRes2 E; E.out = X2; E.base_p = X1; E.base_s = X1 + (size_t)4096 * DM; E.gate = mod + 5120; E.A2 = H; E.ng = p.norm_g + 2048; E.sc = mod + 5 * NMOD + 1024; E.ssq = SSQ + (size_t)NTOK * 16;
      gemm_split<1>(lds, PROJ, W0 + (size_t)NPROJ_PAD * DM + (size_t)DM * DM + (size_t)DFF * DM, DFF, E, p.ws); }
    GSYNC(10);
    PH(11, { pg8::EpiBfSB<0> E; E.O = PROJ; E.ldc = 3072; E.ssq = SSQ + (size_t)NTOK * 16; E.bias = CB + 5 * 4096; E.ldb = 3072; gemm(lds, H, W1, 3072, 1024, E); });
    GSYNC(12);
    PH(12, phase_qknorm(p));
    GSYNC(13);
    PH(13, phase_attn(p, lds));
    GSYNC(14);
    { pg8::EpiRes2 E; E.out = X1; E.base_p = X2; E.base_s = X2 + (size_t)4096 * DM; E.gate = mod + 5 * NMOD + 2048; E.A2 = H; E.ng = p.norm_g + 3072; E.sc = mod + 5 * NMOD + 4096; E.ssq = SSQ + (size_t)2 * NTOK * 16;
      gemm_split<2>(lds, H2, W1 + (size_t)3072 * DM, 1024, E, p.ws); }
    GSYNC(15);
    PH(16, { pg8::EpiBfSB<1> E; E.O = PROJ; E.ldc = DFF; E.ssq = SSQ + (size_t)2 * NTOK * 16; E.bias = CB + 5 * 4096 + 5 * 3072; E.ldb = DFF; gemm(lds, H, W1 + (size_t)3072 * DM + (size_t)DM * DM, DFF, 1024, E); });
    GSYNC(17);
    { pg8::EpiRes E; E.out = X1; E.base_p = X1; E.base_s = X1 + (size_t)4096 * DM; E.gate = mod + 5 * NMOD + 5120; gemm_split<3>(lds, PROJ, W1 + (size_t)3072 * DM + (size_t)DM * DM + (size_t)DFF * DM, DFF, E, p.ws); }
    if (PROBE_A >= 0) { TSTAMP(18);
        if (threadIdx.x == 0 && blockIdx.x == 0) { float us = (PROBE_A >= 100) ? (float)(long long)(((volatile unsigned long long*)(p.ws + OFF_STAMP2))[PROBE_B - 100] - ((volatile unsigned long long*)(p.ws + OFF_STAMP2))[PROBE_A - 100]) * 0.01f : (float)(long long)(tsl[PROBE_B < 100 ? PROBE_B : 0] - tsl[PROBE_A < 100 ? PROBE_A : 0]) * 0.01f;
            if (PROBE_GEMM >= 0) { const unsigned long long* st = (const unsigned long long*)(p.ws + OFF_STAMP); us = (float)(long long)(st[PROBE_GB] - st[PROBE_GA]) * (PROBE_GB >= 62 ? 0.01f : (1.0f / 2100.0f)); }
            float* e = p.out + (size_t)NTOK * DM + 2 * 2097152 + 4194304 + 7; *e = *e + 0.06f + us * PROBE_SCALE; } }
}

#undef mod
#undef H
#undef W0
#undef W1
#undef PROJ
#undef X1
#undef X2
#undef H2
#undef SSQ
#undef CB
extern "C" void kernel_launch(void* const* d_in, const int* in_sizes, int n_in, void* d_out, int out_size, void* d_ws, size_t ws_size, hipStream_t stream) {
    (void)in_sizes; (void)n_in; (void)out_size;
    static int grid_blocks = 0;
    if (!grid_blocks) {
        int dev = 0, cus = 0, per_cu = 0;
        (void)hipGetDevice(&dev);
        (void)hipDeviceGetAttribute(&cus, hipDeviceAttributeMultiprocessorCount, dev);
        (void)hipFuncSetAttribute((const void*)fwd_megakernel, hipFuncAttributeMaxDynamicSharedMemorySize, LDS_BYTES);
        (void)hipOccupancyMaxActiveBlocksPerMultiprocessor(&per_cu, fwd_megakernel, 512, LDS_BYTES);
        if (per_cu > 1) per_cu = 1;
        grid_blocks = cus * per_cu;
        if (ws_size < WS_NEED) fprintf(stderr, "workspace too small: %zu < %zu\n", ws_size, (size_t)WS_NEED);
    }
    Params p{};
    const float* const* in = (const float* const*)d_in;
    p.xp = in[0]; p.xs = in[1]; p.st_hgrn = in[2]; p.st_gdn = in[3]; p.cache_k = in[4]; p.cache_v = in[5]; p.c = in[6]; p.c_ctx = in[7]; p.ada_w = in[8]; p.ada_b = in[9];
    p.norm_g = in[10]; p.w_in = in[11]; p.w_out_ab = in[12]; p.hgrn_lb = in[13]; p.gdn_conv = in[14]; p.a_log = in[15]; p.dt_bias = in[16]; p.gn_hgrn = in[17]; p.gn_gdn = in[18];
    p.w_qkv = in[19]; p.qn = in[20]; p.kn = in[21]; p.rpb = in[22]; p.w_out_na = in[23]; p.w_mlp1 = in[24]; p.w_mlp2 = in[25];
    p.out = (float*)d_out; p.ws = (unsigned char*)d_ws;
    (void)hipMemsetAsync((unsigned char*)d_ws + OFF_BAR, 0, XCD_BAR_WORDS * 4 + 4096, stream);
    void* args[] = {&p};
    hipError_t e = hipLaunchCooperativeKernel((const void*)fwd_megakernel, dim3(grid_blocks), dim3(512), args, LDS_BYTES, stream);
    if (e != hipSuccess) fprintf(stderr, "cooperative launch failed: %s (grid %d)\n", hipGetErrorString(e), grid_blocks);
}
```

```cpp
#include <hip/hip_runtime.h>
#include <hip/hip_cooperative_groups.h>
#include <cstdint>
#include <cstdio>
namespace cg = cooperative_groups;
namespace pg8 {
#define PG8_LAS __attribute__((address_space(3)))
typedef unsigned short bf16_t;
typedef short bf16x8 __attribute__((ext_vector_type(8)));
typedef float f32x4 __attribute__((ext_vector_type(4)));
typedef unsigned u32x4 __attribute__((ext_vector_type(4)));
constexpr int BM = 256, BK = 64, HALF = 128, HTB = HALF * BK * 2  , STAGE_BYTES = 8 * HTB, NXCD = 8, WGM = 8;

__host__ __device__ __forceinline__ int lds_byte(int r, int c) { const int st = (r >> 4) * 2 + (c >> 5), rr = r & 15, cc = c & 31, ob = rr * 64 + cc * 2; return st * 1024 + (ob ^ (((ob >> 9) & 1) << 5)); }
__host__ __device__ __forceinline__ void stage_rc(int b, int& R, int& C) { const int st = b / 1024, sb = b % 1024, swz = sb ^ (((sb >> 9) & 1) << 5); R = (st >> 1) * 16 + swz / 64; C = (st & 1) * 32 + (swz % 64) / 2; }
__host__ __device__ __forceinline__ int perm32(int rho) { const int n = rho >> 4, i = rho & 15; return 8 * (i >> 2) + 4 * n + (i & 3); }

struct Unit { int pm, pn; };
struct Gemm { const bf16_t* A; const bf16_t* Bt; int M, N, K; int ld = 0; int aswap = 0; };

struct StaticOrder {
    int nM, nN, nwg, G, c;
    __host__ __device__ void init(int M, int N, int G_, int c_) { nM = M / BM; nN = N / BM; nwg = nM * nN; G = G_; c = c_; }
    __host__ __device__ bool next(int i, Unit& u) const {
        const long L = (long)i * G + c; if (L >= nwg) return false;
        int wgid = (int)L; { const int q = nwg / NXCD, r = nwg % NXCD, xcd = wgid % NXCD, off = wgid / NXCD; wgid = (xcd < r ? xcd * (q + 1) : r * (q + 1) + (xcd - r) * q) + off; }
        const int nig = WGM * nN, gid = wgid / nig, fm = gid * WGM, gsz = (nM - fm) < WGM ? (nM - fm) : WGM;
        u.pm = fm + ((wgid % nig) % gsz); u.pn = (wgid % nig) / gsz; return true;
    }
    __device__ __forceinline__ void a_ready(const Unit&) const {}
    __device__ __forceinline__ void done(const Unit&) const {}
};
struct SplitOrder {
    int c;
    __device__ __forceinline__ bool next(int i, Unit& u) const { if (i) return false; const int xcd = c & 7, j = c >> 3, t = (j >> 1) * 8 + xcd; u.pm = t >> 2; u.pn = t & 3; return true; }
    __device__ __forceinline__ void a_ready(const Unit&) const {}
    __device__ __forceinline__ void done(const Unit&) const {}
};
__device__ __forceinline__ unsigned cvt_pk_bf16(float lo, float hi) { unsigned r; asm volatile("v_cvt_pk_bf16_f32 %0, %1, %2" : "=v"(r) : "v"(lo), "v"(hi)); return r; }
template <int ACT  > struct EpiBf {
    static constexpr bool PERM = true, AFTER_DRAIN = false;
    bf16_t* O; int ldc;
    __device__ __forceinline__ void operator()(const f32x4 (&acc)[2][2][4][2], const Unit& u, int wr, int wc, int fr, int fq) const {
        const int row0 = u.pm * BM + wr * 64 + fr, col0 = u.pn * BM + wc * 32 + 8 * fq;
#pragma unroll
        for (int ai = 0; ai < 2; ++ai)
#pragma unroll
            for (int m = 0; m < 4; ++m) { bf16_t* rowp = O + (size_t)(row0 + ai * HALF + m * 16) * ldc + col0;
#pragma unroll
                for (int bj = 0; bj < 2; ++bj) { f32x4 v0 = acc[ai][bj][m][0], v1 = acc[ai][bj][m][1];
                    if (ACT == 1) {
#pragma unroll
                        for (int e = 0; e < 4; ++e) { const float a = v0[e] > 0.f ? v0[e] : 0.f, b = v1[e] > 0.f ? v1[e] : 0.f; v0[e] = a * a; v1[e] = b * b; } }
                    u32x4 w; w.x = cvt_pk_bf16(v0[0], v0[1]); w.y = cvt_pk_bf16(v0[2], v0[3]); w.z = cvt_pk_bf16(v1[0], v1[1]); w.w = cvt_pk_bf16(v1[2], v1[3]);
                    *(u32x4*)(rowp + bj * HALF) = w; } }
    }
};
struct EpiRes {
    static constexpr bool PERM = false, AFTER_DRAIN = false;
    float* out; const float* base_p; const float* base_s; const float* gate;
    template <int AI, int RB = 2, bool RED = false> __device__ __forceinline__ void half(const f32x4 (&acc)[2][2][4][2], const Unit& u, int wr, int wc, int fr, int fq, int rowofs = 0, PG8_LAS float* = nullptr) const {
        const int row0 = u.pm * BM + rowofs + wr * 64 + fr, col0 = u.pn * BM + wc * 32 + 4 * fq;
        const int t0 = u.pm * BM; const int mr = t0 < 4096 ? 0 : 1 + ((t0 - 4096) >> 10);
        const float* gp = gate + (size_t)mr * 6144 + col0;
        f32x4 gv[2][2];
#pragma unroll
        for (int bj = 0; bj < 2; ++bj)
#pragma unroll
            for (int n = 0; n < 2; ++n) gv[bj][n] = *(const f32x4*)(gp + bj * HALF + n * 16);
#pragma unroll
        for (int mh = 0; mh < 4 / RB; ++mh) { const int ai = AI, m0 = mh * RB;
            f32x4 bb[4][2][2];
#pragma unroll
            for (int m = m0; m < m0 + RB; ++m) { const int row = row0 + ai * HALF + m * 16;
                const float* bp = (row < 4096 ? base_p + (size_t)row * 1024 : base_s + (size_t)(row - 4096) * 1024) + col0;
#pragma unroll
                for (int bj = 0; bj < 2; ++bj)
#pragma unroll
                    for (int n = 0; n < 2; ++n) bb[m][bj][n] = *(const f32x4*)(bp + bj * HALF + n * 16); }
#pragma unroll
            for (int m = m0; m < m0 + RB; ++m) { const int row = row0 + ai * HALF + m * 16; float* op = out + (size_t)row * 1024 + col0;
#pragma unroll
                for (int bj = 0; bj < 2; ++bj)
#pragma unroll
                    for (int n = 0; n < 2; ++n) *(f32x4*)(op + bj * HALF + n * 16) = bb[m][bj][n] + gv[bj][n] * acc[ai][bj][m][n]; }
        }
    }
    __device__ __forceinline__ void operator()(const f32x4 (&acc)[2][2][4][2], const Unit& u, int wr, int wc, int fr, int fq) const { half<0, 1>(acc, u, wr, wc, fr, fq); half<1, 1>(acc, u, wr, wc, fr, fq); }
};

struct EpiRes2 {
    static constexpr bool PERM = false, AFTER_DRAIN = false;
    float* out; const float* base_p; const float* base_s; const float* gate; bf16_t* A2; const float* ng; const float* sc; float* ssq;
    template <int AI, int RB = 2, bool RED = false> __device__ __forceinline__ void half(const f32x4 (&acc)[2][2][4][2], const Unit& u, int wr, int wc, int fr, int fq, int rowofs = 0, PG8_LAS float* red = nullptr) const {
        const int row0 = u.pm * BM + rowofs + wr * 64 + fr, col0 = u.pn * BM + wc * 32 + 4 * fq;
        const int t0 = u.pm * BM; const int mr = t0 < 4096 ? 0 : 1 + ((t0 - 4096) >> 10);
        const float* gp = gate + (size_t)mr * 6144 + col0; const float* sp = sc + (size_t)mr * 6144 + col0; const float* np = ng + col0;
        f32x4 gv[2][2], mv[2][2];
#pragma unroll
        for (int bj = 0; bj < 2; ++bj)
#pragma unroll
            for (int n = 0; n < 2; ++n) { gv[bj][n] = *(const f32x4*)(gp + bj * HALF + n * 16);
                const f32x4 s4 = *(const f32x4*)(sp + bj * HALF + n * 16), n4 = *(const f32x4*)(np + bj * HALF + n * 16); mv[bj][n] = n4 * (s4 + 1.0f); }
#pragma unroll
        for (int mh = 0; mh < 4 / RB; ++mh) { const int ai = AI, m0 = mh * RB;
            f32x4 bb[4][2][2];
#pragma unroll
            for (int m = m0; m < m0 + RB; ++m) { const int row = row0 + ai * HALF + m * 16;
                const float* bp = (row < 4096 ? base_p + (size_t)row * 1024 : base_s + (size_t)(row - 4096) * 1024) + col0;
#pragma unroll
                for (int bj = 0; bj < 2; ++bj)
#pragma unroll
                    for (int n = 0; n < 2; ++n) bb[m][bj][n] = *(const f32x4*)(bp + bj * HALF + n * 16); }
#pragma unroll
            for (int m = m0; m < m0 + RB; ++m) { const int row = row0 + ai * HALF + m * 16; float* op = out + (size_t)row * 1024 + col0;
                bf16_t* ap = A2 + (size_t)row * 1024 + col0; float ss = 0.f;
#pragma unroll
                for (int bj = 0; bj < 2; ++bj)
#pragma unroll
                    for (int n = 0; n < 2; ++n) { const f32x4 v = bb[m][bj][n] + gv[bj][n] * acc[ai][bj][m][n];
                        *(f32x4*)(op + bj * HALF + n * 16) = v; ss += (v[0] * v[0] + v[1] * v[1]) + (v[2] * v[2] + v[3] * v[3]);
                        const f32x4 a = v * mv[bj][n]; uint2 w; w.x = cvt_pk_bf16(a[0], a[1]); w.y = cvt_pk_bf16(a[2], a[3]); *(uint2*)(ap + bj * HALF + n * 16) = w; }
                ss += __shfl_xor(ss, 16); ss += __shfl_xor(ss, 32);
                if (fq == 0) { if (RED) red[(wr * 64 + m * 16 + fr) * 4 + wc] = ss; else ssq[(size_t)row * 16 + u.pn * 4 + wc] = ss; } }
        }
        if (RED) {
            __syncthreads();
            const int t = threadIdx.x;
            if (t < 128) { const f32x4 v = *(const PG8_LAS f32x4*)(red + t * 4); const int row = u.pm * BM + rowofs + t;
                ssq[(size_t)row * 4 + u.pn] = (v[0] + v[1]) + (v[2] + v[3]); }
        }
    }
    __device__ __forceinline__ void operator()(const f32x4 (&acc)[2][2][4][2], const Unit& u, int wr, int wc, int fr, int fq) const { half<0, 1>(acc, u, wr, wc, fr, fq); half<1, 1>(acc, u, wr, wc, fr, fq); }
};
template <int ACT  > struct EpiBfSB {
    static constexpr bool PERM = true, AFTER_DRAIN = false;
    bf16_t* O; int ldc; const float* ssq; const float* bias; int ldb; int npart;
    __device__ __forceinline__ void operator()(const f32x4 (&acc)[2][2][4][2], const Unit& u, int wr, int wc, int fr, int fq) const {
        const int row0 = u.pm * BM + wr * 64 + fr, col0 = u.pn * BM + wc * 32 + 8 * fq;
        const int t0 = u.pm * BM; const int mr = t0 < 4096 ? 0 : 1 + ((t0 - 4096) >> 10);
        const float* bp = bias + (size_t)mr * ldb + col0;
        f32x4 bv[2][2];
#pragma unroll
        for (int bj = 0; bj < 2; ++bj) { bv[bj][0] = *(const f32x4*)(bp + bj * HALF); bv[bj][1] = *(const f32x4*)(bp + bj * HALF + 4); }
#pragma unroll
        for (int ai = 0; ai < 2; ++ai)
#pragma unroll
            for (int m = 0; m < 4; ++m) { const int row = row0 + ai * HALF + m * 16; bf16_t* rowp = O + (size_t)row * ldc + col0;
                f32x4 ps;
                if (npart == 4) ps = *(const f32x4*)(ssq + (size_t)row * 4);
                else { const f32x4 p0 = *(const f32x4*)(ssq + (size_t)row * 16), p1 = *(const f32x4*)(ssq + (size_t)row * 16 + 4), p2 = *(const f32x4*)(ssq + (size_t)row * 16 + 8), p3 = *(const f32x4*)(ssq + (size_t)row * 16 + 12);
                    ps = (p0 + p1) + (p2 + p3); }
                const float rs = __builtin_amdgcn_rsqf(((ps[0] + ps[1]) + (ps[2] + ps[3])) * (1.0f / 1024.0f) + 1e-6f);
#pragma unroll
                for (int bj = 0; bj < 2; ++bj) { f32x4 v0 = acc[ai][bj][m][0] * rs + bv[bj][0], v1 = acc[ai][bj][m][1] * rs + bv[bj][1];
                    if (ACT == 1) {
#pragma unroll
                        for (int e = 0; e < 4; ++e) { const float a = v0[e] > 0.f ? v0[e] : 0.f, b = v1[e] > 0.f ? v1[e] : 0.f; v0[e] = a * a; v1[e] = b * b; } }
                    u32x4 w; w.x = cvt_pk_bf16(v0[0], v0[1]); w.y = cvt_pk_bf16(v0[2], v0[3]); w.z = cvt_pk_bf16(v1[0], v1[1]); w.w = cvt_pk_bf16(v1[2], v1[3]);
                    *(u32x4*)(rowp + bj * HALF) = w; } }
    }
};

struct EpiProj {
    static constexpr bool PERM = true, AFTER_DRAIN = false;
    bf16_t* O; float* ab;
    __device__ __forceinline__ void operator()(const f32x4 (&acc)[2][2][4][2], const Unit& u, int wr, int wc, int fr, int fq) const {
        if (u.pn < 18) { EpiBf<0> E; E.O = O; E.ldc = 4608; E(acc, u, wr, wc, fr, fq); return; }
        if (wc == 0 && fq < 2) {
            const int row0 = u.pm * BM + wr * 64 + fr;
#pragma unroll
            for (int ai = 0; ai < 2; ++ai)
#pragma unroll
                for (int m = 0; m < 4; ++m) { float* rp = ab + (size_t)(row0 + ai * HALF + m * 16) * 16 + 8 * fq;
                    *(f32x4*)rp = acc[ai][0][m][0]; *(f32x4*)(rp + 4) = acc[ai][0][m][1]; }
        }
    }
};

template <class Inner> struct EpiSplit {
    static constexpr bool PERM = Inner::PERM, AFTER_DRAIN = true;
    Inner in; float* slab; unsigned* flags;
    __device__ __forceinline__ void operator()(const f32x4 (&)[2][2][4][2], const Unit&, int, int, int, int) const {}
    template <int AI> static __device__ __forceinline__ void send(const f32x4 (&acc)[2][2][4][2], f32x4* mine, int tid) {
        const __amdgpu_buffer_rsrc_t rs = __builtin_amdgcn_make_buffer_rsrc((void*)mine, 0, 131072, 0x00020000);
#pragma unroll
        for (int bj = 0; bj < 2; ++bj)
#pragma unroll
            for (int m = 0; m < 4; ++m)
#pragma unroll
                for (int n = 0; n < 2; ++n) __builtin_amdgcn_raw_buffer_store_b128(__builtin_bit_cast(u32x4, acc[AI][bj][m][n]), rs, (((bj * 4 + m) * 2 + n) * 512 + tid) * 16, 0, 16);
    }
    template <int AI> static __device__ __forceinline__ void recv(f32x4 (&acc)[2][2][4][2], const f32x4* theirs, int tid) {
#pragma unroll
        for (int bj = 0; bj < 2; ++bj) {
            f32x4 t[4][2];
#pragma unroll
            for (int m = 0; m < 4; ++m)
#pragma unroll
                for (int n = 0; n < 2; ++n) t[m][n] = theirs[((bj * 4 + m) * 2 + n) * 512 + tid];
#pragma unroll
            for (int m = 0; m < 4; ++m)
#pragma unroll
                for (int n = 0; n < 2; ++n) acc[AI][bj][m][n] += t[m][n];
            asm volatile("" ::: "memory");
        }
    }
    __device__ __forceinline__ void fused(f32x4 (&acc)[2][2][4][2], const Unit& u, int wr, int wc, int fr, int fq, PG8_LAS unsigned char* lds, int wid, int lane) const {
        const int tid = wid * 64 + lane, c = blockIdx.x, kh = (c >> 3) & 1, partner = c ^ 8;
        f32x4* mine = (f32x4*)slab + (size_t)c * 8192; const f32x4* theirs = (const f32x4*)slab + (size_t)partner * 8192;
        send<1>(acc, mine, tid);
        __builtin_amdgcn_sched_barrier(0);
        asm volatile("s_waitcnt vmcnt(0)" ::: "memory");
        __syncthreads();
        if (tid == 0) {
            __hip_atomic_store(flags + c, 1u, __ATOMIC_RELAXED, __HIP_MEMORY_SCOPE_AGENT);
            unsigned spins = 0;
            while (__hip_atomic_load(flags + partner, __ATOMIC_RELAXED, __HIP_MEMORY_SCOPE_AGENT) == 0u) { __builtin_amdgcn_s_sleep(2); if (++spins > (1u << 22)) break; }
            __builtin_amdgcn_fence(__ATOMIC_ACQUIRE, "agent");
            asm volatile("s_waitcnt vmcnt(0)" ::: "memory");
        }
        __syncthreads();
        recv<0>(acc, theirs, tid);
        __builtin_amdgcn_sched_barrier(0);
        in.template half<0, 2, true>(acc, u, wr, wc, fr, fq, kh * HALF, (PG8_LAS float*)lds);
        (void)lds;
    }
};

template <class Epi, class Sched, bool STAMP = false>
__device__ __forceinline__ void gemm_phase(PG8_LAS unsigned char* lds, const Gemm g, const Sched& S, const Epi& E, unsigned long long* stamps) {
    int tid_l = threadIdx.x; asm volatile("" : "+v"(tid_l));
    const int tid = tid_l, wid = __builtin_amdgcn_readfirstlane(tid >> 6), lane = tid & 63, wr = wid >> 2, wc = wid & 3, fr = lane & 15, fq = lane >> 4;
    const int K = g.ld ? g.ld : g.K, nt = g.K / BK;
    int ts_lo = 0, ts_hi = 0, nts = 0; const unsigned long long rt_entry = STAMP ? (unsigned long long)wall_clock64() : 0ull;
#define PG8_STAMP() do { if (STAMP && wid == 0 && nts < 64) { const unsigned long long _c = (unsigned long long)clock64(); \
        ts_lo = (lane == nts) ? (int)(unsigned)_c : ts_lo; ts_hi = (lane == nts) ? (int)(unsigned)(_c >> 32) : ts_hi; ++nts; } } while (0)
    PG8_STAMP();
    unsigned voffA[2], voffB[2];
#pragma unroll
    for (int i = 0; i < 2; ++i) { int R, C; stage_rc(tid * 16 + i * 8192, R, C); const int Rb = Epi::PERM ? ((R & ~31) + perm32(R & 31)) : R;
        voffA[i] = (unsigned)(R * K + C) * 2u; voffB[i] = (unsigned)(Rb * K + C) * 2u; }
    const size_t kstep = (size_t)(BK * 2);
    const size_t hstep = (size_t)HALF * K * 2;
    const size_t tstep = 2 * hstep;
    const long hstepA = g.aswap ? -(long)hstep : (long)hstep;
    const unsigned ldsw = (unsigned)wid * 1024u;
    const int aoff = lds_byte(wr * 64 + fr, fq * 8), boff = lds_byte(wc * 32 + fr, fq * 8);
#define PG8_SA(b, h) (((b) * 2 + (h)) * HTB)
#define PG8_SB(b, h) ((4 + (b) * 2 + (h)) * HTB)
#define PG8_STAGE(bufoff, gbase, voff) do { _Pragma("unroll") for (int _i = 0; _i < 2; ++_i) \
        __builtin_amdgcn_global_load_lds((const unsigned*)((const char*)(gbase) + (voff)[_i]), (PG8_LAS unsigned*)(lds + (bufoff) + ldsw + _i * 8192), 16, 0, 0); } while (0)
#define PG8_LDA(dst, b, h) do { _Pragma("unroll") for (int m = 0; m < 4; ++m) _Pragma("unroll") for (int k = 0; k < 2; ++k) dst[m][k] = *(const PG8_LAS bf16x8*)(lds + PG8_SA(b, h) + aoff + m * 2048 + k * 1024); } while (0)
#define PG8_LDB(dst, b, h) do { _Pragma("unroll") for (int n = 0; n < 2; ++n) _Pragma("unroll") for (int k = 0; k < 2; ++k) dst[n][k] = *(const PG8_LAS bf16x8*)(lds + PG8_SB(b, h) + boff + n * 2048 + k * 1024); } while (0)
#define PG8_MMA(ai, bj, At, Bt) do { __builtin_amdgcn_s_setprio(1); _Pragma("unroll") for (int m = 0; m < 4; ++m) _Pragma("unroll") for (int n = 0; n < 2; ++n) _Pragma("unroll") for (int k = 0; k < 2; ++k) \
        acc[ai][bj][m][n] = __builtin_amdgcn_mfma_f32_16x16x32_bf16(Bt[n][k], At[m][k], acc[ai][bj][m][n], 0, 0, 0); __builtin_amdgcn_s_setprio(0); } while (0)
#define PG8_WAIT_V(n) asm volatile("s_waitcnt vmcnt(" #n ")" ::: "memory")
#define PG8_WAIT_L(n) asm volatile("s_waitcnt lgkmcnt(" #n ")" ::: "memory")
#define PG8_BAR __builtin_amdgcn_s_barrier()
#define PG8_SCHED __builtin_amdgcn_sched_barrier(0)
    Unit cur, nxt; int ui = 0;
    if (!S.next(0, cur)) return;
    f32x4 acc[2][2][4][2];
#pragma unroll
    for (int a = 0; a < 2; ++a)
#pragma unroll
        for (int b = 0; b < 2; ++b)
#pragma unroll
            for (int m = 0; m < 4; ++m)
#pragma unroll
                for (int n = 0; n < 2; ++n) acc[a][b][m][n] = (f32x4){0.f, 0.f, 0.f, 0.f};
    bf16x8 At[4][2], B0[2][2], B1[2][2];
    const char* cA = (const char*)g.A + (size_t)cur.pm * tstep + (g.aswap ? hstep : 0); const char* cB = (const char*)g.Bt + (size_t)cur.pn * tstep;
    S.a_ready(cur);
    PG8_STAGE(PG8_SB(0, 0), cB, voffB); PG8_STAGE(PG8_SA(0, 0), cA, voffA); PG8_STAGE(PG8_SB(0, 1), cB + hstep, voffB); PG8_STAGE(PG8_SA(0, 1), cA + hstepA, voffA);
    if (wr == 1) PG8_BAR;
    PG8_WAIT_V(4); PG8_BAR;
    PG8_STAGE(PG8_SB(1, 0), cB + kstep, voffB); PG8_STAGE(PG8_SA(1, 0), cA + kstep, voffA); PG8_STAGE(PG8_SB(1, 1), cB + hstep + kstep, voffB);
    PG8_WAIT_V(6); PG8_BAR;
    PG8_STAMP();
    for (;;) {
        const bool has_next = S.next(ui + 1, nxt);
        const char* nA = has_next ? (const char*)g.A + (size_t)nxt.pm * tstep + (g.aswap ? hstep : 0) : cA; const char* nB = has_next ? (const char*)g.Bt + (size_t)nxt.pn * tstep : cB;
        for (int t = 0; t < nt; t += 2) {
            const bool last = (t == nt - 2);
            const char* a1 = cA + (size_t)(t + 1) * kstep;
            const char* a2 = last ? nA : cA + (size_t)(t + 2) * kstep; const char* b2 = last ? nB : cB + (size_t)(t + 2) * kstep;
            const char* a3 = a2 + kstep; const char* b3 = b2 + kstep;
            if (last && has_next) S.a_ready(nxt);
            PG8_LDB(B0, 0, 0); PG8_SCHED; PG8_LDA(At, 0, 0); PG8_STAGE(PG8_SA(1, 1), a1 + hstepA, voffA);
            PG8_WAIT_L(8); PG8_BAR; PG8_WAIT_L(0); PG8_MMA(0, 0, At, B0); PG8_BAR; PG8_SCHED;
            PG8_LDB(B1, 0, 1); PG8_STAGE(PG8_SB(0, 0), b2, voffB);
            PG8_BAR; PG8_WAIT_L(0); PG8_MMA(0, 1, At, B1); PG8_BAR;
            PG8_LDA(At, 0, 1); PG8_STAGE(PG8_SA(0, 0), a2, voffA);
            PG8_BAR; PG8_WAIT_L(0); PG8_MMA(1, 0, At, B0); PG8_BAR; PG8_SCHED;
            PG8_STAGE(PG8_SB(0, 1), b2 + hstep, voffB);
            PG8_WAIT_V(6); PG8_BAR; PG8_MMA(1, 1, At, B1); PG8_BAR;
            PG8_LDB(B0, 1, 0); PG8_SCHED; PG8_LDA(At, 1, 0); PG8_STAGE(PG8_SA(0, 1), a2 + hstepA, voffA);
            PG8_WAIT_L(8); PG8_BAR; PG8_WAIT_L(0); PG8_MMA(0, 0, At, B0); PG8_BAR; PG8_SCHED;
            PG8_LDB(B1, 1, 1); PG8_STAGE(PG8_SB(1, 0), b3, voffB);
            PG8_BAR; PG8_WAIT_L(0); PG8_MMA(0, 1, At, B1); PG8_BAR;
            PG8_LDA(At, 1, 1); PG8_STAGE(PG8_SA(1, 0), a3, voffA);
            PG8_BAR; PG8_WAIT_L(0); PG8_MMA(1, 0, At, B0); PG8_BAR; PG8_SCHED;
            PG8_STAGE(PG8_SB(1, 1), b3 + hstep, voffB);
            PG8_WAIT_V(6); PG8_BAR; PG8_MMA(1, 1, At, B1); PG8_BAR;
        }
        PG8_STAMP();
        if constexpr (!Epi::AFTER_DRAIN) { E(acc, cur, wr, wc, fr, fq); S.done(cur); }
        PG8_STAMP();
        if (!has_next) break;
#pragma unroll
        for (int a = 0; a < 2; ++a)
#pragma unroll
            for (int b = 0; b < 2; ++b)
#pragma unroll
                for (int m = 0; m < 4; ++m)
#pragma unroll
                    for (int n = 0; n < 2; ++n) acc[a][b][m][n] = (f32x4){0.f, 0.f, 0.f, 0.f};
        cur = nxt; cA = nA; cB = nB; ++ui;
    }
    PG8_WAIT_V(0);
    if (wr == 0) PG8_BAR;
    PG8_BAR;
    if constexpr (Epi::AFTER_DRAIN) { E.fused(acc, cur, wr, wc, fr, fq, lds, wid, lane); S.done(cur); }
    PG8_STAMP();
    if (STAMP && wid == 0) { stamps[lane] = lane < nts ? (((unsigned long long)(unsigned)ts_hi << 32) | (unsigned)ts_lo) : 0ull;
        if (lane == 62) stamps[62] = rt_entry; if (lane == 63) stamps[63] = (unsigned long long)wall_clock64(); }
#undef PG8_STAMP
#undef PG8_SA
#undef PG8_SB
#undef PG8_STAGE
#undef PG8_LDA
#undef PG8_LDB
#undef PG8_MMA
#undef PG8_WAIT_V
#undef PG8_WAIT_L
#undef PG8_BAR
#undef PG8_SCHED
}
}

using pg8::bf16_t; using pg8::bf16x8; using pg8::f32x4; using pg8::u32x4;
#define LAS __attribute__((address_space(3)))
#define DI __device__ __forceinline__
typedef float f32x2 __attribute__((ext_vector_type(2)));
typedef unsigned u32x2 __attribute__((ext_vector_type(2)));
typedef unsigned short u16x8 __attribute__((ext_vector_type(8)));
typedef unsigned short u16x4 __attribute__((ext_vector_type(4)));

constexpr int NTOK = 8192, DM = 1024, DFF = 4096, NPROJ = 4608, NPROJ_ALL = 4624, NMOD = 6144;
constexpr int LDS_BYTES = 147456;
constexpr int GDN_PACK_B = 34880, HG_PACK_B = 18944;
constexpr size_t OFF_MOD = 0;
constexpr size_t OFF_BAR = 245760;
constexpr size_t OFF_FLAG = OFF_BAR + 13824;
constexpr size_t OFF_LBS = 264192;
constexpr size_t OFF_AB = 266240;
constexpr size_t OFF_W0 = OFF_AB + (size_t)NTOK * 16 * 4;
constexpr int NPROJ_PAD = 4864;
constexpr size_t SZ_WIN = (size_t)NPROJ_PAD * DM * 2, SZ_WSQ = (size_t)DM * DM * 2, SZ_WFF = (size_t)DFF * DM * 2;
constexpr size_t OFF_H = OFF_W0 + SZ_WIN + SZ_WSQ + 2 * SZ_WFF;
constexpr size_t OFF_PROJ = OFF_H + (size_t)NTOK * DM * 2;
constexpr size_t OFF_PACK = OFF_PROJ + (size_t)NTOK * NPROJ * 2;
constexpr size_t SZ_GPACK = (size_t)2048 * GDN_PACK_B, SZ_HPACK = (size_t)2048 * HG_PACK_B;
constexpr size_t OFF_O = OFF_PACK + SZ_GPACK + SZ_HPACK;
constexpr size_t WS_NEED = OFF_O + (size_t)2 * NTOK * DM * 2;
constexpr size_t OFF_W1 = OFF_PACK;
constexpr size_t SZ_WQKV = (size_t)3072 * DM * 2;
constexpr size_t OFF_X2 = OFF_W1 + SZ_WQKV + SZ_WSQ + 2 * SZ_WFF;
constexpr size_t OFF_CK = OFF_X2 + (size_t)NTOK * DM * 4;
constexpr size_t OFF_H2 = OFF_CK + (size_t)2 * 4 * 16 * 256 * 64 * 2;
constexpr size_t OFF_SSQ = OFF_H2 + (size_t)NTOK * DM * 2;
constexpr size_t OFF_CB = OFF_SSQ + (size_t)3 * NTOK * 16 * 4;
constexpr size_t OFF_STAMP2 = OFF_CB + (size_t)5 * (4096 + 3072 + 4096) * 4 + 131072 + 4096;
static_assert(OFF_STAMP2 + 4096 <= OFF_O, "overlay");
static_assert(WS_NEED <= 268435456ull, "workspace");

#ifndef PROBE_A
#define PROBE_A -1
#define PROBE_B 56
#define PROBE_SCALE 0.01f
#endif
#define TSTAMP(n) do { if (PROBE_A >= 0 && threadIdx.x == 0 && blockIdx.x == 0) tsl[n] = __builtin_amdgcn_s_memrealtime(); } while (0)
#define SUBSTAMP(lds_, n) do { if (PROBE_A >= 0 && threadIdx.x == 0 && blockIdx.x == 0) ((volatile LAS unsigned long long*)((lds_) + LDS_BYTES - 16 - 512))[n] = __builtin_amdgcn_s_memrealtime(); } while (0)
#define SUBSTAMPB(ws_, blk, n) do { if (PROBE_A >= 0 && threadIdx.x == 0 && blockIdx.x == (blk)) ((volatile unsigned long long*)((ws_) + OFF_STAMP2))[n] = __builtin_amdgcn_s_memrealtime(); } while (0)
struct Params {
    const float *xp, *xs, *st_hgrn, *st_gdn, *cache_k, *cache_v, *c, *c_ctx, *ada_w, *ada_b, *norm_g, *w_in, *w_out_ab, *hgrn_lb, *gdn_conv, *a_log, *dt_bias,
        *gn_hgrn, *gn_gdn, *w_qkv, *qn, *kn, *rpb, *w_out_na, *w_mlp1, *w_mlp2;
    float* out; unsigned char* ws;
};

typedef __bf16 bf16x2_t __attribute__((ext_vector_type(2)));
DI bf16_t f2bf(float f) { return __builtin_bit_cast(unsigned short, (__bf16)f); }
DI unsigned pack2_safe(float lo, float hi) { const f32x2 v = {lo, hi}; return __builtin_bit_cast(unsigned, __builtin_convertvector(v, bf16x2_t)); }
DI float bf2f(bf16_t h) { return __uint_as_float((unsigned)h << 16); }
DI float sigmoidf_(float x) { return 1.0f / (1.0f + __expf(-x)); }
DI float siluf_(float x) { return x / (1.0f + __expf(-x)); }
DI float softplusf_(float x) { return x > 20.f ? x : log1pf(__expf(x)); }
DI float wave_sum(float v) { for (int o = 32; o > 0; o >>= 1) v += __shfl_xor(v, o); return v; }
DI int modrow(int tok) { return tok < 4096 ? 0 : 1 + ((tok - 4096) >> 10); }
DI const float* xrow(const Params& p, int tok) { return tok < 4096 ? p.xp + (size_t)tok * DM : p.xs + (size_t)(tok - 4096) * DM; }

DI f32x4 mma16(const LAS bf16_t* A, int lda, const LAS bf16_t* Bt, int ldb, int K, f32x4 acc) {
    const int lane = threadIdx.x & 63, r = lane & 15, q = lane >> 4;
    const LAS bf16_t* pa = A + r * lda + 8 * q; const LAS bf16_t* pb = Bt + r * ldb + 8 * q;
    for (int k0 = 0; k0 < K; k0 += 32) {
        const bf16x8 a = *(const LAS bf16x8*)(pa + k0), b = *(const LAS bf16x8*)(pb + k0);
        acc = __builtin_amdgcn_mfma_f32_16x16x32_bf16(a, b, acc, 0, 0, 0);
    }
    return acc;
}
DI void phase_mod(const Params& p, LAS unsigned char* lds) {
    LAS float* sc = (LAS float*)lds;
    LAS float* red = (LAS float*)(lds + 20480);
    int tid_ = threadIdx.x; asm volatile("" : "+v"(tid_));
    const int tid = tid_;
    float* mod = (float*)(p.ws + OFF_MOD);
    for (int e = tid; e < 5 * 1024; e += 512) { const int m = e >> 10, k = e & 1023; const float v = m == 0 ? p.c_ctx[k] : p.c[(m - 1) * 1024 + k]; sc[e] = siluf_(v); }
    __syncthreads();
    for (int cb = blockIdx.x; cb < 256; cb += gridDim.x) {
        const int l = cb >> 7, n0 = (cb & 127) * 48;
        const float* W = p.ada_w + (size_t)l * 1024 * NMOD + n0;
        const int cq = tid % 12, ks = tid / 12;
        float acc[5][4];
#pragma unroll
        for (int m = 0; m < 5; ++m)
#pragma unroll
            for (int j = 0; j < 4; ++j) acc[m][j] = 0.f;
        if (ks < 42) {
            const int k0 = ks * 25;
#pragma unroll 1
            for (int kk = 0; kk < 25; kk += 5) {
                f32x4 w[5];
#pragma unroll
                for (int u = 0; u < 5; ++u) { const int k = k0 + kk + u; w[u] = k < 1024 ? *(const f32x4*)(W + (size_t)k * NMOD + 4 * cq) : (f32x4){0.f, 0.f, 0.f, 0.f}; }
#pragma unroll
                for (int u = 0; u < 5; ++u) { const int k = (k0 + kk + u) < 1024 ? (k0 + kk + u) : 1023;
#pragma unroll
                    for (int m = 0; m < 5; ++m) { const float sv = sc[m * 1024 + k];
#pragma unroll
                        for (int j = 0; j < 4; ++j) acc[m][j] += sv * w[u][j]; } }
            }
#pragma unroll
            for (int m = 0; m < 5; ++m)
#pragma unroll
                for (int j = 0; j < 4; ++j) red[(ks * 5 + m) * 48 + 4 * cq + j] = acc[m][j];
        }
        __syncthreads();
        if (tid < 240) { const int m = tid / 48, j = tid % 48; float s = 0.f; for (int k = 0; k < 42; ++k) s += red[(k * 5 + m) * 48 + j];
            mod[((size_t)l * 5 + m) * NMOD + n0 + j] = s + p.ada_b[l * NMOD + n0 + j]; }
        __syncthreads();
    }
    if (blockIdx.x == gridDim.x - 1) {
        float* lbs = (float*)(p.ws + OFF_LBS);
        const float a = p.hgrn_lb[tid], b = p.hgrn_lb[512 + tid], c = p.hgrn_lb[1024 + tid];
        const float mx = fmaxf(a, fmaxf(b, c)); const float ea = __expf(a - mx), eb = __expf(b - mx), ec = __expf(c - mx);
        lbs[tid] = ea / (ea + eb + ec);
    }
}
DI void transpose_tiles(const float* W, int K, int N, int ldw, bf16_t* Wt, int tbase, int ttotal, LAS unsigned char* lds, int bid = -1, int nb = 0) {
    if (bid < 0) { bid = blockIdx.x; nb = gridDim.x; }
    LAS float* tile = (LAS float*)lds;
    int tid_ = threadIdx.x; asm volatile("" : "+v"(tid_));
    const int tid = tid_, nk = K / 64, nn = N / 64, nt = nk * nn;
    int g = bid; if (g < tbase) g += ((tbase - g + nb - 1) / nb) * nb;
    __syncthreads();
    for (; g < tbase + nt; g += 4 * nb) {
        f32x4 v[4][2];
#pragma unroll
        for (int u = 0; u < 4; ++u) { const int gu = g + u * nb;
            if (gu < tbase + nt) { const int t = gu - tbase, tk = t % nk, tn = t / nk; const float* src = W + (size_t)(tk * 64 + (tid >> 4)) * ldw + tn * 64 + 4 * (tid & 15);
                v[u][0] = *(const f32x4*)src; v[u][1] = *(const f32x4*)(src + (size_t)32 * ldw); } }
#pragma unroll
        for (int u = 0; u < 4; ++u) { if (g + u * nb < tbase + nt) { LAS float* tl = tile + u * 4160; const int row = tid >> 4, c4 = tid & 15;
#pragma unroll
            for (int e = 0; e < 4; ++e) { tl[row * 65 + 4 * c4 + e] = v[u][0][e]; tl[(row + 32) * 65 + 4 * c4 + e] = v[u][1][e]; } } }
        __syncthreads();
#pragma unroll
        for (int u = 0; u < 4; ++u) { const int gu = g + u * nb;
            if (gu < tbase + nt) { const int t = gu - tbase, tk = t % nk, tn = t / nk, k0 = tk * 64, n0 = tn * 64; const LAS float* tl = tile + u * 4160;
                const int n = tid >> 3, k8 = tid & 7; u32x4 w;
                w.x = pg8::cvt_pk_bf16(tl[(k8 * 8 + 0) * 65 + n], tl[(k8 * 8 + 1) * 65 + n]); w.y = pg8::cvt_pk_bf16(tl[(k8 * 8 + 2) * 65 + n], tl[(k8 * 8 + 3) * 65 + n]);
                w.z = pg8::cvt_pk_bf16(tl[(k8 * 8 + 4) * 65 + n], tl[(k8 * 8 + 5) * 65 + n]); w.w = pg8::cvt_pk_bf16(tl[(k8 * 8 + 6) * 65 + n], tl[(k8 * 8 + 7) * 65 + n]);
                *(u32x4*)(Wt + (size_t)(n0 + n) * K + k0 + k8 * 8) = w; } }
        __syncthreads();
    }
    (void)ttotal;
}
DI void phase_w0(const Params& p, LAS unsigned char* lds) {
    bf16_t* w = (bf16_t*)(p.ws + OFF_W0);
    transpose_tiles(p.w_in, 1024, NPROJ, NPROJ_ALL, w, 0, 0, lds);
    for (int e = blockIdx.x * 512 + threadIdx.x; e < 16 * 1024; e += gridDim.x * 512) { const int k = e >> 4, j = e & 15; w[(size_t)(NPROJ + j) * DM + k] = f2bf(p.w_in[(size_t)k * NPROJ_ALL + NPROJ + j]); }
    for (int e = blockIdx.x * 512 + threadIdx.x; e < 240 * 128; e += gridDim.x * 512) *(u32x4*)(w + (size_t)(NPROJ + 16) * DM + (size_t)e * 8) = (u32x4){0u, 0u, 0u, 0u};
}
DI void bias_cols(const float* W, int N, const float* shv, float* outb, LAS unsigned char* lds, int bid, int nb) {
    LAS float* sv = (LAS float*)lds;
    LAS float* red = (LAS float*)(lds + 20480);
    int tid_ = threadIdx.x; asm volatile("" : "+v"(tid_));
    const int tid = tid_, cq = tid & 7, ks = tid >> 3;
    __syncthreads();
    for (int e = tid; e < 5 * 1024; e += 512) sv[e] = shv[(size_t)(e >> 10) * NMOD + (e & 1023)];
    __syncthreads();
    for (int cb = bid; cb < N / 32; cb += nb) {
        const float* Wp = W + cb * 32 + 4 * cq;
        float acc[5][4];
#pragma unroll
        for (int m = 0; m < 5; ++m)
#pragma unroll
            for (int j = 0; j < 4; ++j) acc[m][j] = 0.f;
#pragma unroll 1
        for (int kk = 0; kk < 16; kk += 4) {
            f32x4 w[4];
#pragma unroll
            for (int u = 0; u < 4; ++u) w[u] = *(const f32x4*)(Wp + (size_t)(ks * 16 + kk + u) * N);
#pragma unroll
            for (int u = 0; u < 4; ++u)
#pragma unroll
                for (int m = 0; m < 5; ++m) { const float s0 = sv[m * 1024 + ks * 16 + kk + u];
#pragma unroll
                    for (int j = 0; j < 4; ++j) acc[m][j] += s0 * w[u][j]; }
        }
#pragma unroll
        for (int m = 0; m < 5; ++m)
#pragma unroll
            for (int j = 0; j < 4; ++j) red[(ks * 5 + m) * 32 + 4 * cq + j] = acc[m][j];
        __syncthreads();
        if (tid < 160) { const int m = tid >> 5, j = tid & 31; float s0 = 0.f; for (int k = 0; k < 64; ++k) s0 += red[(k * 5 + m) * 32 + j]; outb[(size_t)m * N + cb * 32 + j] = s0; }
        __syncthreads();
    }
}
DI bf16_t* w1_temp(const Params& p) { return (bf16_t*)(p.out + (size_t)NTOK * DM + 2 * 2097152); }
DI void helper_scan(const Params& p, LAS unsigned char* lds, int bid, int nb) {
    bf16_t* w0 = (bf16_t*)(p.ws + OFF_W0) + (size_t)NPROJ_PAD * DM + (size_t)DM * DM;
    int tb = 0;
    transpose_tiles(p.w_mlp1, 1024, 4096, 4096, w0, tb, 0, lds, bid, nb); tb += 1024;
    transpose_tiles(p.w_mlp2, 4096, 1024, 1024, w0 + (size_t)DFF * DM, tb, 0, lds, bid, nb); tb += 1024;
    bf16_t* w = w1_temp(p);
    transpose_tiles(p.w_qkv, 1024, 3072, 3072, w, tb, 0, lds, bid, nb); tb += 16 * 48;
    transpose_tiles(p.w_out_na, 1024, 1024, 1024, w + (size_t)3072 * DM, tb, 0, lds, bid, nb); tb += 256;
    transpose_tiles(p.w_mlp1 + (size_t)DM * DFF, 1024, 4096, 4096, w + (size_t)3072 * DM + (size_t)DM * DM, tb, 0, lds, bid, nb); tb += 1024;
    transpose_tiles(p.w_mlp2 + (size_t)DFF * DM, 4096, 1024, 1024, w + (size_t)3072 * DM + (size_t)DM * DM + (size_t)DFF * DM, tb, 0, lds, bid, nb);
}
DI void phase_w1(const Params& p, LAS unsigned char* lds) {
    transpose_tiles(p.w_out_ab, 1024, 1024, 1024, (bf16_t*)(p.ws + OFF_W0) + (size_t)NPROJ_PAD * DM, 0, 0, lds);
    int tid_ = threadIdx.x; asm volatile("" : "+v"(tid_));
    const int tid = tid_, bid = blockIdx.x, nb = gridDim.x;
    { const u32x4* src = (const u32x4*)w1_temp(p); u32x4* dst = (u32x4*)(p.ws + OFF_W1);
      for (int e = bid * 512 + tid; e < 1572864; e += nb * 2048) {
          u32x4 v[4];
#pragma unroll
          for (int u = 0; u < 4; ++u) if (e + u * nb * 512 < 1572864) v[u] = src[e + u * nb * 512];
#pragma unroll
          for (int u = 0; u < 4; ++u) if (e + u * nb * 512 < 1572864) dst[e + u * nb * 512] = v[u]; } }
    const float* mod0 = (const float*)(p.ws + OFF_MOD); const float* mod1 = mod0 + (size_t)5 * NMOD;
    bias_cols(p.w_mlp1, 4096, mod0 + 3072, (float*)(p.ws + OFF_CB), lds, bid, nb);
    bias_cols(p.w_qkv, 3072, mod1, (float*)(p.ws + OFF_CB) + 5 * 4096, lds, bid, nb);
    bias_cols(p.w_mlp1 + (size_t)DM * DFF, 4096, mod1 + 3072, (float*)(p.ws + OFF_CB) + 5 * 4096 + 5 * 3072, lds, bid, nb);
    { bf16_t* CK = (bf16_t*)(p.ws + OFF_CK);
      for (int e = bid * 512 + tid; e < 262144; e += nb * 512) {
          const float* src = e < 131072 ? p.cache_k + (size_t)e * 8 : p.cache_v + (size_t)(e - 131072) * 8;
          const f32x4 a = *(const f32x4*)src, b = *(const f32x4*)(src + 4);
          *(u32x4*)(CK + (size_t)e * 8) = (u32x4){pg8::cvt_pk_bf16(a[0], a[1]), pg8::cvt_pk_bf16(a[2], a[3]), pg8::cvt_pk_bf16(b[0], b[1]), pg8::cvt_pk_bf16(b[2], b[3])}; } }
}
template <bool AB> DI void phase_norm(const Params& p, const float* srcp, const float* srcs, int l, int sub, LAS unsigned char* lds) {
    int tid_ = threadIdx.x; asm volatile("" : "+v"(tid_));
    const int tid = tid_, wid = tid >> 6, lane = tid & 63;
    const float* mod = (const float*)(p.ws + OFF_MOD) + (size_t)l * 5 * NMOD;
    const float* gw = p.norm_g + (l * 2 + sub) * 1024;
    bf16_t* H = (bf16_t*)(p.ws + OFF_H);
    LAS float* wab = (LAS float*)lds;
    if (AB) {
#pragma unroll
        for (int u = 0; u < 8; ++u) { const int e4 = tid + u * 512, k = e4 >> 2, j4 = e4 & 3;
            *(LAS f32x4*)(wab + k * 16 + 4 * j4) = *(const f32x4*)(p.w_in + (size_t)k * NPROJ_ALL + NPROJ + 4 * j4); }
        __syncthreads(); }
    SUBSTAMP(lds, 32);
    float* ab = (float*)(p.ws + OFF_AB);
    const int stride = 1;
    for (int tb = blockIdx.x * 32 + wid * 4; tb < NTOK; tb += gridDim.x * 32) {
        f32x4 x[4][4]; float ss[4];
#pragma unroll
        for (int r = 0; r < 4; ++r) { const int tok = tb + r * stride;
            if (tok < NTOK) { const float* xr = tok < 4096 ? srcp + (size_t)tok * 1024 : srcs + (size_t)(tok - 4096) * 1024;
#pragma unroll
                for (int i = 0; i < 4; ++i) x[r][i] = *(const f32x4*)(xr + i * 256 + lane * 4); }
            else {
#pragma unroll
                for (int i = 0; i < 4; ++i) x[r][i] = (f32x4){0.f, 0.f, 0.f, 0.f}; } }
        f32x4 g4[4];
#pragma unroll
        for (int i = 0; i < 4; ++i) g4[i] = *(const f32x4*)(gw + i * 256 + lane * 4);
#pragma unroll
        for (int r = 0; r < 4; ++r) { float a = 0.f;
#pragma unroll
            for (int i = 0; i < 4; ++i) a += x[r][i][0] * x[r][i][0] + x[r][i][1] * x[r][i][1] + x[r][i][2] * x[r][i][2] + x[r][i][3] * x[r][i][3];
            ss[r] = a; }
#pragma unroll
        for (int o = 32; o > 0; o >>= 1) {
#pragma unroll
            for (int r = 0; r < 4; ++r) ss[r] += __shfl_xor(ss[r], o); }
#pragma unroll
        for (int r = 0; r < 4; ++r) { const int tok = tb + r * stride; if (tok >= NTOK) break;
            const float rs = rsqrtf(ss[r] * (1.0f / 1024.0f) + 1e-6f);
            const int mr = modrow(tok);
            const float* sh = mod + (size_t)mr * NMOD + sub * 3072; const float* scp = sh + 1024;
            float pa[16];
            if (AB) {
#pragma unroll
                for (int j = 0; j < 16; ++j) pa[j] = 0.f; }
#pragma unroll
            for (int i = 0; i < 4; ++i) { const int k = i * 256 + lane * 4;
                const f32x4 s4 = *(const f32x4*)(scp + k), h4 = *(const f32x4*)(sh + k);
                f32x4 hv;
#pragma unroll
                for (int e = 0; e < 4; ++e) hv[e] = x[r][i][e] * rs * g4[i][e] * (1.0f + s4[e]) + h4[e];
                uint2 w; w.x = pg8::cvt_pk_bf16(hv[0], hv[1]); w.y = pg8::cvt_pk_bf16(hv[2], hv[3]);
                *(uint2*)(H + (size_t)tok * 1024 + k) = w;
                if (AB) {
#pragma unroll
                    for (int e = 0; e < 4; ++e) {
#pragma unroll
                        for (int j4 = 0; j4 < 4; ++j4) { const f32x4 wv = *(const LAS f32x4*)(wab + (k + e) * 16 + 4 * j4);
                            pa[4 * j4 + 0] += hv[e] * wv[0]; pa[4 * j4 + 1] += hv[e] * wv[1]; pa[4 * j4 + 2] += hv[e] * wv[2]; pa[4 * j4 + 3] += hv[e] * wv[3]; } } }
            }
            if (AB) {
                float mine = 0.f;
#pragma unroll
                for (int j = 0; j < 16; ++j) { const float sv = wave_sum(pa[j]); if (lane == j) mine = sv; }
                if (lane < 16) ab[(size_t)tok * 16 + lane] = mine;
            }
        }
    }
}
DI int chunk_seq_start(int gc) { return gc < 128 ? (gc >> 3) * 256 : 4096 + ((gc - 128) >> 5) * 1024; }
DI int chunk_seq_len(int gc) { return gc < 128 ? 256 : 1024; }
struct PrepRaw { u32x4 v[4]; float ab; };
DI void prep_fetch(const Params& p, int pi, int kind, PrepRaw& R) {
    const int tid = threadIdx.x, h = pi & 3, gc = pi >> 2, t0 = gc * 32;
    const bf16_t* proj = (const bf16_t*)(p.ws + OFF_PROJ);
    if (kind == 0) {
        const int sb = chunk_seq_start(gc), se = sb + chunk_seq_len(gc);
#pragma unroll
        for (int k = 0; k < 4; ++k) { const int pc = tid + k * 512; R.v[k] = (u32x4){0u, 0u, 0u, 0u};
            if (pc < 1728) { const int row = pc / 48, rem = pc % 48, part = rem >> 4, c8 = rem & 15, tk = t0 - 2 + row;
                if (tk >= sb && tk < se) R.v[k] = *(const u32x4*)(proj + (size_t)tk * NPROJ + 2560 + part * 512 + h * 128 + c8 * 8); } }
        R.ab = 0.f;
        if (tid < 128) { const int i = tid >> 2, w = tid & 3;
            R.ab = ((const float*)(p.ws + OFF_AB))[(size_t)(t0 + i) * 16 + w * 4 + h]; }
    } else {
#pragma unroll
        for (int k = 0; k < 3; ++k) { const int pc = tid + k * 512, row = pc / 48, rem = pc % 48, which = rem >> 4, c8 = rem & 15;
            R.v[k] = *(const u32x4*)(proj + (size_t)(t0 + row) * NPROJ + which * 512 + h * 128 + c8 * 8); }
    }
}
DI void gdn_prep_item(const Params& p, int gc, int h, const PrepRaw& R, LAS unsigned char* lds) {
    int tid_ = threadIdx.x; asm volatile("" : "+v"(tid_));
    const int tid = tid_, wid = __builtin_amdgcn_readfirstlane(tid >> 6), lane = tid & 63;
    LAS bf16_t* RAW = (LAS bf16_t*)lds;
    LAS bf16_t* QB = (LAS bf16_t*)(lds + 27648); LAS bf16_t* KB = (LAS bf16_t*)(lds + 36352); LAS bf16_t* VB = (LAS bf16_t*)(lds + 45056);
    LAS float* KK = (LAS float*)(lds + 53760); LAS float* QK = (LAS float*)(lds + 57984);
    LAS float* CW = (LAS float*)(lds + 117248); LAS float* ABL = (LAS float*)(lds + 124928);
#pragma unroll
    for (int k = 0; k < 4; ++k) { const int pc = tid + k * 512; if (pc < 1728) *(LAS u32x4*)(RAW + pc * 8) = R.v[k]; }
    if (tid < 128) ABL[tid] = R.ab;
    SUBSTAMP(lds, 33);
    __syncthreads();
    SUBSTAMP(lds, 34);
    { const int i = tid >> 4, cg = tid & 15;
#pragma unroll
      for (int part = 0; part < 3; ++part) {
          float a[8];
#pragma unroll
          for (int e = 0; e < 8; ++e) a[e] = 0.f;
#pragma unroll
          for (int j = 0; j < 5; ++j) { const u16x8 x = *(const LAS u16x8*)(RAW + (i + j) * 384 + part * 128 + cg * 8);
              const f32x4 w0 = *(const LAS f32x4*)(CW + j * 384 + part * 128 + cg * 8), w1 = *(const LAS f32x4*)(CW + j * 384 + part * 128 + cg * 8 + 4);
#pragma unroll
              for (int e = 0; e < 4; ++e) { a[e] += bf2f(x[e]) * w0[e]; a[4 + e] += bf2f(x[4 + e]) * w1[e]; } }
          float ss = 0.f;
#pragma unroll
          for (int e = 0; e < 8; ++e) { a[e] = siluf_(a[e]); ss += a[e] * a[e]; }
          float sc = 1.f;
          if (part < 2) { ss += __shfl_xor(ss, 1); ss += __shfl_xor(ss, 2); ss += __shfl_xor(ss, 4); ss += __shfl_xor(ss, 8);
              sc = rsqrtf(ss + 1e-6f) * (part == 0 ? 0.08838834764831845f : 1.f); }
          u32x4 w; w.x = pg8::cvt_pk_bf16(a[0] * sc, a[1] * sc); w.y = pg8::cvt_pk_bf16(a[2] * sc, a[3] * sc); w.z = pg8::cvt_pk_bf16(a[4] * sc, a[5] * sc); w.w = pg8::cvt_pk_bf16(a[6] * sc, a[7] * sc);
          *(LAS u32x4*)(QB + part * 4352 + i * 136 + cg * 8) = w;
      } }
    __syncthreads();
    SUBSTAMP(lds, 35);
    { const int w4 = wid & 3, mt = w4 >> 1, nt = w4 & 1, r = lane & 15, q = lane >> 4;
      f32x4 acc = {0.f, 0.f, 0.f, 0.f};
      acc = mma16((wid < 4 ? KB : QB) + 16 * mt * 136, 136, KB + 16 * nt * 136, 136, 128, acc);
      LAS float* D = wid < 4 ? KK : QK;
#pragma unroll
      for (int i = 0; i < 4; ++i) D[(16 * mt + 4 * q + i) * 33 + 16 * nt + r] = acc[i]; }
    const int dir = wid >> 2, ht = tid & 255, hw = wid & 3;
    LAS float* GS = (LAS float*)(lds + 125440 + dir * 512);     LAS float* AM = (LAS float*)(lds + 62720 + dir * 4224);
    LAS bf16_t* TM = (LAS bf16_t*)(lds + 71168 + dir * 2560); LAS bf16_t* RT = (LAS bf16_t*)(lds + 76288 + dir * 20480);
    bf16_t* pack = (bf16_t*)(p.ws + OFF_PACK + ((size_t)(gc * 4 + h) * 2 + dir) * GDN_PACK_B);
    if (hw == 0) {
        const int pp = lane & 31, i = dir ? 31 - pp : pp;
        const float araw = ABL[i * 4 + dir], braw = ABL[i * 4 + 2 + dir];
        const float beta = sigmoidf_(braw);
        float g = -__expf(p.a_log[dir * 4 + h]) * softplusf_(araw + p.dt_bias[dir * 4 + h]);
#pragma unroll
        for (int o = 1; o < 32; o <<= 1) { const float t = __shfl_up(g, o, 32); if (pp >= o) g += t; }
        const float glast = __shfl(g, 31, 32);
        if (lane < 32) { GS[pp] = g; GS[32 + pp] = beta; GS[64 + pp] = __expf(g); GS[96 + pp] = __expf(glast - g); }
    }
    __syncthreads();
    SUBSTAMP(lds, 36);
    { const int pp = ht >> 3, s0 = (ht & 7) * 4, ip = dir ? 31 - pp : pp; const float gp = GS[pp], bp = GS[32 + pp];
      float at[4];
#pragma unroll
      for (int e = 0; e < 4; ++e) { const int s = s0 + e, is = dir ? 31 - s : s; const float dec = s <= pp ? __expf(gp - GS[s]) : 0.f;
          AM[pp * 33 + s] = s < pp ? bp * KK[ip * 33 + is] * dec : 0.f; at[e] = s <= pp ? QK[ip * 33 + is] * dec : 0.f; }
      uint2 w; w.x = pg8::cvt_pk_bf16(at[0], at[1]); w.y = pg8::cvt_pk_bf16(at[2], at[3]);
      *(uint2*)(pack + 12288 + pp * 32 + s0) = w; }
    __syncthreads();
    SUBSTAMP(lds, 37);
    if (hw == 0) {
        LAS bf16_t* XA = (LAS bf16_t*)(lds + 126464 + dir * 5120); LAS bf16_t* TB = XA + 640; LAS bf16_t* PA = XA + 1280; LAS bf16_t* XB = XA + 1920;
        { const int rr = lane >> 2, c4 = 16 + (lane & 3) * 4;
          *(LAS u32x2*)(XA + rr * 40 + c4) = (u32x2){0u, 0u}; *(LAS u32x2*)(TB + rr * 40 + c4) = (u32x2){0u, 0u}; *(LAS u32x2*)(PA + rr * 40 + c4) = (u32x2){0u, 0u}; *(LAS u32x2*)(XB + rr * 40 + c4) = (u32x2){0u, 0u};
          *(LAS u32x2*)(TM + rr * 40 + c4) = (u32x2){0u, 0u}; }
        { const int n = lane & 15, k0 = (lane >> 4) * 4;
#pragma unroll
          for (int e = 0; e < 4; ++e) TB[n * 40 + k0 + e] = f2bf(AM[(16 + k0 + e) * 33 + n]); }
        if (lane < 32) {
            const int c = lane & 15, base = lane & 16;
            float x[16];
#pragma unroll
            for (int pp = 0; pp < 16; ++pp) {
                float a0 = (pp == c) ? 1.f : 0.f, a1 = 0.f;
                const LAS float* ar = AM + (base + pp) * 33 + base;
#pragma unroll
                for (int j = 0; j < pp; ++j) { if (j & 1) a1 -= ar[j] * x[j]; else a0 -= ar[j] * x[j]; }
                x[pp] = a0 + a1; const bf16_t xb = f2bf(a0 + a1);
                TM[(base + pp) * 40 + base + c] = xb;
                if (base) XA[pp * 40 + c] = xb; else XB[c * 40 + pp] = xb;
            }
        }
        asm volatile("s_waitcnt lgkmcnt(0)" ::: "memory");
        { const int r = lane & 15, q = lane >> 4;
          f32x4 acc = {0.f, 0.f, 0.f, 0.f};
          acc = mma16(XA, 40, TB, 40, 32, acc);
#pragma unroll
          for (int i = 0; i < 4; ++i) PA[(4 * q + i) * 40 + r] = f2bf(acc[i]);
          asm volatile("s_waitcnt lgkmcnt(0)" ::: "memory");
          f32x4 acc2 = {0.f, 0.f, 0.f, 0.f};
          acc2 = mma16(PA, 40, XB, 40, 32, acc2);
#pragma unroll
          for (int i = 0; i < 4; ++i) TM[(16 + 4 * q + i) * 40 + r] = f2bf(-acc2[i]); }
    } else {
        if (ht == 64) *(float*)((unsigned char*)pack + 34816) = GS[64 + 31];
        for (int task = ht - 64; task < 2048; task += 192) {
            if (task < 1024) {
                const int row = task >> 2, p0 = (task & 3) * 8, d = row & 127; const LAS bf16_t* src = row < 128 ? KB : VB;
                float o[8];
#pragma unroll
                for (int e = 0; e < 8; ++e) { const int pp = p0 + e, ip = dir ? 31 - pp : pp; const float sc = GS[32 + pp] * (row < 128 ? GS[64 + pp] : 1.f); o[e] = bf2f(src[ip * 136 + d]) * sc; }
                u32x4 w; w.x = pg8::cvt_pk_bf16(o[0], o[1]); w.y = pg8::cvt_pk_bf16(o[2], o[3]); w.z = pg8::cvt_pk_bf16(o[4], o[5]); w.w = pg8::cvt_pk_bf16(o[6], o[7]);
                *(LAS u32x4*)(RT + row * 40 + p0) = w;
            } else if (task < 1536) {
                const int t2 = task - 1024, pp = t2 >> 4, d0 = (t2 & 15) * 8, ip = dir ? 31 - pp : pp; const float eg = GS[64 + pp];
                const u16x8 x = *(const LAS u16x8*)(QB + ip * 136 + d0);
                u32x4 w; w.x = pg8::cvt_pk_bf16(bf2f(x[0]) * eg, bf2f(x[1]) * eg); w.y = pg8::cvt_pk_bf16(bf2f(x[2]) * eg, bf2f(x[3]) * eg);
                w.z = pg8::cvt_pk_bf16(bf2f(x[4]) * eg, bf2f(x[5]) * eg); w.w = pg8::cvt_pk_bf16(bf2f(x[6]) * eg, bf2f(x[7]) * eg);
                *(u32x4*)(pack + 4096 + pp * 128 + d0) = w;
            } else {
                const int t2 = task - 1536, d = t2 >> 2, p0 = (t2 & 3) * 8;
                float o[8];
#pragma unroll
                for (int e = 0; e < 8; ++e) { const int pp = p0 + e, ip = dir ? 31 - pp : pp; o[e] = bf2f(KB[ip * 136 + d]) * GS[96 + pp]; }
                u32x4 w; w.x = pg8::cvt_pk_bf16(o[0], o[1]); w.y = pg8::cvt_pk_bf16(o[2], o[3]); w.z = pg8::cvt_pk_bf16(o[4], o[5]); w.w = pg8::cvt_pk_bf16(o[6], o[7]);
                *(u32x4*)(pack + 8192 + d * 32 + p0) = w;
            }
        }
    }
    __syncthreads();
    SUBSTAMP(lds, 38);
#pragma unroll
    for (int t = 0; t < 8; ++t) { const int id = hw * 8 + t, which = id >> 4, dt = (id >> 1) & 7, pt = id & 1, r = lane & 15, q = lane >> 4;
        f32x4 acc = {0.f, 0.f, 0.f, 0.f};
        acc = mma16(RT + (which * 128 + 16 * dt) * 40, 40, TM + 16 * pt * 40, 40, 32, acc);
        uint2 w; w.x = pack2_safe(acc[0], acc[1]); w.y = pack2_safe(acc[2], acc[3]);
        *(uint2*)(pack + (which ? 13312 : 0) + (16 * pt + r) * 128 + 16 * dt + 4 * q) = w; }
    __syncthreads();
    SUBSTAMP(lds, 39);
}
template <int PH> DI void hgrn_cols(const Params& p, const LAS bf16_t* RAW, LAS bf16_t* QT, LAS bf16_t* KT, LAS float* XS, bf16_t* pack, const float* lbs, int h, int dir, int d) {
    const float lb = lbs[h * 128 + d];
    float g[16], kv[16];
    float acc = 0.f;
#pragma unroll
    for (int e = 0; e < 16; ++e) { const int pp = PH * 16 + e, ip = dir ? 31 - pp : pp; const float fraw = bf2f(RAW[ip * 384 + 128 + dir * 128 + d]);
        const float f = lb + (1.0f - lb) * sigmoidf_(fraw); kv[e] = 1.0f - f; acc += __logf(f); g[e] = acc; }
    XS[PH * 128 + d] = acc;
    __syncthreads();
    const float oth = XS[(1 - PH) * 128 + d];
    const float gr = PH ? oth : acc, gl = acc + oth, egr = __expf(gr), eglr = __expf(gl - gr);
    if (PH == 1) ((float*)((unsigned char*)pack + 18432))[d] = __expf(gl);
    float kh[16];
#pragma unroll
    for (int e = 0; e < 16; ++e) {
        const int pp = PH * 16 + e, ip = dir ? 31 - pp : pp;
        const float ge = PH ? g[e] + oth : g[e];
        const float e1 = __expf(ge - gr), r1 = __builtin_amdgcn_rcpf(e1);
        const float qv = siluf_(bf2f(RAW[ip * 384 + d])) * 0.08838834764831845f;
        pack[1024 + pp * 128 + d] = f2bf(qv * e1 * egr);
        kh[e] = kv[e] * eglr * r1;
        QT[pp * 136 + d] = f2bf(qv * e1); KT[pp * 136 + d] = f2bf(kv[e] * r1);
    }
    u32x4 w0, w1;
    w0.x = pg8::cvt_pk_bf16(kh[0], kh[1]); w0.y = pg8::cvt_pk_bf16(kh[2], kh[3]); w0.z = pg8::cvt_pk_bf16(kh[4], kh[5]); w0.w = pg8::cvt_pk_bf16(kh[6], kh[7]);
    w1.x = pg8::cvt_pk_bf16(kh[8], kh[9]); w1.y = pg8::cvt_pk_bf16(kh[10], kh[11]); w1.z = pg8::cvt_pk_bf16(kh[12], kh[13]); w1.w = pg8::cvt_pk_bf16(kh[14], kh[15]);
    *(u32x4*)(pack + 5120 + d * 32 + PH * 16) = w0; *(u32x4*)(pack + 5120 + d * 32 + PH * 16 + 8) = w1;
}
DI void hgrn_prep_item(const Params& p, int gc, int h, const PrepRaw& R, LAS unsigned char* lds) {
    int tid_ = threadIdx.x; asm volatile("" : "+v"(tid_));
    const int tid = tid_, wid = __builtin_amdgcn_readfirstlane(tid >> 6), lane = tid & 63;
    LAS bf16_t* RAW = (LAS bf16_t*)lds;
    const float* lbs = (const float*)(p.ws + OFF_LBS);
#pragma unroll
    for (int k = 0; k < 3; ++k) *(LAS u32x4*)(RAW + (tid + k * 512) * 8) = R.v[k];
    __syncthreads();
    SUBSTAMP(lds, 40);
    const int dir = wid >> 2, ht = tid & 255, hw = wid & 3, d = ht & 127, ph = ht >> 7;
    LAS bf16_t* QT = (LAS bf16_t*)(lds + 24576 + dir * 17408); LAS bf16_t* KT = (LAS bf16_t*)(lds + 33280 + dir * 17408);
    bf16_t* pack = (bf16_t*)(p.ws + OFF_PACK + SZ_GPACK + ((size_t)(gc * 4 + h) * 2 + dir) * HG_PACK_B);
    LAS float* XS = (LAS float*)(lds + 59392 + dir * 1024);
    if (ph == 0) hgrn_cols<0>(p, RAW, QT, KT, XS, pack, lbs, h, dir, d); else hgrn_cols<1>(p, RAW, QT, KT, XS, pack, lbs, h, dir, d);
    __syncthreads();
    SUBSTAMP(lds, 41);
    { const int mt = hw >> 1, nt = hw & 1, r = lane & 15, q = lane >> 4;
      f32x4 acc = {0.f, 0.f, 0.f, 0.f};
      acc = mma16(QT + 16 * mt * 136, 136, KT + 16 * nt * 136, 136, 128, acc);
#pragma unroll
      for (int i = 0; i < 4; ++i) { const int pp = 16 * mt + 4 * q + i, s = 16 * nt + r; pack[pp * 32 + s] = f2bf(s <= pp ? acc[i] : 0.f); } }
    __syncthreads();
    SUBSTAMP(lds, 42);
}
DI void phase_prep(const Params& p, LAS unsigned char* lds) {
    const int G = gridDim.x, tid = threadIdx.x;
    LAS float* CW = (LAS float*)(lds + 117248);
    int cwh = -1;
    PrepRaw R;
    int pi = blockIdx.x;
    if (pi < 1024) prep_fetch(p, pi, 0, R);
#pragma unroll 1
    for (; pi < 1024; pi += G) {
        const int h = pi & 3, gc = pi >> 2;
        if (h != cwh) { __syncthreads(); for (int e = tid; e < 5 * 384; e += 512) { const int j = e / 384, c = e % 384; CW[e] = p.gdn_conv[j * 1536 + (c >> 7) * 512 + h * 128 + (c & 127)]; } cwh = h; }
        PrepRaw R2; prep_fetch(p, pi, 1, R2);
        gdn_prep_item(p, gc, h, R, lds);
        if (pi + G < 1024) prep_fetch(p, pi + G, 0, R);
        hgrn_prep_item(p, gc, h, R2, lds);
    }
}
struct ScanPre { u32x4 v[5]; };
template <bool GDN> DI void scan_fetch(const Params& p, const unsigned char* packb, int tok0, int h, int dir, ScanPre& R) {
    const int tid = threadIdx.x; const bf16_t* pack = (const bf16_t*)packb;
    if (GDN) { R.v[0] = *(const u32x4*)(pack + tid * 8); R.v[1] = *(const u32x4*)(pack + 4096 + tid * 8); R.v[2] = *(const u32x4*)(pack + 8192 + tid * 8);
        R.v[3] = *(const u32x4*)(pack + 13312 + tid * 8); R.v[4] = tid < 128 ? *(const u32x4*)(pack + 12288 + tid * 8) : *(const u32x4*)(packb + 34816); }
    else { R.v[0] = *(const u32x4*)(pack + 1024 + tid * 8); R.v[2] = *(const u32x4*)(pack + 5120 + tid * 8);
        { const int pp = tid >> 4, ip = dir ? 31 - pp : pp; R.v[1] = *(const u32x4*)((const bf16_t*)(p.ws + OFF_PROJ) + (size_t)(tok0 + ip) * NPROJ + 1536 + h * 128 + (tid & 15) * 8); }
        R.v[3] = tid < 32 ? *(const u32x4*)(packb + 18432 + tid * 16) : (u32x4){0u, 0u, 0u, 0u};
        R.v[4] = tid < 128 ? *(const u32x4*)(pack + tid * 8) : (u32x4){0u, 0u, 0u, 0u}; }
}
template <bool GDN> DI void scan_stash(LAS unsigned char* buf, const ScanPre& R) {
    const int tid = threadIdx.x, row = tid >> 4, c8 = (tid & 15) * 8, kr = tid >> 2, k8 = (tid & 3) * 8;
    *(LAS u32x4*)((LAS bf16_t*)buf + row * 136 + c8) = R.v[0];
    *(LAS u32x4*)((LAS bf16_t*)(buf + 8704) + row * 136 + c8) = R.v[1];
    *(LAS u32x4*)((LAS bf16_t*)(buf + 17408) + kr * 40 + k8) = R.v[2];
    if (GDN) { *(LAS u32x4*)((LAS bf16_t*)(buf + 30208) + row * 136 + c8) = R.v[3]; if (tid == 128) *(LAS unsigned*)(buf + 38912) = R.v[4].x; }
    else if (tid < 32) *(LAS u32x4*)(buf + 30208 + tid * 16) = R.v[3];
    if (tid < 128) *(LAS u32x4*)((LAS bf16_t*)(buf + 27648) + (tid >> 2) * 40 + k8) = R.v[4];
}
template <bool GDN> DI void scan_item(const Params& p, int s, int h, int dir, LAS unsigned char* lds) {
    int tid_ = threadIdx.x; asm volatile("" : "+v"(tid_));
    const int tid = tid_, wid = __builtin_amdgcn_readfirstlane(tid >> 6), lane = tid & 63, r = lane & 15, q = lane >> 4, dv0 = wid * 16;
    LAS bf16_t* ST = (LAS bf16_t*)(lds + 77856 + wid * 4352); LAS bf16_t* VN = (LAS bf16_t*)(lds + 112672 + wid * 1280);
    const int sstart = s < 16 ? s * 256 : 4096 + (s - 16) * 1024, N = s < 16 ? 8 : 32, gc0 = sstart >> 5;
    bf16_t* O = (bf16_t*)(p.ws + OFF_O) + (size_t)dir * NTOK * DM;
    const unsigned char* pbase = p.ws + OFF_PACK + (GDN ? 0 : SZ_GPACK);
    const size_t pstride = GDN ? GDN_PACK_B : HG_PACK_B;
    ScanPre Ra;
    auto fetch = [&](int mm, ScanPre& R) { if (mm < N) { const int nn = dir ? N - 1 - mm : mm; scan_fetch<GDN>(p, pbase + ((size_t)((gc0 + nn) * 4 + h) * 2 + dir) * pstride, sstart + 32 * nn, h, dir, R); } };
    fetch(0, Ra);
    f32x4 S[8];
    if (s >= 16) { const float* st = (GDN ? p.st_gdn : p.st_hgrn) + ((size_t)((s - 16) * 2 + dir) * 4 + h) * 16384;
#pragma unroll
        for (int i = 0; i < 8; ++i)
#pragma unroll
            for (int j = 0; j < 4; ++j) S[i][j] = st[(16 * i + 4 * q + j) * 128 + dv0 + r];
    } else {
#pragma unroll
        for (int i = 0; i < 8; ++i) S[i] = (f32x4){0.f, 0.f, 0.f, 0.f}; }
#pragma unroll
    for (int i = 0; i < 8; ++i) { u32x2 w; w.x = pack2_safe(S[i][0], S[i][1]); w.y = pack2_safe(S[i][2], S[i][3]); *(LAS u32x2*)(ST + r * 136 + 16 * i + 4 * q) = w; }
    __syncthreads();
    scan_stash<GDN>(lds, Ra);
#pragma unroll 1
    for (int m = 0; m < N; ++m) {
        const int n = dir ? N - 1 - m : m;
        LAS unsigned char* buf = lds + (m & 1) * 38928;
        LAS bf16_t* A0 = (LAS bf16_t*)buf; LAS bf16_t* A1 = (LAS bf16_t*)(buf + 8704); LAS bf16_t* KT = (LAS bf16_t*)(buf + 17408);
        LAS bf16_t* AT = (LAS bf16_t*)(buf + 27648); LAS bf16_t* U = (LAS bf16_t*)(buf + 30208); LAS float* av = (LAS float*)(buf + 30208);
        fetch(m + 1, Ra);
        if (m == 3) SUBSTAMP(lds, 44);
        __syncthreads();
        const float egl = GDN ? *(const LAS float*)(buf + 38912) : 1.f;
        if (m == 3) SUBSTAMP(lds, 45);
        const int fo = r * 136 + 8 * q, fk = r * 40 + 8 * q;
        bf16x8 bst[4], a0f[2][4], atf[2], ktf[8];
#pragma unroll
        for (int kk = 0; kk < 4; ++kk) { bst[kk] = *(const LAS bf16x8*)(ST + fo + 32 * kk); a0f[0][kk] = *(const LAS bf16x8*)(A0 + fo + 32 * kk); a0f[1][kk] = *(const LAS bf16x8*)(A0 + 16 * 136 + fo + 32 * kk); }
        atf[0] = *(const LAS bf16x8*)(AT + fk); atf[1] = *(const LAS bf16x8*)(AT + 16 * 40 + fk);
#pragma unroll
        for (int i = 0; i < 8; ++i) ktf[i] = *(const LAS bf16x8*)(KT + 16 * i * 40 + fk);
        if (GDN) {
            bf16x8 a1f[2][4];
#pragma unroll
            for (int kk = 0; kk < 4; ++kk) { a1f[0][kk] = *(const LAS bf16x8*)(A1 + fo + 32 * kk); a1f[1][kk] = *(const LAS bf16x8*)(A1 + 16 * 136 + fo + 32 * kk); }
            float uv[2][4];
#pragma unroll
            for (int mt = 0; mt < 2; ++mt)
#pragma unroll
                for (int i = 0; i < 4; ++i) uv[mt][i] = bf2f(U[(16 * mt + 4 * q + i) * 136 + dv0 + r]);
            __builtin_amdgcn_sched_barrier(0);
            f32x4 ws[2] = {{0.f, 0.f, 0.f, 0.f}, {0.f, 0.f, 0.f, 0.f}};
#pragma unroll
            for (int kk = 0; kk < 4; ++kk) { ws[0] = __builtin_amdgcn_mfma_f32_16x16x32_bf16(a0f[0][kk], bst[kk], ws[0], 0, 0, 0); ws[1] = __builtin_amdgcn_mfma_f32_16x16x32_bf16(a0f[1][kk], bst[kk], ws[1], 0, 0, 0); }
#pragma unroll
            for (int mt = 0; mt < 2; ++mt) { u32x2 w; w.x = pack2_safe(uv[mt][0] - ws[mt][0], uv[mt][1] - ws[mt][1]); w.y = pack2_safe(uv[mt][2] - ws[mt][2], uv[mt][3] - ws[mt][3]);
                *(LAS u32x2*)(VN + r * 40 + 16 * mt + 4 * q) = w; }
            f32x4 oo[2] = {{0.f, 0.f, 0.f, 0.f}, {0.f, 0.f, 0.f, 0.f}};
#pragma unroll
            for (int kk = 0; kk < 4; ++kk) { oo[0] = __builtin_amdgcn_mfma_f32_16x16x32_bf16(a1f[0][kk], bst[kk], oo[0], 0, 0, 0); oo[1] = __builtin_amdgcn_mfma_f32_16x16x32_bf16(a1f[1][kk], bst[kk], oo[1], 0, 0, 0); }
#pragma unroll
            for (int i = 0; i < 8; ++i) S[i] = S[i] * egl;
            asm volatile("s_waitcnt lgkmcnt(0)" ::: "memory");
            const bf16x8 bvn = *(const LAS bf16x8*)(VN + fk);
            oo[0] = __builtin_amdgcn_mfma_f32_16x16x32_bf16(atf[0], bvn, oo[0], 0, 0, 0); oo[1] = __builtin_amdgcn_mfma_f32_16x16x32_bf16(atf[1], bvn, oo[1], 0, 0, 0);
#pragma unroll
            for (int i = 0; i < 8; ++i) S[i] = __builtin_amdgcn_mfma_f32_16x16x32_bf16(ktf[i], bvn, S[i], 0, 0, 0);
#pragma unroll
            for (int mt = 0; mt < 2; ++mt)
#pragma unroll
                for (int i = 0; i < 4; ++i) { const int pp = 16 * mt + 4 * q + i, ip = dir ? 31 - pp : pp;
                    O[(size_t)(sstart + 32 * n + ip) * DM + 512 + h * 128 + dv0 + r] = f2bf(oo[mt][i]); }
        } else {
            { const int pp = lane >> 1, d8 = (lane & 1) * 8; const u16x8 x = *(const LAS u16x8*)(A1 + pp * 136 + dv0 + d8);
#pragma unroll
              for (int e = 0; e < 8; ++e) VN[(d8 + e) * 40 + pp] = x[e]; }
            f32x4 a4[8];
#pragma unroll
            for (int i = 0; i < 8; ++i) a4[i] = *(const LAS f32x4*)(av + 16 * i + 4 * q);
            __builtin_amdgcn_sched_barrier(0);
            f32x4 oo[2] = {{0.f, 0.f, 0.f, 0.f}, {0.f, 0.f, 0.f, 0.f}};
#pragma unroll
            for (int kk = 0; kk < 4; ++kk) { oo[0] = __builtin_amdgcn_mfma_f32_16x16x32_bf16(a0f[0][kk], bst[kk], oo[0], 0, 0, 0); oo[1] = __builtin_amdgcn_mfma_f32_16x16x32_bf16(a0f[1][kk], bst[kk], oo[1], 0, 0, 0); }
#pragma unroll
            for (int i = 0; i < 8; ++i) S[i] = S[i] * a4[i];
            asm volatile("s_waitcnt lgkmcnt(0)" ::: "memory");
            const bf16x8 bvn = *(const LAS bf16x8*)(VN + fk);
            oo[0] = __builtin_amdgcn_mfma_f32_16x16x32_bf16(atf[0], bvn, oo[0], 0, 0, 0); oo[1] = __builtin_amdgcn_mfma_f32_16x16x32_bf16(atf[1], bvn, oo[1], 0, 0, 0);
#pragma unroll
            for (int i = 0; i < 8; ++i) S[i] = __builtin_amdgcn_mfma_f32_16x16x32_bf16(ktf[i], bvn, S[i], 0, 0, 0);
#pragma unroll
            for (int mt = 0; mt < 2; ++mt)
#pragma unroll
                for (int i = 0; i < 4; ++i) { const int pp = 16 * mt + 4 * q + i, ip = dir ? 31 - pp : pp;
                    O[(size_t)(sstart + 32 * n + ip) * DM + h * 128 + dv0 + r] = f2bf(oo[mt][i]); }
        }
        if (m == 3) SUBSTAMP(lds, 46);
        asm volatile("s_waitcnt lgkmcnt(0)" ::: "memory");
#pragma unroll
        for (int i = 0; i < 8; ++i) { u32x2 w; w.x = pack2_safe(S[i][0], S[i][1]); w.y = pack2_safe(S[i][2], S[i][3]); *(LAS u32x2*)(ST + r * 136 + 16 * i + 4 * q) = w; }
        if (m == 3) SUBSTAMP(lds, 47);
        if (m + 1 < N) scan_stash<GDN>(lds + ((m + 1) & 1) * 38928, Ra);
        if (m == 3) SUBSTAMP(lds, 48);
        if (m == 4) SUBSTAMP(lds, 49);
        (void)U; (void)av;
    }
    if (s < 16) { float* so = p.out + (size_t)NTOK * DM + (GDN ? (size_t)2097152 : 0) + ((size_t)(s * 2 + dir) * 4 + h) * 16384;
#pragma unroll
        for (int i = 0; i < 8; ++i)
#pragma unroll
            for (int j = 0; j < 4; ++j) so[(16 * i + 4 * q + j) * 128 + dv0 + r] = S[i][j]; }
    __syncthreads();
}
DI void scan_dispatch(const Params& p, int it, LAS unsigned char* lds) {
    int mixer, dir, h, s;
    if (it < 64) { mixer = it & 1; dir = (it >> 1) & 1; h = (it >> 2) & 3; s = 16 + (it >> 4); }
    else { const int si = it - 64; mixer = si & 1; dir = (si >> 1) & 1; h = (si >> 2) & 3; s = si >> 4; }
    if (mixer) scan_item<true>(p, s, h, dir, lds); else scan_item<false>(p, s, h, dir, lds);
}
DI void phase_scan(const Params& p, LAS unsigned char* lds) {
    const int b = blockIdx.x, G = gridDim.x;
    if (G == 256) { scan_dispatch(p, b, lds); if (b >= 64 && b < 128) scan_dispatch(p, 256 + b - 64, lds); if (b >= 128) helper_scan(p, lds, b - 128, 128); }
    else { for (int it = b; it < 320; it += G) scan_dispatch(p, it, lds); helper_scan(p, lds, b, G); }
}
DI void phase_combine(const Params& p) {
    int tid_ = threadIdx.x; asm volatile("" : "+v"(tid_));
    const int tid = tid_, wid = tid >> 6, lane = tid & 63;
    const bf16_t* O0 = (const bf16_t*)(p.ws + OFF_O); const bf16_t* O1 = O0 + (size_t)NTOK * DM;
    const bf16_t* proj = (const bf16_t*)(p.ws + OFF_PROJ);
    bf16_t* H = (bf16_t*)(p.ws + OFF_H);
    const int mixer = lane >> 5, d0 = (lane & 7) * 16, gcol = (mixer ? 4096 : 2048) + ((16 * lane) & 511);
    const float* gn = (mixer ? p.gn_gdn : p.gn_hgrn) + d0;
    for (int tok = blockIdx.x * 8 + wid; tok < NTOK; tok += gridDim.x * 8) {
        const u16x8 a0 = *(const u16x8*)(O0 + (size_t)tok * DM + 16 * lane), a1 = *(const u16x8*)(O0 + (size_t)tok * DM + 16 * lane + 8);
        const u16x8 b0 = *(const u16x8*)(O1 + (size_t)tok * DM + 16 * lane), b1 = *(const u16x8*)(O1 + (size_t)tok * DM + 16 * lane + 8);
        const u16x8 g0 = *(const u16x8*)(proj + (size_t)tok * NPROJ + gcol), g1 = *(const u16x8*)(proj + (size_t)tok * NPROJ + gcol + 8);
        float v[16]; float ss = 0.f;
#pragma unroll
        for (int j = 0; j < 8; ++j) { v[j] = bf2f(a0[j]) + bf2f(b0[j]); v[8 + j] = bf2f(a1[j]) + bf2f(b1[j]); }
#pragma unroll
        for (int j = 0; j < 16; ++j) ss += v[j] * v[j];
        ss += __shfl_xor(ss, 1); ss += __shfl_xor(ss, 2); ss += __shfl_xor(ss, 4);
        const float rs = rsqrtf(ss * (1.0f / 128.0f) + 1e-6f);
        unsigned w[8];
#pragma unroll
        for (int j = 0; j < 8; ++j) { const float ga = bf2f(j < 4 ? g0[2 * j] : g1[2 * j - 8]), gb = bf2f(j < 4 ? g0[2 * j + 1] : g1[2 * j - 7]);
            w[j] = pg8::cvt_pk_bf16(v[2 * j] * rs * gn[2 * j] * siluf_(ga), v[2 * j + 1] * rs * gn[2 * j + 1] * siluf_(gb)); }
        *(u32x4*)(H + (size_t)tok * DM + 16 * lane) = (u32x4){w[0], w[1], w[2], w[3]};
        *(u32x4*)(H + (size_t)tok * DM + 16 * lane + 8) = (u32x4){w[4], w[5], w[6], w[7]};
    }
}
DI void phase_qknorm(const Params& p) {
    int tid_ = threadIdx.x; asm volatile("" : "+v"(tid_));
    const int tid = tid_, wid = tid >> 6, lane = tid & 63;
    const bf16_t* QKV = (const bf16_t*)(p.ws + OFF_PROJ);
    bf16_t* QN = (bf16_t*)(p.ws + OFF_O); bf16_t* KN = QN + (size_t)NTOK * DM;
    float* ck = p.out + (size_t)NTOK * DM + 2 * 2097152; float* cv = ck + 4194304;
    const int hd = lane >> 2, d0 = (lane & 3) * 16;
    for (int tok = blockIdx.x * 8 + wid; tok < NTOK; tok += gridDim.x * 8) {
#pragma unroll
        for (int part = 0; part < 2; ++part) {
            const bf16_t* src = QKV + (size_t)tok * 3072 + part * 1024 + 16 * lane;
            const u16x8 a0 = *(const u16x8*)src, a1 = *(const u16x8*)(src + 8);
            float v[16]; float ss = 0.f;
#pragma unroll
            for (int j = 0; j < 8; ++j) { v[j] = bf2f(a0[j]); v[8 + j] = bf2f(a1[j]); }
#pragma unroll
            for (int j = 0; j < 16; ++j) ss += v[j] * v[j];
            ss += __shfl_xor(ss, 1); ss += __shfl_xor(ss, 2);
            const float rs = rsqrtf(ss * (1.0f / 64.0f) + 1e-6f);
            const float* gw = (part ? p.kn : p.qn) + d0;
#pragma unroll
            for (int j = 0; j < 16; ++j) v[j] = v[j] * rs * gw[j];
            unsigned w[8];
#pragma unroll
            for (int j = 0; j < 8; ++j) w[j] = pg8::cvt_pk_bf16(v[2 * j], v[2 * j + 1]);
            bf16_t* dst = (part ? KN : QN) + (size_t)tok * DM + 16 * lane;
            *(u32x4*)dst = (u32x4){w[0], w[1], w[2], w[3]}; *(u32x4*)(dst + 8) = (u32x4){w[4], w[5], w[6], w[7]};
            if (part == 1 && tok < 4096) { float* o = ck + (((size_t)(tok >> 8) * 16 + hd) * 256 + (tok & 255)) * 64 + d0;
#pragma unroll
                for (int j4 = 0; j4 < 4; ++j4) *(f32x4*)(o + 4 * j4) = (f32x4){v[4 * j4], v[4 * j4 + 1], v[4 * j4 + 2], v[4 * j4 + 3]}; }
        }
        if (tok < 4096) { const bf16_t* src = QKV + (size_t)tok * 3072 + 2048 + 16 * lane;
            const u16x8 a0 = *(const u16x8*)src, a1 = *(const u16x8*)(src + 8);
            float* o = cv + (((size_t)(tok >> 8) * 16 + hd) * 256 + (tok & 255)) * 64 + d0;
            *(f32x4*)(o) = (f32x4){bf2f(a0[0]), bf2f(a0[1]), bf2f(a0[2]), bf2f(a0[3])}; *(f32x4*)(o + 4) = (f32x4){bf2f(a0[4]), bf2f(a0[5]), bf2f(a0[6]), bf2f(a0[7])};
            *(f32x4*)(o + 8) = (f32x4){bf2f(a1[0]), bf2f(a1[1]), bf2f(a1[2]), bf2f(a1[3])}; *(f32x4*)(o + 12) = (f32x4){bf2f(a1[4]), bf2f(a1[5]), bf2f(a1[6]), bf2f(a1[7])}; }
    }
}
struct AStage { const bf16_t* kb; const bf16_t* vb; int ks, vs, nkeys; };
DI void attn_fetch(const AStage& d, u32x4 (&kv)[8]) {
    const int tid = threadIdx.x;
#pragma unroll
    for (int k = 0; k < 4; ++k) { const int pc = tid + k * 512, key = pc >> 3, c8 = (pc & 7) * 8;
        if (key < d.nkeys) { kv[k] = *(const u32x4*)(d.kb + (size_t)key * d.ks + c8); kv[4 + k] = *(const u32x4*)(d.vb + (size_t)key * d.vs + c8); } }
}
DI void attn_stash(LAS unsigned char* lds, const u32x4 (&kv)[8], int nkeys, const float* kn, float* ck, float* cv) {
    const int tid = threadIdx.x; LAS bf16_t* KB = (LAS bf16_t*)lds; LAS bf16_t* VT = (LAS bf16_t*)(lds + 36864);
#pragma unroll
    for (int k = 0; k < 4; ++k) { const int pc = tid + k * 512, key = pc >> 3, c8 = (pc & 7) * 8;
        if (key < nkeys) {
            u32x4 kq = kv[k];
            if (kn) {
                float x[8]; float ss = 0.f;
#pragma unroll
                for (int j = 0; j < 4; ++j) { x[2 * j] = __uint_as_float(kq[j] << 16); x[2 * j + 1] = __uint_as_float(kq[j] & 0xFFFF0000u); ss += x[2 * j] * x[2 * j] + x[2 * j + 1] * x[2 * j + 1]; }
                ss += __shfl_xor(ss, 1); ss += __shfl_xor(ss, 2); ss += __shfl_xor(ss, 4);
                const float rs = rsqrtf(ss * (1.0f / 64.0f) + 1e-6f);
                const f32x4 w0 = *(const f32x4*)(kn + c8), w1 = *(const f32x4*)(kn + c8 + 4);
#pragma unroll
                for (int j = 0; j < 4; ++j) { x[j] *= rs * w0[j]; x[4 + j] *= rs * w1[j]; }
                kq = (u32x4){pack2_safe(x[0], x[1]), pack2_safe(x[2], x[3]), pack2_safe(x[4], x[5]), pack2_safe(x[6], x[7])};
                if (ck) { float* o = ck + (size_t)key * 64 + c8; *(f32x4*)o = (f32x4){x[0], x[1], x[2], x[3]}; *(f32x4*)(o + 4) = (f32x4){x[4], x[5], x[6], x[7]};
                    float* ov = cv + (size_t)key * 64 + c8; const u32x4 vv = kv[4 + k];
                    *(f32x4*)ov = (f32x4){__uint_as_float(vv[0] << 16), __uint_as_float(vv[0] & 0xFFFF0000u), __uint_as_float(vv[1] << 16), __uint_as_float(vv[1] & 0xFFFF0000u)};
                    *(f32x4*)(ov + 4) = (f32x4){__uint_as_float(vv[2] << 16), __uint_as_float(vv[2] & 0xFFFF0000u), __uint_as_float(vv[3] << 16), __uint_as_float(vv[3] & 0xFFFF0000u)}; }
            }
            *(LAS u32x4*)(KB + key * 72 + c8) = kq;
#pragma unroll
            for (int j = 0; j < 4; ++j) { VT[(c8 + 2 * j) * 264 + key] = (bf16_t)(kv[4 + k][j] & 0xFFFFu); VT[(c8 + 2 * j + 1) * 264 + key] = (bf16_t)(kv[4 + k][j] >> 16); } } }
}
DI void attn_qfrag(const bf16_t* qrow, const float* qn, bf16x8 (&qf)[2]) {
    const int lane = threadIdx.x & 63, q = lane >> 4;
    const u32x4 a = *(const u32x4*)(qrow + 8 * q), b = *(const u32x4*)(qrow + 32 + 8 * q);
    float x[16]; float ss = 0.f;
#pragma unroll
    for (int j = 0; j < 4; ++j) { x[2 * j] = __uint_as_float(a[j] << 16); x[2 * j + 1] = __uint_as_float(a[j] & 0xFFFF0000u); x[8 + 2 * j] = __uint_as_float(b[j] << 16); x[9 + 2 * j] = __uint_as_float(b[j] & 0xFFFF0000u); }
#pragma unroll
    for (int j = 0; j < 16; ++j) ss += x[j] * x[j];
    ss += __shfl_xor(ss, 16); ss += __shfl_xor(ss, 32);
    const float rs = rsqrtf(ss * (1.0f / 64.0f) + 1e-6f);
    const f32x4 w0 = *(const f32x4*)(qn + 8 * q), w1 = *(const f32x4*)(qn + 8 * q + 4), w2 = *(const f32x4*)(qn + 32 + 8 * q), w3 = *(const f32x4*)(qn + 36 + 8 * q);
#pragma unroll
    for (int j = 0; j < 4; ++j) { x[j] *= rs * w0[j]; x[4 + j] *= rs * w1[j]; x[8 + j] *= rs * w2[j]; x[12 + j] *= rs * w3[j]; }
    qf[0] = __builtin_bit_cast(bf16x8, (u32x4){pack2_safe(x[0], x[1]), pack2_safe(x[2], x[3]), pack2_safe(x[4], x[5]), pack2_safe(x[6], x[7])});
    qf[1] = __builtin_bit_cast(bf16x8, (u32x4){pack2_safe(x[8], x[9]), pack2_safe(x[10], x[11]), pack2_safe(x[12], x[13]), pack2_safe(x[14], x[15])});
}
struct AttnState { f32x4 o[4]; float m, l; };
DI void attn_init(AttnState& st) {
#pragma unroll
    for (int i = 0; i < 4; ++i) st.o[i] = (f32x4){0.f, 0.f, 0.f, 0.f};
    st.m = -1e30f; st.l = 0.f;
}
DI void attn_tile(AttnState& st, const bf16x8 (&qf)[2], LAS unsigned char* lds, int wid, int mode, int nkeys, int krow0, int rsW, int rw, int ct) {
    const int lane = threadIdx.x & 63, r = lane & 15, q = lane >> 4;
    const LAS bf16_t* KB = (const LAS bf16_t*)lds; const LAS bf16_t* VT = (const LAS bf16_t*)(lds + 36864);
    const LAS float* RPB = (const LAS float*)(lds + 105472);
    const int c = ct * 16 + r, cs = c - 8 < 0 ? 0 : (c - 8 > 48 ? 48 : c - 8);
#pragma unroll 1
    for (int hf = 0; hf < 2; ++hf) {
      if (128 * hf < nkeys) {
        f32x4 sc[8];
#pragma unroll
        for (int g2 = 0; g2 < 2; ++g2) {
            const int g = 2 * hf + g2;
            bool act = (64 * g < nkeys);
            const int krow = krow0 + g;
            if (mode == 2) act = act && (krow >= rsW) && (krow < rsW + 8);
            if (act) {
#pragma unroll
                for (int n2 = 0; n2 < 4; n2 += 2) {
                    bf16x8 kf[2][2];
#pragma unroll
                    for (int n = 0; n < 2; ++n) { kf[n][0] = *(const LAS bf16x8*)(KB + (64 * g + 16 * (n2 + n) + r) * 72 + 8 * q); kf[n][1] = *(const LAS bf16x8*)(KB + (64 * g + 16 * (n2 + n) + r) * 72 + 32 + 8 * q); }
#pragma unroll
                    for (int nn = 0; nn < 2; ++nn) { const int n = n2 + nn; f32x4 a = {0.f, 0.f, 0.f, 0.f};
                        a = __builtin_amdgcn_mfma_f32_16x16x32_bf16(kf[nn][0], qf[0], a, 0, 0, 0); a = __builtin_amdgcn_mfma_f32_16x16x32_bf16(kf[nn][1], qf[1], a, 0, 0, 0);
                        if (mode == 2) {
                            const LAS float* rp = RPB + (krow - rw + 7) * 31 + 15 - c;
#pragma unroll
                            for (int i = 0; i < 4; ++i) { const int kc = 16 * n + 4 * q + i; const bool valid = kc >= cs && kc < cs + 16;
                                a[i] = valid ? a[i] * 0.125f + rp[valid ? kc : c] : -1e30f; }
                        } else a = a * 0.125f;
                        sc[4 * g2 + n] = a; }
                }
            } else {
#pragma unroll
                for (int n = 0; n < 4; ++n) sc[4 * g2 + n] = (f32x4){-1e30f, -1e30f, -1e30f, -1e30f}; }
        }
        float mx = sc[0][0];
#pragma unroll
        for (int n = 0; n < 8; ++n)
#pragma unroll
            for (int i = 0; i < 4; ++i) mx = fmaxf(mx, sc[n][i]);
        mx = fmaxf(mx, __shfl_xor(mx, 16)); mx = fmaxf(mx, __shfl_xor(mx, 32));
        const float mn = fmaxf(st.m, mx), alpha = __expf(st.m - mn); st.m = mn;
        float rsum = 0.f;
#pragma unroll
        for (int n = 0; n < 8; ++n)
#pragma unroll
            for (int i = 0; i < 4; ++i) { const float pv = __expf(sc[n][i] - mn); sc[n][i] = pv; rsum += pv; }
        rsum += __shfl_xor(rsum, 16); rsum += __shfl_xor(rsum, 32);
        st.l = st.l * alpha + rsum;
#pragma unroll
        for (int dt = 0; dt < 4; ++dt) st.o[dt] = st.o[dt] * alpha;
#pragma unroll
        for (int kk = 0; kk < 4; ++kk) {
            u32x4 pw; pw.x = pack2_safe(sc[2 * kk][0], sc[2 * kk][1]); pw.y = pack2_safe(sc[2 * kk][2], sc[2 * kk][3]); pw.z = pack2_safe(sc[2 * kk + 1][0], sc[2 * kk + 1][1]); pw.w = pack2_safe(sc[2 * kk + 1][2], sc[2 * kk + 1][3]);
            const bf16x8 pb = __builtin_bit_cast(bf16x8, pw);
#pragma unroll
            for (int dt = 0; dt < 4; ++dt) { const LAS bf16_t* vp = VT + (16 * dt + r) * 264 + 128 * hf + 32 * kk + 4 * q;
                const u32x2 v0 = *(const LAS u32x2*)vp, v1 = *(const LAS u32x2*)(vp + 16);
                const bf16x8 va = __builtin_bit_cast(bf16x8, (u32x4){v0.x, v0.y, v1.x, v1.y});
                st.o[dt] = __builtin_amdgcn_mfma_f32_16x16x32_bf16(va, pb, st.o[dt], 0, 0, 0); }
        }
      }
    }
    (void)wid;
}
DI void attn_out(const AttnState& st, bf16_t* AO, int qtok0, int h) {
    const int lane = threadIdx.x & 63, r = lane & 15, q = lane >> 4;
    const float il = 1.0f / st.l;
#pragma unroll
    for (int dt = 0; dt < 4; ++dt) { u32x2 w; w.x = pack2_safe(st.o[dt][0] * il, st.o[dt][1] * il); w.y = pack2_safe(st.o[dt][2] * il, st.o[dt][3] * il);
        *(u32x2*)(AO + (size_t)(qtok0 + r) * DM + h * 64 + 16 * dt + 4 * q) = w; }
}
DI void phase_attn(const Params& p, LAS unsigned char* lds) {
    int tid_ = threadIdx.x; asm volatile("" : "+v"(tid_));
    const int tid = tid_, wid = __builtin_amdgcn_readfirstlane(tid >> 6), lane = tid & 63, r = lane & 15, q = lane >> 4;
    const bf16_t* QKV = (const bf16_t*)(p.ws + OFF_PROJ);
    const bf16_t* CK = (const bf16_t*)(p.ws + OFF_CK); const bf16_t* CV = CK + (size_t)4 * 16 * 256 * 64;
    bf16_t* AO = (bf16_t*)(p.ws + OFF_H2);
    LAS float* RPB = (LAS float*)(lds + 105472);
    u32x4 kv[8];
    SUBSTAMP(lds, 50);
    for (int it = blockIdx.x; it < 256; it += gridDim.x) {
        const int b = it >> 4, h = it & 15;
        AStage d; d.kb = QKV + (size_t)(b * 256) * 3072 + 1024 + h * 64; d.ks = 3072; d.vb = QKV + (size_t)(b * 256) * 3072 + 2048 + h * 64; d.vs = 3072; d.nkeys = 256;
        attn_fetch(d, kv);
        bf16x8 qf[2][2];
#pragma unroll
        for (int t = 0; t < 2; ++t) attn_qfrag(QKV + (size_t)(b * 256 + wid * 32 + t * 16 + r) * 3072 + h * 64, p.qn, qf[t]);
        __syncthreads();
        { float* ck = p.out + (size_t)NTOK * DM + 2 * 2097152 + (size_t)((b * 16 + h) * 256) * 64; attn_stash(lds, kv, 256, p.kn, ck, ck + 4194304); }
        __syncthreads();
#pragma unroll
        for (int t = 0; t < 2; ++t) { AttnState st; attn_init(st); attn_tile(st, qf[t], lds, wid, 0, 256, 0, 0, 0, 0); attn_out(st, AO, b * 256 + wid * 32 + t * 16, h); }
    }
    SUBSTAMP(lds, 51);
    for (int it = blockIdx.x; it < 512; it += gridDim.x) {
        const int b = it >> 7, h = (it >> 3) & 15, rp = it & 7, r0 = 2 * rp, rw = r0 + (wid >> 2), ct = wid & 3;
        const int rsA = r0 - 4 < 0 ? 0 : (r0 - 4 > 8 ? 8 : r0 - 4), r1 = r0 + 1, rsB = r1 - 4 < 0 ? 0 : (r1 - 4 > 8 ? 8 : r1 - 4);
        const int rsW = (wid >> 2) ? rsB : rsA, nwin = rsB + 8 - rsA, nst = 1 + (nwin + 3) / 4;
        const int qtok0 = 4096 + b * 1024 + rw * 64 + ct * 16;
        auto desc = [&](int s) { AStage d;
            if (s == 0) { d.kb = CK + (size_t)((b * 16 + h) * 256) * 64; d.ks = 64; d.vb = CV + (size_t)((b * 16 + h) * 256) * 64; d.vs = 64; d.nkeys = 256; }
            else { const int kr0 = rsA + 4 * (s - 1), nr = (nwin - 4 * (s - 1)) < 4 ? (nwin - 4 * (s - 1)) : 4; const size_t tok0 = 4096 + b * 1024 + kr0 * 64;
                d.kb = QKV + tok0 * 3072 + 1024 + h * 64; d.ks = 3072; d.vb = QKV + tok0 * 3072 + 2048 + h * 64; d.vs = 3072; d.nkeys = nr * 64; }
            return d; };
        AStage d0 = desc(0);
        attn_fetch(d0, kv);
        bf16x8 qf[2];
        attn_qfrag(QKV + (size_t)(qtok0 + r) * 3072 + h * 64, p.qn, qf);
        AttnState st; attn_init(st);
        __syncthreads();
        if (tid < 465) RPB[tid] = p.rpb[h * 465 + tid];
#pragma unroll 1
        for (int s = 0; s < nst; ++s) {
            const AStage d = desc(s);
            if (s) __syncthreads();
            if (s == 1) SUBSTAMP(lds, 53);
            attn_stash(lds, kv, d.nkeys, s ? p.kn : nullptr, nullptr, nullptr);
            if (s == 1) SUBSTAMP(lds, 54);
            if (s + 1 < nst) { const AStage dn = desc(s + 1); attn_fetch(dn, kv); }
            __syncthreads();
            if (s == 1) SUBSTAMP(lds, 55);
            attn_tile(st, qf, lds, wid, s == 0 ? 0 : 2, d.nkeys, rsA + 4 * (s - 1), rsW, rw, ct);
            if (s == 1) SUBSTAMP(lds, 56);
        }
        attn_out(st, AO, qtok0, h);
    }
    SUBSTAMP(lds, 52);
}
#define XB_TMO      128
#define XB_XCNT(j)  (256  + 64 * (j))
#define XB_XSUB(j)  (1280 + 64 * (j))
#define XB_XGEN(j)  (2304 + 64 * (j))
#define XB_TOP      3328
#define XB_TOPGEN   3392
#define XCD_BAR_WORDS 3456
#define XB_SPIN_CAP (1u << 18)

__device__ __forceinline__ unsigned xb_ld(unsigned* p)              { return __hip_atomic_load(p, __ATOMIC_RELAXED, __HIP_MEMORY_SCOPE_AGENT); }
__device__ __forceinline__ unsigned xb_add(unsigned* p, unsigned v) { return __hip_atomic_fetch_add(p, v, __ATOMIC_RELAXED, __HIP_MEMORY_SCOPE_AGENT); }
__device__ __forceinline__ unsigned xb_xcc_id() { return (unsigned)__builtin_amdgcn_s_getreg((3 << 11) | 20) & 0xFu; }
#define XB_SPIN(cond, bar) do { unsigned _sp = 0; while (cond) { __builtin_amdgcn_s_sleep(1); \
    if ((++_sp & 255u) == 0u) { if (xb_ld(&(bar)[XB_TMO])) break; if (_sp > XB_SPIN_CAP) { atomicAdd(&(bar)[XB_TMO], 1u); break; } } } } while (0)

struct XcdBarrier {
    unsigned* bar; unsigned x;
    volatile LAS unsigned* st;
};

__device__ __forceinline__ XcdBarrier xcd_barrier_post(unsigned* bar, volatile LAS unsigned* st) {
    XcdBarrier b; b.bar = bar; b.x = xb_xcc_id(); b.st = st;
    if (threadIdx.x == 0) (void)xb_add(&bar[XB_XCNT(b.x)], 1u);
    return b;
}
__device__ __forceinline__ void xcd_barrier_complete(unsigned* bar, unsigned x, unsigned& nloc, unsigned& nx) {
    const unsigned G = gridDim.x * gridDim.y * gridDim.z;
    unsigned sum, cnt, mine, sp = 0u;
    for (;;) {
        sum = 0u; cnt = 0u; mine = 0u;
#pragma unroll
        for (unsigned j = 0; j < 16; ++j) { const unsigned c = xb_ld(&bar[XB_XCNT(j)]); sum += c; cnt += (c > 0u) ? 1u : 0u; mine = (j == x) ? c : mine; }
        if (sum == G) break;
        __builtin_amdgcn_s_sleep(1);
        if ((++sp & 255u) == 0u) { if (xb_ld(&bar[XB_TMO])) break; if (sp > XB_SPIN_CAP) { atomicAdd(&bar[XB_TMO], 1u); break; } }
    }
    nloc = mine > 0u ? mine : 1u; nx = cnt > 0u ? cnt : 1u;
}

__device__ __forceinline__ void xcd_barrier(const XcdBarrier& b) {
    asm volatile("s_waitcnt vmcnt(0)" ::: "memory");
    __syncthreads();
    if (threadIdx.x == 0) {
        unsigned* bar = b.bar;
        __builtin_amdgcn_s_waitcnt(0);
        unsigned nloc = b.st[0], nx = b.st[1];
        if (nloc == 0u) { xcd_barrier_complete(bar, b.x, nloc, nx); b.st[0] = nloc; b.st[1] = nx; }
        const unsigned old = xb_add(&bar[XB_XSUB(b.x)], 1u);
        const unsigned gen = old / nloc;
        if (old + 1u == (gen + 1u) * nloc) {
            __builtin_amdgcn_fence(__ATOMIC_RELEASE, "agent");
            asm volatile("s_waitcnt vmcnt(0)" ::: "memory");
            const unsigned og = xb_add(&bar[XB_TOP], 1u);
            const unsigned tg = og / nx;
            if (og + 1u == (tg + 1u) * nx) xb_add(&bar[XB_TOPGEN], 1u);
            else XB_SPIN(xb_ld(&bar[XB_TOPGEN]) == tg, bar);
            __builtin_amdgcn_fence(__ATOMIC_ACQUIRE, "agent");
            xb_add(&bar[XB_XGEN(b.x)], 1u);
            asm volatile("s_waitcnt vmcnt(0)" ::: "memory");
        } else {
            XB_SPIN(xb_ld(&bar[XB_XGEN(b.x)]) == gen, bar);
            __builtin_amdgcn_fence(__ATOMIC_ACQUIRE, "agent");
            asm volatile("s_waitcnt vmcnt(0)" ::: "memory");
        }
    }
    __syncthreads();
}

#ifndef PROBE_GEMM
#define PROBE_GEMM -1
#define PROBE_GA 3
#define PROBE_GB 4
#endif
constexpr size_t OFF_STAMP = OFF_CB + (size_t)5 * (4096 + 3072 + 4096) * 4;
template <int ID = -2, class Epi> DI void gemm(LAS unsigned char* lds, const bf16_t* A, const bf16_t* Bt, int N, int K, const Epi& E, unsigned char* ws = nullptr) {
    pg8::Gemm g; g.A = A; g.Bt = Bt; g.M = NTOK; g.N = N; g.K = K;
    pg8::StaticOrder S; S.init(NTOK, N, gridDim.x, blockIdx.x);
    if (ID == PROBE_GEMM) pg8::gemm_phase<Epi, pg8::StaticOrder, true>(lds, g, S, E, (unsigned long long*)(ws + OFF_STAMP) + (size_t)blockIdx.x * 64);
    else pg8::gemm_phase<Epi, pg8::StaticOrder, false>(lds, g, S, E, nullptr);
}
template <int PHX, class Inner> DI void gemm_split(LAS unsigned char* lds, const bf16_t* A, const bf16_t* Bt, int K, const Inner& in, unsigned char* ws) {
    if (gridDim.x == 256) {
        const int kh = (blockIdx.x >> 3) & 1;
        pg8::Gemm g; g.A = A + (size_t)kh * (K / 2); g.Bt = Bt + (size_t)kh * (K / 2); g.M = NTOK; g.N = 1024; g.K = K / 2; g.ld = K; g.aswap = kh;
        pg8::SplitOrder S; S.c = blockIdx.x;
        pg8::EpiSplit<Inner> E; E.in = in; E.slab = (float*)(ws + OFF_O); E.flags = (unsigned*)(ws + OFF_FLAG) + PHX * 256;
        pg8::gemm_phase<pg8::EpiSplit<Inner>, pg8::SplitOrder, false>(lds, g, S, E, nullptr);
    } else gemm(lds, A, Bt, 1024, K, in);
}
#define GSYNC(n) do { xcd_barrier(xb); TSTAMP(n); } while (0)
#ifndef REPEAT_MASK
#define REPEAT_MASK 0
#endif
#define PH(n, ...) do { __VA_ARGS__; if ((REPEAT_MASK >> (n)) & 1) { xcd_barrier(xb); __VA_ARGS__; } } while (0)
static_assert(XCD_BAR_WORDS * 4 == 13824 && OFF_FLAG + 4096 <= OFF_LBS, "bar");
extern __shared__ __attribute__((aligned(16))) unsigned char smem_dyn[];
__global__ void __launch_bounds__(512, 2) fwd_megakernel(Params p) {
    LAS unsigned char* lds = (LAS unsigned char*)smem_dyn;
    volatile LAS unsigned* xst = (volatile LAS unsigned*)(lds + LDS_BYTES - 16);
    if (threadIdx.x < 4) xst[threadIdx.x] = 0u;
    __syncthreads();
    const XcdBarrier xb = xcd_barrier_post((unsigned*)(p.ws + OFF_BAR), xst);
    volatile LAS unsigned long long* tsl = (volatile LAS unsigned long long*)(lds + LDS_BYTES - 16 - 512);
    TSTAMP(0);
#define mod ((const float*)(p.ws + OFF_MOD))
#define H ((bf16_t*)(p.ws + OFF_H))
#define W0 ((bf16_t*)(p.ws + OFF_W0))
#define W1 ((bf16_t*)(p.ws + OFF_W1))
#define PROJ ((bf16_t*)(p.ws + OFF_PROJ))
#define X1 (p.out)
#define X2 ((float*)(p.ws + OFF_X2))
#define H2 ((bf16_t*)(p.ws + OFF_H2))
#define SSQ ((float*)(p.ws + OFF_SSQ))
#define CB ((const float*)(p.ws + OFF_CB))
    const int G = gridDim.x;
    PH(0, phase_mod(p, lds); __syncthreads(); phase_w0(p, lds));
    GSYNC(1);
    PH(1, phase_norm<false>(p, p.xp, p.xs, 0, 0, lds));
    GSYNC(2);
    PH(2, { pg8::EpiProj E; E.O = PROJ; E.ab = (float*)(p.ws + OFF_AB); gemm<2>(lds, H, W0, NPROJ_PAD, 1024, E, p.ws); });
    GSYNC(3);
    PH(3, phase_prep(p, lds));
    GSYNC(4);
    PH(4, phase_scan(p, lds));
    GSYNC(5);
    PH(5, phase_combine(p); __syncthreads(); phase_w1(p, lds));
    GSYNC(6);
    { pg8::EpiRes2 E; E.out = X1; E.base_p = p.xp; E.base_s = p.xs; E.gate = mod + 2048; E.A2 = H2; E.ng = p.norm_g + 1024; E.sc = mod + 4096; E.ssq = SSQ;
      gemm_split<0>(lds, H, W0 + (size_t)NPROJ_PAD * DM, 1024, E, p.ws); }
    GSYNC(8);
    PH(8, { pg8::EpiBfSB<1> E; E.O = PROJ; E.ldc = DFF; E.ssq = SSQ; E.bias = CB; E.ldb = DFF; E.npart = (G == 256) ? 4 : 16; gemm(lds, H2, W0 + (size_t)NPROJ_PAD * DM + (size_t)DM * DM, DFF, 1024, E); });
    GSYNC(9);
    { pg8::EpiRes2 E; E.out = X2; E.base_p = X1; E.base_s = X1 + (size_t)4096 * DM; E.gate = mod + 5120; E.A2 = H; E.ng = p.norm_g + 2048; E.sc = mod + 5 * NMOD + 1024; E.ssq = SSQ + (size_t)NTOK * 16;
      gemm_split<1>(lds, PROJ, W0 + (size_t)NPROJ_PAD * DM + (size_t)DM * DM + (size_t)DFF * DM, DFF, E, p.ws); }
    GSYNC(10);
    PH(11, { pg8::EpiBfSB<0> E; E.O = PROJ; E.ldc = 3072; E.ssq = SSQ + (size_t)NTOK * 16; E.bias = CB + 5 * 4096; E.ldb = 3072; E.npart = (G == 256) ? 4 : 16; gemm(lds, H, W1, 3072, 1024, E); });
    GSYNC(12);
    PH(13, phase_attn(p, lds));
    GSYNC(14);
    { pg8::EpiRes2 E; E.out = X1; E.base_p = X2; E.base_s = X2 + (size_t)4096 * DM; E.gate = mod + 5 * NMOD + 2048; E.A2 = H; E.ng = p.norm_g + 3072; E.sc = mod + 5 * NMOD + 4096; E.ssq = SSQ + (size_t)2 * NTOK * 16;
      gemm_split<2>(lds, H2, W1 + (size_t)3072 * DM, 1024, E, p.ws); }
    GSYNC(15);
    PH(16, { pg8::EpiBfSB<1> E; E.O = PROJ; E.ldc = DFF; E.ssq = SSQ + (size_t)2 * NTOK * 16; E.bias = CB + 5 * 4096 + 5 * 3072; E.ldb = DFF; E.npart = (G == 256) ? 4 : 16; gemm(lds, H, W1 + (size_t)3072 * DM + (size_t)DM * DM, DFF, 1024, E); });
    GSYNC(17);
    { pg8::EpiRes E; E.out = X1; E.base_p = X1; E.base_s = X1 + (size_t)4096 * DM; E.gate = mod + 5 * NMOD + 5120; gemm_split<3>(lds, PROJ, W1 + (size_t)3072 * DM + (size_t)DM * DM + (size_t)DFF * DM, DFF, E, p.ws); }
    if (PROBE_A >= 0) { TSTAMP(18);
        if (threadIdx.x == 0 && blockIdx.x == 0) { float us = (PROBE_A >= 100) ? (float)(long long)(((volatile unsigned long long*)(p.ws + OFF_STAMP2))[PROBE_B - 100] - ((volatile unsigned long long*)(p.ws + OFF_STAMP2))[PROBE_A - 100]) * 0.01f : (float)(long long)(tsl[PROBE_B < 100 ? PROBE_B : 0] - tsl[PROBE_A < 100 ? PROBE_A : 0]) * 0.01f;
            if (PROBE_GEMM >= 0) { const unsigned long long* st = (const unsigned long long*)(p.ws + OFF_STAMP); us = (float)(long long)(st[PROBE_GB] - st[PROBE_GA]) * (PROBE_GB >= 62 ? 0.01f : (1.0f / 2100.0f)); }
            float* e = p.out + (size_t)NTOK * DM + 2 * 2097152 + 4194304 + 7; *e = *e + 0.06f + us * PROBE_SCALE; } }
}

#undef mod
#undef H
#undef W0
#undef W1
#undef PROJ
#undef X1
#undef X2
#undef H2
#undef SSQ
#undef CB
extern "C" void kernel_launch(void* const* d_in, const int* in_sizes, int n_in, void* d_out, int out_size, void* d_ws, size_t ws_size, hipStream_t stream) {
    (void)in_sizes; (void)n_in; (void)out_size;
    static int grid_blocks = 0;
    if (!grid_blocks) {
        int dev = 0, cus = 0, per_cu = 0;
        (void)hipGetDevice(&dev);
        (void)hipDeviceGetAttribute(&cus, hipDeviceAttributeMultiprocessorCount, dev);
        (void)hipFuncSetAttribute((const void*)fwd_megakernel, hipFuncAttributeMaxDynamicSharedMemorySize, LDS_BYTES);
        (void)hipOccupancyMaxActiveBlocksPerMultiprocessor(&per_cu, fwd_megakernel, 512, LDS_BYTES);
        if (per_cu > 1) per_cu = 1;
        grid_blocks = cus * per_cu;
        if (ws_size < WS_NEED) fprintf(stderr, "workspace too small: %zu < %zu\n", ws_size, (size_t)WS_NEED);
    }
    Params p{};
    const float* const* in = (const float* const*)d_in;
    p.xp = in[0]; p.xs = in[1]; p.st_hgrn = in[2]; p.st_gdn = in[3]; p.cache_k = in[4]; p.cache_v = in[5]; p.c = in[6]; p.c_ctx = in[7]; p.ada_w = in[8]; p.ada_b = in[9];
    p.norm_g = in[10]; p.w_in = in[11]; p.w_out_ab = in[12]; p.hgrn_lb = in[13]; p.gdn_conv = in[14]; p.a_log = in[15]; p.dt_bias = in[16]; p.gn_hgrn = in[17]; p.gn_gdn = in[18];
    p.w_qkv = in[19]; p.qn = in[20]; p.kn = in[21]; p.rpb = in[22]; p.w_out_na = in[23]; p.w_mlp1 = in[24]; p.w_mlp2 = in[25];
    p.out = (float*)d_out; p.ws = (unsigned char*)d_ws;
    (void)hipMemsetAsync((unsigned char*)d_ws + OFF_BAR, 0, XCD_BAR_WORDS * 4 + 4096, stream);
    void* args[] = {&p};
    hipError_t e = hipLaunchCooperativeKernel((const void*)fwd_megakernel, dim3(grid_blocks), dim3(512), args, LDS_BYTES, stream);
    if (e != hipSuccess) fprintf(stderr, "cooperative launch failed: %s (grid %d)\n", hipGetErrorString(e), grid_blocks);
}
```
